# Optimizing an MI355X kernel written in HIP

```python
import math
import jax, jax.numpy as jnp
from jax import lax
import numpy as np

D_MODEL = 2048
BATCH = 1
SEQ = 16384
DEPTH = 1

CONV_CH = D_MODEL
CONV_K = 3
N_HEADS = 16
N_KV_HEADS = 4
GROUP = N_HEADS // N_KV_HEADS
HEAD_DIM = 128
CMP_LEN = 32
CMP_STRIDE = 16
CMP_HIDDEN = 2 * HEAD_DIM
SLC_LEN = 64
SLC_TOPN = 16
WINDOW = 512
Q_BLOCK = 128
D_FF = 4 * D_MODEL
PLE_DIM = 256
REL_BUCKETS = 32
REL_EXACT = REL_BUCKETS // 2
REL_MAX_DIST = 4096
LN_EPS = 1e-5
NEG_INF = -1e30
FORCE_SCORE = 1e9
DN_ALPHA = (2 * DEPTH) ** 0.25
DN_BETA = (8 * DEPTH) ** -0.25

kernel_name = "hybrid_conv_nsa_gated_block"


def _in_sizes():
    kv = N_KV_HEADS * HEAD_DIM
    return [CONV_CH, CONV_CH, CONV_CH, N_HEADS * HEAD_DIM, kv, kv, kv, kv, kv, kv, N_HEADS * 3, D_MODEL, D_MODEL]


def _split_in(proj):
    offsets = [int(o) for o in np.cumsum(_in_sizes())[:-1]]
    return jnp.split(proj, offsets, axis=-1)


def _layer_norm(x, g, b):
    xf = x.astype(jnp.float32)
    mu = jnp.mean(xf, axis=-1, keepdims=True)
    var = jnp.mean(jnp.square(xf - mu), axis=-1, keepdims=True)
    y = (xf - mu) * lax.rsqrt(var + LN_EPS) * g.astype(jnp.float32) + b.astype(jnp.float32)
    return y.astype(x.dtype)


def _rel_bucket(dist):
    n = jnp.maximum(dist, 0)
    nf = jnp.maximum(n, 1).astype(jnp.float32)
    large = REL_EXACT + (jnp.log(nf / REL_EXACT) / math.log(REL_MAX_DIST / REL_EXACT)
                         * (REL_BUCKETS - REL_EXACT)).astype(jnp.int32)
    large = jnp.minimum(large, REL_BUCKETS - 1)
    return jnp.where(n < REL_EXACT, n, large)


def _masked_softmax(s, mask):
    p = jax.nn.softmax(jnp.where(mask, s, NEG_INF), axis=-1)
    return jnp.where(mask, p, 0.0)


def _causal_dwconv(z, w):
    C = z.shape[-1]
    return lax.conv_general_dilated(z, w[:, None, :].astype(z.dtype), window_strides=(1,),
                                    padding=[(CONV_K - 1, 0)],
                                    dimension_numbers=('NWC', 'WIO', 'NWC'),
                                    feature_group_count=C)


def _compress(k, pe, w1, w2):
    B, T, Hk, Dh = k.shape
    n_cmp = (T - CMP_LEN) // CMP_STRIDE + 1
    idx = jnp.arange(n_cmp)[:, None] * CMP_STRIDE + jnp.arange(CMP_LEN)[None, :]
    blocks = k[:, idx] + pe[None, None, :, None, :]
    blocks = jnp.moveaxis(blocks, 3, 2).reshape(B, n_cmp, Hk, CMP_LEN * Dh)
    return jax.nn.gelu(blocks @ w1) @ w2


def _gather_rows(kv, pos):
    return jax.vmap(jax.vmap(lambda a, i: a[i]))(kv, pos)


def _nsa(q, k_c, v_c, k_s, v_s, k_w, v_w, gates, pe_k, w1_k, w2_k, pe_v, w1_v, w2_v, rel_bias):
    B, T = q.shape[0], q.shape[1]
    scale = HEAD_DIM ** -0.5
    n_q = T // Q_BLOCK
    n_slc = T // SLC_LEN
    n_sel = min(SLC_TOPN, n_slc)

    kc = _compress(k_c, pe_k, w1_k, w2_k)
    vc = _compress(v_c, pe_v, w1_v, w2_v)
    n_cmp = kc.shape[1]
    cmp_start = jnp.arange(n_cmp) * CMP_STRIDE
    cmp_end = cmp_start + CMP_LEN - 1
    sblk = jnp.arange(n_slc)
    overlap = ((cmp_start[:, None] < (sblk[None, :] + 1) * SLC_LEN)
               & (cmp_start[:, None] + CMP_LEN > sblk[None, :] * SLC_LEN)).astype(jnp.float32)

    ks_t = jnp.transpose(k_s, (0, 2, 1, 3))
    vs_t = jnp.transpose(v_s, (0, 2, 1, 3))
    kw_pad = jnp.pad(k_w, ((0, 0), (WINDOW, 0), (0, 0), (0, 0)))
    vw_pad = jnp.pad(v_w, ((0, 0), (WINDOW, 0), (0, 0), (0, 0)))
    table = rel_bias.astype(jnp.float32)
    table_hg = table.reshape(REL_BUCKETS, N_KV_HEADS, GROUP)

    def bias_dense(dist):
        bsel = table[_rel_bucket(dist)].reshape(dist.shape + (N_KV_HEADS, GROUP))
        return jnp.transpose(bsel, (2, 3, 0, 1))

    def block_fn(args):
        qb, gb, blk = args
        t = blk * Q_BLOCK + jnp.arange(Q_BLOCK)

        dist_c = t[:, None] - cmp_end[None, :]
        s = jnp.einsum('bqhgd,bchd->bhgqc', qb, kc).astype(jnp.float32) * scale + bias_dense(dist_c)
        p_cmp = _masked_softmax(s, dist_c >= 0)
        o_cmp = jnp.einsum('bhgqc,bchd->bqhgd', p_cmp.astype(vc.dtype), vc)

        imp = jnp.einsum('bhgqc,cs->bhqs', p_cmp, overlap)
        jt = (t // SLC_LEN)[:, None]
        forced = (sblk[None, :] == 0) | (sblk[None, :] == jt) | (sblk[None, :] == jt - 1)
        future = sblk[None, :] * SLC_LEN > t[:, None]
        imp = jnp.where(forced, FORCE_SCORE, jnp.where(future, -1.0, imp))
        _, sel = lax.top_k(imp, n_sel)
        pos = (sel[..., None] * SLC_LEN + jnp.arange(SLC_LEN)).reshape(B, N_KV_HEADS, Q_BLOCK, n_sel * SLC_LEN)

        ks = _gather_rows(ks_t, pos)
        vs = _gather_rows(vs_t, pos)
        dist_s = t[None, None, :, None] - pos
        bias_s = table_hg[_rel_bucket(dist_s), jnp.arange(N_KV_HEADS)[None, :, None, None]]
        bias_s = jnp.moveaxis(bias_s, -1, 2)
        s = jnp.einsum('bqhgd,bhqkd->bhgqk', qb, ks).astype(jnp.float32) * scale + bias_s
        p_s = _masked_softmax(s, (dist_s >= 0)[:, :, None])
        o_slc = jnp.einsum('bhgqk,bhqkd->bqhgd', p_s.astype(vs.dtype), vs)

        start = blk * Q_BLOCK
        kw = lax.dynamic_slice_in_dim(kw_pad, start, Q_BLOCK + WINDOW, axis=1)
        vw = lax.dynamic_slice_in_dim(vw_pad, start, Q_BLOCK + WINDOW, axis=1)
        kpos = start - WINDOW + jnp.arange(Q_BLOCK + WINDOW)
        dist_w = t[:, None] - kpos[None, :]
        mask_w = (dist_w >= 0) & (dist_w < WINDOW) & (kpos >= 0)[None, :]
        s = jnp.einsum('bqhgd,bkhd->bhgqk', qb, kw).astype(jnp.float32) * scale + bias_dense(dist_w)
        p_w = _masked_softmax(s, mask_w)
        o_win = jnp.einsum('bhgqk,bkhd->bqhgd', p_w.astype(vw.dtype), vw)

        return gb[..., 0:1] * o_cmp + gb[..., 1:2] * o_slc + gb[..., 2:3] * o_win

    q_blocks = jnp.moveaxis(q.reshape(B, n_q, Q_BLOCK, N_KV_HEADS, GROUP, HEAD_DIM), 1, 0)
    g_blocks = jnp.moveaxis(gates.reshape(B, n_q, Q_BLOCK, N_KV_HEADS, GROUP, 3), 1, 0)
    out = lax.map(block_fn, (q_blocks, g_blocks, jnp.arange(n_q)))
    return jnp.moveaxis(out, 0, 1).reshape(B, T, N_HEADS * HEAD_DIM)


def setup_inputs(seed: int = 0) -> dict:
    key = jax.random.key(seed)
    ks = jax.random.split(key, 24)
    f32 = jnp.float32
    n_in = sum(_in_sizes())
    kv_flat = CMP_LEN * HEAD_DIM

    def nrm(k, shape, scale):
        return jax.random.normal(k, shape, f32) * scale

    return {
        "x": nrm(ks[0], (BATCH, SEQ, D_MODEL), 1.0),
        "p": nrm(ks[1], (DEPTH, BATCH, SEQ, PLE_DIM), 1.0),
        "w_in": nrm(ks[2], (DEPTH, D_MODEL, n_in), D_MODEL ** -0.5),
        "conv_w": nrm(ks[3], (DEPTH, CONV_K, CONV_CH), CONV_K ** -0.5),
        "cmp_pe_k": nrm(ks[4], (DEPTH, CMP_LEN, HEAD_DIM), 0.1),
        "cmp_w1_k": nrm(ks[5], (DEPTH, kv_flat, CMP_HIDDEN), kv_flat ** -0.5),
        "cmp_w2_k": nrm(ks[6], (DEPTH, CMP_HIDDEN, HEAD_DIM), CMP_HIDDEN ** -0.5),
        "cmp_pe_v": nrm(ks[7], (DEPTH, CMP_LEN, HEAD_DIM), 0.1),
        "cmp_w1_v": nrm(ks[8], (DEPTH, kv_flat, CMP_HIDDEN), kv_flat ** -0.5),
        "cmp_w2_v": nrm(ks[9], (DEPTH, CMP_HIDDEN, HEAD_DIM), CMP_HIDDEN ** -0.5),
        "w_conv_out": nrm(ks[10], (DEPTH, CONV_CH, D_MODEL), CONV_CH ** -0.5),
        "w_attn_out": nrm(ks[11], (DEPTH, N_HEADS * HEAD_DIM, D_MODEL), (N_HEADS * HEAD_DIM) ** -0.5),
        "w_mix_out": nrm(ks[12], (DEPTH, D_MODEL, D_MODEL), DN_BETA * D_MODEL ** -0.5),
        "ln1_g": 1.0 + nrm(ks[13], (DEPTH, D_MODEL), 0.02),
        "ln1_b": nrm(ks[14], (DEPTH, D_MODEL), 0.02),
        "w_mlp_up": nrm(ks[15], (DEPTH, D_MODEL, D_FF), D_MODEL ** -0.5),
        "w_mlp_down": nrm(ks[16], (DEPTH, D_FF, D_MODEL), DN_BETA * D_FF ** -0.5),
        "w_ple": nrm(ks[17], (DEPTH, PLE_DIM, D_MODEL), DN_BETA * PLE_DIM ** -0.5),
        "w_ple_gate": nrm(ks[18], (DEPTH, D_MODEL, D_MODEL), D_MODEL ** -0.5),
        "ln2_g": 1.0 + nrm(ks[19], (DEPTH, D_MODEL), 0.02),
        "ln2_b": nrm(ks[20], (DEPTH, D_MODEL), 0.02),
        "rel_bias": nrm(ks[21], (REL_BUCKETS, N_HEADS), 0.5),
    }


def reference(x, p, w_in, conv_w, cmp_pe_k, cmp_w1_k, cmp_w2_k, cmp_pe_v, cmp_w1_v, cmp_w2_v,
              w_conv_out, w_attn_out, w_mix_out, ln1_g, ln1_b, w_mlp_up, w_mlp_down,
              w_ple, w_ple_gate, ln2_g, ln2_b, rel_bias):
    B, T, _ = x.shape
    for i in range(DEPTH):
        proj = x @ w_in[i]
        bg, cg, hx, q, k_c, v_c, k_s, v_s, k_w, v_w, ng, ma, mb = _split_in(proj)

        y_a = (bg * _causal_dwconv(cg * hx, conv_w[i])) @ w_conv_out[i]

        kv_shape = (B, T, N_KV_HEADS, HEAD_DIM)
        o_nsa = _nsa(q.reshape(B, T, N_KV_HEADS, GROUP, HEAD_DIM),
                     k_c.reshape(kv_shape), v_c.reshape(kv_shape),
                     k_s.reshape(kv_shape), v_s.reshape(kv_shape),
                     k_w.reshape(kv_shape), v_w.reshape(kv_shape),
                     jax.nn.sigmoid(ng).reshape(B, T, N_KV_HEADS, GROUP, 3),
                     cmp_pe_k[i], cmp_w1_k[i], cmp_w2_k[i], cmp_pe_v[i], cmp_w1_v[i], cmp_w2_v[i],
                     rel_bias)
        y_b = o_nsa @ w_attn_out[i]

        mixed = jax.nn.sigmoid(ma) * y_a + jax.nn.sigmoid(mb) * y_b
        x = _layer_norm(DN_ALPHA * x + mixed @ w_mix_out[i], ln1_g[i], ln1_b[i])

        h = jnp.square(jax.nn.relu(x @ w_mlp_up[i])) @ w_mlp_down[i]
        ple = (p[i] @ w_ple[i]) * jax.nn.sigmoid(x @ w_ple_gate[i])
        x = _layer_norm(DN_ALPHA * x + h + ple, ln2_g[i], ln2_b[i])
    return x
```

```cpp
#include <hip/hip_runtime.h>
#include <hip/hip_cooperative_groups.h>
#include <cstdio>
#include <cstdint>
namespace cg = cooperative_groups;

#define LAS __attribute__((address_space(3)))
typedef unsigned short bf16_t;
typedef short bf16x8 __attribute__((ext_vector_type(8)));
typedef float f32x4 __attribute__((ext_vector_type(4)));
typedef float f32x2 __attribute__((ext_vector_type(2)));
typedef unsigned u32x4 __attribute__((ext_vector_type(4)));
typedef unsigned u32x2 __attribute__((ext_vector_type(2)));

#ifndef MK_PER_PHASE
#define MK_PER_PHASE 0
#endif

constexpr int T = 16384, D = 2048, NIN = 15408, FF = 8192, PLE = 256, HK = 4, HD = 128, NCMP = 1024;
constexpr float DN_ALPHA = 1.189207115002721f;
constexpr float LN_EPS = 1e-5f;
constexpr int NWAVES = 8;
constexpr int LDS_BYTES = 147456;

constexpr size_t MiB = 1u << 20;
constexpr size_t WS_BIASK = 0, WS_BIASV = 4096;
constexpr size_t WS_XB = 1 * MiB;
constexpr size_t WS_WTUP = 1 * MiB, WS_WTDOWN = 33 * MiB;
constexpr size_t WS_WTIN = 65 * MiB;
constexpr size_t WS_WTVT = 114 * MiB;
constexpr size_t WS_WTMB = 118 * MiB;
constexpr size_t WS_WTCONV = 65 * MiB, WS_WTATTN = 73 * MiB, WS_WTMIX = 81 * MiB, WS_WTGATE = 89 * MiB, WS_WTPLE = 97 * MiB, WS_PB = 98 * MiB;
constexpr size_t WS_W1K = 126 * MiB, WS_W1V = 128 * MiB;
constexpr size_t WS_HIDK = 130 * MiB, WS_HIDV = 132 * MiB;
constexpr size_t WS_KC = 134 * MiB, WS_VCT = 135 * MiB;
constexpr size_t WS_GATES = 136 * MiB;
constexpr size_t WS_BG = 140 * MiB;
constexpr size_t WS_X1B = 140 * MiB;
constexpr size_t WS_ZZ = 204 * MiB;
constexpr size_t WS_SMB = 204 * MiB, WS_H1 = 204 * MiB;
constexpr size_t WS_Q = 268 * MiB;
constexpr size_t WS_KCS = 332 * MiB, WS_VCS = 348 * MiB, WS_KS = 364 * MiB, WS_KW = 380 * MiB, WS_VST = 396 * MiB, WS_VWT = 412 * MiB;
constexpr size_t WS_SMA = 428 * MiB;
constexpr size_t WS_PRE1 = 300 * MiB, WS_PRE2 = 364 * MiB;
constexpr size_t WS_END = 492 * MiB;

typedef __bf16 bf16x2_t __attribute__((ext_vector_type(2)));
__device__ __forceinline__ unsigned cvt_pk_bf16(float lo, float hi) { f32x2 v = {lo, hi}; bf16x2_t b = __builtin_convertvector(v, bf16x2_t); return __builtin_bit_cast(unsigned, b); }
__device__ __forceinline__ float bf_lo(unsigned w) { return __uint_as_float(w << 16); }
__device__ __forceinline__ float bf_hi(unsigned w) { return __uint_as_float(w & 0xffff0000u); }
__device__ __forceinline__ float fast_sigmoid(float x) { return __builtin_amdgcn_rcpf(1.f + __expf(-x)); }
__device__ __forceinline__ u32x4 pack8(const f32x4& a, const f32x4& b) { u32x4 w; w.x = cvt_pk_bf16(a[0], a[1]); w.y = cvt_pk_bf16(a[2], a[3]); w.z = cvt_pk_bf16(b[0], b[1]); w.w = cvt_pk_bf16(b[2], b[3]); return w; }
__device__ __forceinline__ void unpack8(const u32x4& w, f32x4& a, f32x4& b) { a[0] = bf_lo(w.x); a[1] = bf_hi(w.x); a[2] = bf_lo(w.y); a[3] = bf_hi(w.y); b[0] = bf_lo(w.z); b[1] = bf_hi(w.z); b[2] = bf_lo(w.w); b[3] = bf_hi(w.w); }

namespace pg8 {
constexpr int BM = 256, BK = 64, HALF = 128, HTB = HALF * BK * 2, STAGE_BYTES = 8 * HTB, NXCD = 8, WGM = 8;
__host__ __device__ __forceinline__ int lds_byte(int r, int c) { const int st = (r >> 4) * 2 + (c >> 5), rr = r & 15, cc = c & 31, ob = rr * 64 + cc * 2; return st * 1024 + (ob ^ (((ob >> 9) & 1) << 5)); }
__host__ __device__ __forceinline__ void stage_rc(int b, int& R, int& C) { const int st = b / 1024, sb = b % 1024, swz = sb ^ (((sb >> 9) & 1) << 5); R = (st >> 1) * 16 + swz / 64; C = (st & 1) * 32 + (swz % 64) / 2; }
__host__ __device__ __forceinline__ int perm32(int rho) { const int n = rho >> 4, i = rho & 15; return 8 * (i >> 2) + 4 * n + (i & 3); }

struct Unit { int pm, pn; };
struct Gemm { const bf16_t* A; const bf16_t* Bt; int M, N, K, lda, ldb; };

struct StaticOrder {
    int nM, nN, nwg, G, c;
    __device__ void init(int M, int N, int G_, int c_) { nM = M / BM; nN = N / BM; nwg = nM * nN; G = G_; c = c_; }
    __device__ bool next(int i, Unit& u) const {
        const long L = (long)i * G + c; if (c < 0 || L >= nwg) return false;
        int wgid = (int)L; { const int q = nwg / NXCD, r = nwg % NXCD, xcd = wgid % NXCD, off = wgid / NXCD; wgid = (xcd < r ? xcd * (q + 1) : r * (q + 1) + (xcd - r) * q) + off; }
        const int nig = WGM * nN, gid = wgid / nig, fm = gid * WGM, gsz = (nM - fm) < WGM ? (nM - fm) : WGM;
        u.pm = fm + ((wgid % nig) % gsz); u.pn = (wgid % nig) / gsz; return true;
    }
};

template <class F> struct EpiGen {
    F f;
    __device__ __forceinline__ void operator()(const f32x4 (&acc)[2][2][4][2], const Unit& u, int wr, int wc, int fr, int fq) const {
        const int row0 = u.pm * BM + wr * 64 + fr, col0 = u.pn * BM + wc * 32 + 8 * fq;
#pragma unroll
        for (int ai = 0; ai < 2; ++ai)
#pragma unroll
            for (int m = 0; m < 4; ++m) {
                const int row = row0 + ai * HALF + m * 16;
#pragma unroll
                for (int bj = 0; bj < 2; ++bj) f(row, col0 + bj * HALF, acc[ai][bj][m][0], acc[ai][bj][m][1]);
            }
    }
};

template <class Epi, class Sched>
__device__ __forceinline__ void gemm_phase(LAS unsigned char* lds, const Gemm g, const Sched& S, const Epi& E) {
    const int tid = threadIdx.x, wid = __builtin_amdgcn_readfirstlane(tid >> 6), lane = tid & 63, wr = wid >> 2, wc = wid & 3, fr = lane & 15, fq = lane >> 4;
    const int K = g.K, nt = K / BK;
    unsigned voffA[2], voffB[2];
#pragma unroll
    for (int i = 0; i < 2; ++i) { int R, C; stage_rc(tid * 16 + i * 8192, R, C); const int Rb = (R & ~31) + perm32(R & 31);
        voffA[i] = (unsigned)(R * g.lda + C) * 2u; voffB[i] = (unsigned)(Rb * g.ldb + C) * 2u; }
    const size_t kstep = (size_t)(BK * 2);
    const size_t hstepA = (size_t)HALF * g.lda * 2, hstepB = (size_t)HALF * g.ldb * 2;
    const size_t tstepA = 2 * hstepA, tstepB = 2 * hstepB;
    const unsigned ldsw = (unsigned)wid * 1024u;
    const int aoff = lds_byte(wr * 64 + fr, fq * 8), boff = lds_byte(wc * 32 + fr, fq * 8);
#define PG8_SA(b, h) (((b) * 2 + (h)) * HTB)
#define PG8_SB(b, h) ((4 + (b) * 2 + (h)) * HTB)
#define PG8_STAGE(bufoff, gbase, voff) do { _Pragma("unroll") for (int _i = 0; _i < 2; ++_i) \
        __builtin_amdgcn_global_load_lds((const unsigned*)((const char*)(gbase) + (voff)[_i]), (LAS unsigned*)(lds + (bufoff) + ldsw + _i * 8192), 16, 0, 0); } while (0)
#define PG8_LDA(dst, b, h) do { _Pragma("unroll") for (int m = 0; m < 4; ++m) _Pragma("unroll") for (int k = 0; k < 2; ++k) dst[m][k] = *(const LAS bf16x8*)(lds + PG8_SA(b, h) + aoff + m * 2048 + k * 1024); } while (0)
#define PG8_LDB(dst, b, h) do { _Pragma("unroll") for (int n = 0; n < 2; ++n) _Pragma("unroll") for (int k = 0; k < 2; ++k) dst[n][k] = *(const LAS bf16x8*)(lds + PG8_SB(b, h) + boff + n * 2048 + k * 1024); } while (0)
#define PG8_MMA(ai, bj, At, Bt) do { __builtin_amdgcn_s_setprio(1); _Pragma("unroll") for (int m = 0; m < 4; ++m) _Pragma("unroll") for (int n = 0; n < 2; ++n) _Pragma("unroll") for (int k = 0; k < 2; ++k) \
        acc[ai][bj][m][n] = __builtin_amdgcn_mfma_f32_16x16x32_bf16(Bt[n][k], At[m][k], acc[ai][bj][m][n], 0, 0, 0); __builtin_amdgcn_s_setprio(0); } while (0)
#define PG8_WAIT_V(n) asm volatile("s_waitcnt vmcnt(" #n ")" ::: "memory")
#define PG8_WAIT_L(n) asm volatile("s_waitcnt lgkmcnt(" #n ")" ::: "memory")
#define PG8_BAR __builtin_amdgcn_s_barrier()
#define PG8_SCHED __builtin_amdgcn_sched_barrier(0)
    Unit cur, nxt; int ui = 0;
    if (!S.next(0, cur)) return;
    f32x4 acc[2][2][4][2];
#pragma unroll
    for (int a = 0; a < 2; ++a)
#pragma unroll
        for (int b = 0; b < 2; ++b)
#pragma unroll
            for (int m = 0; m < 4; ++m)
#pragma unroll
                for (int n = 0; n < 2; ++n) acc[a][b][m][n] = (f32x4){0.f, 0.f, 0.f, 0.f};
    bf16x8 At[4][2], B0[2][2], B1[2][2];
    const char* cA = (const char*)g.A + (size_t)cur.pm * tstepA; const char* cB = (const char*)g.Bt + (size_t)cur.pn * tstepB;
    PG8_STAGE(PG8_SB(0, 0), cB, voffB); PG8_STAGE(PG8_SB(0, 1), cB + hstepB, voffB); PG8_STAGE(PG8_SA(0, 0), cA, voffA); PG8_STAGE(PG8_SA(0, 1), cA + hstepA, voffA);
    if (wr == 1) PG8_BAR;
    PG8_WAIT_V(2); PG8_BAR;
    PG8_STAGE(PG8_SB(1, 0), cB + kstep, voffB); PG8_STAGE(PG8_SA(1, 0), cA + kstep, voffA); PG8_STAGE(PG8_SB(1, 1), cB + hstepB + kstep, voffB);
    PG8_WAIT_V(6); PG8_BAR;
    for (;;) {
        const bool has_next = S.next(ui + 1, nxt);
        const char* nA = has_next ? (const char*)g.A + (size_t)nxt.pm * tstepA : cA; const char* nB = has_next ? (const char*)g.Bt + (size_t)nxt.pn * tstepB : cB;
        for (int t = 0; t < nt; t += 2) {
            const bool last = (t == nt - 2);
            const char* a1 = cA + (size_t)(t + 1) * kstep;
            const char* a2 = last ? nA : cA + (size_t)(t + 2) * kstep; const char* b2 = last ? nB : cB + (size_t)(t + 2) * kstep;
            const char* a3 = a2 + kstep; const char* b3 = b2 + kstep;
            PG8_LDB(B0, 0, 0); PG8_LDB(B1, 0, 1); PG8_SCHED; PG8_LDA(At, 0, 0); PG8_STAGE(PG8_SA(1, 1), a1 + hstepA, voffA);
            PG8_WAIT_V(8); PG8_WAIT_L(0); PG8_BAR; PG8_MMA(0, 0, At, B0); PG8_MMA(0, 1, At, B1); PG8_BAR; PG8_SCHED;
            PG8_LDA(At, 0, 1); PG8_STAGE(PG8_SB(0, 0), b2, voffB); PG8_STAGE(PG8_SB(0, 1), b2 + hstepB, voffB); PG8_STAGE(PG8_SA(0, 0), a2, voffA);
            PG8_WAIT_V(8); PG8_WAIT_L(0); PG8_BAR; PG8_MMA(1, 0, At, B0); PG8_MMA(1, 1, At, B1); PG8_BAR; PG8_SCHED;
            PG8_LDB(B0, 1, 0); PG8_LDB(B1, 1, 1); PG8_SCHED; PG8_LDA(At, 1, 0); PG8_STAGE(PG8_SA(0, 1), a2 + hstepA, voffA);
            PG8_WAIT_V(8); PG8_WAIT_L(0); PG8_BAR; PG8_MMA(0, 0, At, B0); PG8_MMA(0, 1, At, B1); PG8_BAR; PG8_SCHED;
            PG8_LDA(At, 1, 1); PG8_STAGE(PG8_SB(1, 0), b3, voffB); PG8_STAGE(PG8_SB(1, 1), b3 + hstepB, voffB); PG8_STAGE(PG8_SA(1, 0), a3, voffA);
            PG8_WAIT_V(8); PG8_WAIT_L(0); PG8_BAR; PG8_MMA(1, 0, At, B0); PG8_MMA(1, 1, At, B1); PG8_BAR; PG8_SCHED;
        }
        if (wr == 0) PG8_BAR;
        E(acc, cur, wr, wc, fr, fq);
        if (!has_next) break;
#pragma unroll
        for (int a = 0; a < 2; ++a)
#pragma unroll
            for (int b = 0; b < 2; ++b)
#pragma unroll
                for (int m = 0; m < 4; ++m)
#pragma unroll
                    for (int n = 0; n < 2; ++n) acc[a][b][m][n] = (f32x4){0.f, 0.f, 0.f, 0.f};
        cur = nxt; cA = nA; cB = nB; ++ui;
        if (wr == 1) PG8_BAR;
    }
    PG8_WAIT_V(0);
    PG8_BAR;
#undef PG8_SA
#undef PG8_SB
#undef PG8_STAGE
#undef PG8_LDA
#undef PG8_LDB
#undef PG8_MMA
#undef PG8_WAIT_V
#undef PG8_WAIT_L
#undef PG8_BAR
#undef PG8_SCHED
}
}

struct FStoreBf16 {
    bf16_t* O; int ldc; int act;
    __device__ __forceinline__ void operator()(int row, int col, f32x4 a, f32x4 b) const {
        if (act == 1) { for (int i = 0; i < 4; ++i) { a[i] = fast_sigmoid(a[i]); b[i] = fast_sigmoid(b[i]); } }
        else if (act == 2) { for (int i = 0; i < 4; ++i) { float x = fmaxf(a[i], 0.f), y = fmaxf(b[i], 0.f); a[i] = x * x; b[i] = y * y; } }
        *(u32x4*)(O + (size_t)row * ldc + col) = pack8(a, b);
    }
};
struct FStoreVT {
    bf16_t* O;
    __device__ __forceinline__ void operator()(int row, int col, f32x4 a, f32x4 b) const {
        if (row < 512) { const int hk = row >> 7, d = row & 127; *(u32x4*)(O + ((size_t)((hk * 256 + (col >> 6)) * 128 + d) << 6) + (col & 63)) = pack8(a, b); }
        else *(u32x4*)(O + (size_t)row * T + col) = pack8(a, b);
    }
};
struct FGeluBias {
    bf16_t* O; int ldc; const float* bias;
    __device__ __forceinline__ void operator()(int row, int col, f32x4 a, f32x4 b) const {
        const f32x4 b0 = *(const f32x4*)(bias + col), b1 = *(const f32x4*)(bias + col + 4);
        a = a + b0; b = b + b1;
        for (int i = 0; i < 4; ++i) {
            float x = a[i]; a[i] = x * __builtin_amdgcn_rcpf(1.f + __expf(-1.5957691216057308f * (x + 0.044715f * x * x * x)));
            float y = b[i]; b[i] = y * __builtin_amdgcn_rcpf(1.f + __expf(-1.5957691216057308f * (y + 0.044715f * y * y * y)));
        }
        *(u32x4*)(O + (size_t)row * ldc + col) = pack8(a, b);
    }
};
struct FMulInplace {
    bf16_t* O; int ldc;
    __device__ __forceinline__ void operator()(int row, int col, f32x4 a, f32x4 b) const {
        bf16_t* p = O + (size_t)row * ldc + col; f32x4 g0, g1; unpack8(*(const u32x4*)p, g0, g1);
        *(u32x4*)p = pack8(a * g0, b * g1);
    }
};
struct FMulAddInplace {
    bf16_t* O; const bf16_t* Y; int ldc;
    __device__ __forceinline__ void operator()(int row, int col, f32x4 a, f32x4 b) const {
        bf16_t* p = O + (size_t)row * ldc + col; f32x4 g0, g1, y0, y1; unpack8(*(const u32x4*)p, g0, g1); unpack8(*(const u32x4*)(Y + (size_t)row * ldc + col), y0, y1);
        *(u32x4*)p = pack8(a * g0 + y0, b * g1 + y1);
    }
};
struct FResidF32 {
    float* P; const float* X; int ldc;
    __device__ __forceinline__ void operator()(int row, int col, f32x4 a, f32x4 b) const {
        const size_t o = (size_t)row * ldc + col;
        const f32x4 x0 = *(const f32x4*)(X + o), x1 = *(const f32x4*)(X + o + 4);
        *(f32x4*)(P + o) = x0 * DN_ALPHA + a; *(f32x4*)(P + o + 4) = x1 * DN_ALPHA + b;
    }
};
struct FSigmoidF32 {
    float* P; int ldc;
    __device__ __forceinline__ void operator()(int row, int col, f32x4 a, f32x4 b) const {
        for (int i = 0; i < 4; ++i) { a[i] = fast_sigmoid(a[i]); b[i] = fast_sigmoid(b[i]); }
        const size_t o = (size_t)row * ldc + col; *(f32x4*)(P + o) = a; *(f32x4*)(P + o + 4) = b;
    }
};
struct FPle {
    float* P; const bf16_t* X; int ldc;
    __device__ __forceinline__ void operator()(int row, int col, f32x4 a, f32x4 b) const {
        const size_t o = (size_t)row * ldc + col; f32x4 x0, x1; unpack8(*(const u32x4*)(X + o), x0, x1);
        const f32x4 p0 = *(const f32x4*)(P + o), p1 = *(const f32x4*)(P + o + 4);
        *(f32x4*)(P + o) = a * p0 + x0 * DN_ALPHA; *(f32x4*)(P + o + 4) = b * p1 + x1 * DN_ALPHA;
    }
};
struct FAccF32 {
    float* P; int ldc;
    __device__ __forceinline__ void operator()(int row, int col, f32x4 a, f32x4 b) const {
        const size_t o = (size_t)row * ldc + col;
        *(f32x4*)(P + o) = *(const f32x4*)(P + o) + a; *(f32x4*)(P + o + 4) = *(const f32x4*)(P + o + 4) + b;
    }
};
struct EpiInProj {
    bf16_t *zz, *bg, *q, *kv, *sma; float* gates;
    __device__ __forceinline__ void operator()(const f32x4 (&acc)[2][2][4][2], const pg8::Unit& u, int wr, int wc, int fr, int fq) const {
        const int row0 = u.pm * 256 + wr * 64 + fr, cw = wc * 32 + 8 * fq; const int pn = u.pn;
        if (pn < 16) {
#pragma unroll
            for (int ai = 0; ai < 2; ++ai)
#pragma unroll
                for (int m = 0; m < 4; ++m) { const int row = row0 + ai * 128 + m * 16;
                    *(u32x4*)(zz + (size_t)row * D + pn * 128 + cw) = pack8(acc[ai][0][m][0] * acc[ai][1][m][0], acc[ai][0][m][1] * acc[ai][1][m][1]); }
        } else if (pn < 32) {
            bf16_t* O = (pn < 24) ? bg : q; const int c0 = ((pn - 16) & 7) * 256 + cw;
#pragma unroll
            for (int ai = 0; ai < 2; ++ai)
#pragma unroll
                for (int m = 0; m < 4; ++m) { const int row = row0 + ai * 128 + m * 16;
#pragma unroll
                    for (int bj = 0; bj < 2; ++bj) *(u32x4*)(O + (size_t)row * D + c0 + bj * 128) = pack8(acc[ai][bj][m][0], acc[ai][bj][m][1]); }
        } else if (pn < 40) {
            const int c0 = (pn - 32) * 256; const int b = c0 >> 9, h0 = (c0 & 511) >> 7;
            bf16_t* O = kv + (size_t)b * ((size_t)T * 512);
#pragma unroll
            for (int ai = 0; ai < 2; ++ai)
#pragma unroll
                for (int m = 0; m < 4; ++m) { const int row = row0 + ai * 128 + m * 16;
#pragma unroll
                    for (int bj = 0; bj < 2; ++bj) *(u32x4*)(O + (size_t)(h0 + bj) * ((size_t)T * 128) + (size_t)row * 128 + cw) = pack8(acc[ai][bj][m][0], acc[ai][bj][m][1]); }
        } else if (pn < 48) {
            const int c0 = (pn - 40) * 256 + cw;
#pragma unroll
            for (int ai = 0; ai < 2; ++ai)
#pragma unroll
                for (int m = 0; m < 4; ++m) { const int row = row0 + ai * 128 + m * 16;
#pragma unroll
                    for (int bj = 0; bj < 2; ++bj) { f32x4 a = acc[ai][bj][m][0], b = acc[ai][bj][m][1];
                        for (int i = 0; i < 4; ++i) { a[i] = fast_sigmoid(a[i]); b[i] = fast_sigmoid(b[i]); }
                        *(u32x4*)(sma + (size_t)row * D + c0 + bj * 128) = pack8(a, b); } }
        } else {
            if (cw < 48) {
#pragma unroll
                for (int ai = 0; ai < 2; ++ai)
#pragma unroll
                    for (int m = 0; m < 4; ++m) { const int row = row0 + ai * 128 + m * 16; f32x4 a = acc[ai][0][m][0], b = acc[ai][0][m][1];
                        for (int i = 0; i < 4; ++i) { a[i] = fast_sigmoid(a[i]); b[i] = fast_sigmoid(b[i]); }
                        *(f32x4*)(gates + (size_t)row * 48 + cw) = a; *(f32x4*)(gates + (size_t)row * 48 + cw + 4) = b; }
            }
        }
    }
};

struct Args {
    const float* in[22]; float* out; unsigned char* ws; int ph_lo, ph_hi, G, pad;
};

struct Ctx { int tid, lane, wave, gw, NGW, gtid, NT; LAS unsigned char* lds; };

__device__ __forceinline__ void tr_item(const float* W, int ldw, int k0, int nsrc0, bf16_t* WT, int ldt, int drow0, LAS float* scr, int lane) {
#pragma unroll 8
    for (int i = 0; i < 32; ++i) { const int kk = 2 * i + (lane >> 5); scr[kk * 33 + (lane & 31)] = W[(size_t)(k0 + kk) * ldw + nsrc0 + (lane & 31)]; }
    asm volatile("s_waitcnt lgkmcnt(0)" ::: "memory");
    const int c = lane & 7;
#pragma unroll
    for (int j = 0; j < 4; ++j) { const int n = (lane >> 3) + 8 * j; const LAS float* s = scr + (8 * c) * 33 + n;
        u32x4 o; o.x = cvt_pk_bf16(s[0 * 33], s[1 * 33]); o.y = cvt_pk_bf16(s[2 * 33], s[3 * 33]); o.z = cvt_pk_bf16(s[4 * 33], s[5 * 33]); o.w = cvt_pk_bf16(s[6 * 33], s[7 * 33]);
        *(u32x4*)(WT + (size_t)(drow0 + n) * ldt + k0 + 8 * c) = o; }
    asm volatile("s_waitcnt lgkmcnt(0)" ::: "memory");
}
__device__ __forceinline__ void tr_job(const Ctx& C, const float* W, int K, int ldw, int ncol0, int ncols, bf16_t* WT, int ldt, int drow0, int grp, int grp_stride) {
    LAS float* scr = (LAS float*)(C.lds + C.wave * 16384);
    const int nblk = ncols / 32, items = (K / 64) * nblk;
    for (int it = C.gw; it < items; it += C.NGW) {
        const int kb = it / nblk, n = (it % nblk) * 32; const int drow = drow0 + (n / grp) * grp_stride + (n % grp);
        tr_item(W, ldw, kb * 64, ncol0 + n, WT, ldt, drow, scr, C.lane);
    }
}
__device__ __forceinline__ void cvt_job(const Ctx& C, const float* X, bf16_t* O, size_t n8) {
    for (size_t i = C.gtid; i < n8; i += C.NT) { const f32x4 a = *(const f32x4*)(X + i * 8), b = *(const f32x4*)(X + i * 8 + 4); *(u32x4*)(O + i * 8) = pack8(a, b); }
}

template <bool OUT_BF16>
__device__ __forceinline__ void ln_rows(const Ctx& C, const float* P, const float* gam, const float* bet, void* outp) {
    for (int r = C.gw; r < T; r += C.NGW) {
        const f32x4* xr = (const f32x4*)(P + (size_t)r * D) + C.lane;
        f32x4 v[8]; float s = 0.f;
#pragma unroll
        for (int j = 0; j < 8; ++j) { v[j] = xr[64 * j]; s += (v[j][0] + v[j][1]) + (v[j][2] + v[j][3]); }
#pragma unroll
        for (int o = 1; o < 64; o <<= 1) s += __shfl_xor(s, o);
        const float mean = s * (1.f / D); float s2 = 0.f;
#pragma unroll
        for (int j = 0; j < 8; ++j) { v[j] = v[j] - mean; s2 += (v[j][0] * v[j][0] + v[j][1] * v[j][1]) + (v[j][2] * v[j][2] + v[j][3] * v[j][3]); }
#pragma unroll
        for (int o = 1; o < 64; o <<= 1) s2 += __shfl_xor(s2, o);
        const float rstd = 1.f / sqrtf(s2 * (1.f / D) + LN_EPS);
#pragma unroll
        for (int j = 0; j < 8; ++j) {
            const f32x4 gg = *((const f32x4*)gam + C.lane + 64 * j), bb = *((const f32x4*)bet + C.lane + 64 * j);
            const f32x4 y = v[j] * rstd * gg + bb;
            if (OUT_BF16) { u32x2 w; w.x = cvt_pk_bf16(y[0], y[1]); w.y = cvt_pk_bf16(y[2], y[3]); *((u32x2*)((bf16_t*)outp + (size_t)r * D) + C.lane + 64 * j) = w; }
            else *((f32x4*)((float*)outp + (size_t)r * D) + C.lane + 64 * j) = y;
        }
    }
}

constexpr float SC_LOG2E = 0.08838834764831845f * 1.4426950408889634f;
__device__ __forceinline__ int rel_bucket(int n) {
    const int e = 31 - __builtin_clz((unsigned)(n | 1));
    const int odd = ((unsigned)n * (unsigned)n >= (1u << (2 * e + 1))) ? 1 : 0;
    const int lg = min(31, 8 + 2 * e + odd);
    return n < 16 ? n : lg;
}
template <int MODE>
__device__ __forceinline__ void att_step(const bf16_t* __restrict__ Kp, const bf16_t* __restrict__ VTp, int ldv, int key0, int tq, bool colok,
                                         const bf16x8 (&qf)[4], float& m, float& lsum, f32x4 (&O)[8], float inv_l,
                                         const LAS float* tab, int hd16, LAS float* impq, int g, int fr) {
    const bf16_t* kpa = Kp + (size_t)(key0 + 8 * (fr >> 2) + (fr & 3)) * HD + 8 * g;
    bf16x8 ka[4], kb[4];
#pragma unroll
    for (int dc = 0; dc < 4; ++dc) { ka[dc] = *(const bf16x8*)(kpa + dc * 32); kb[dc] = *(const bf16x8*)(kpa + 4 * HD + dc * 32); }
    bf16x8 vf[8];
    if (MODE != 0) { const bf16_t* vp = VTp + (size_t)fr * ldv + key0 + 8 * g;
#pragma unroll
        for (int dt = 0; dt < 8; ++dt) vf[dt] = *(const bf16x8*)(vp + (size_t)dt * 16 * ldv); }
    f32x4 sa = {0.f, 0.f, 0.f, 0.f}, sb = {0.f, 0.f, 0.f, 0.f};
#pragma unroll
    for (int dc = 0; dc < 4; ++dc) { sa = __builtin_amdgcn_mfma_f32_16x16x32_bf16(ka[dc], qf[dc], sa, 0, 0, 0); sb = __builtin_amdgcn_mfma_f32_16x16x32_bf16(kb[dc], qf[dc], sb, 0, 0, 0); }
    float s[8]; bool ok[8];
#pragma unroll
    for (int e = 0; e < 8; ++e) {
        const int idx = key0 + 8 * g + e;
        const int dist = (MODE < 2) ? (tq - 31 - 16 * idx) : (tq - idx);
        ok[e] = (MODE < 2) ? (dist >= 0) : (MODE == 2 ? (dist >= 0 && dist < 512) : (dist >= 0 && colok));
        const int bk = rel_bucket(max(dist, 0));
        const float sv = (e < 4 ? sa[e & 3] : sb[e & 3]) * SC_LOG2E + tab[bk * 16 + hd16];
        s[e] = ok[e] ? sv : -1e30f;
    }
    float p[8];
    if (MODE != 1) {
        float mx = fmaxf(fmaxf(fmaxf(s[0], s[1]), fmaxf(s[2], s[3])), fmaxf(fmaxf(s[4], s[5]), fmaxf(s[6], s[7])));
        mx = fmaxf(mx, __shfl_xor(mx, 16)); mx = fmaxf(mx, __shfl_xor(mx, 32));
        const float mn = fmaxf(m, mx); const float alpha = __builtin_amdgcn_exp2f(m - mn); m = mn;
        float ps = 0.f;
#pragma unroll
        for (int e = 0; e < 8; ++e) { p[e] = ok[e] ? __builtin_amdgcn_exp2f(s[e] - mn) : 0.f; ps += p[e]; }
        lsum = lsum * alpha + ps;
        if (MODE != 0) {
#pragma unroll
            for (int dt = 0; dt < 8; ++dt) O[dt] = O[dt] * alpha;
        }
    } else {
#pragma unroll
        for (int e = 0; e < 8; ++e) p[e] = ok[e] ? __builtin_amdgcn_exp2f(s[e] - m) * inv_l : 0.f;
        const int G2 = (key0 >> 2) + 2 * g;
        atomicAdd((float*)(impq + G2), (p[0] + p[1]) + (p[2] + p[3]));
        atomicAdd((float*)(impq + G2 + 1), (p[3] + p[4]) + (p[5] + p[6]) + p[7]);
        atomicAdd((float*)(impq + G2 + 2), p[7]);
    }
    if (MODE != 0) {
        u32x4 pw; pw.x = cvt_pk_bf16(p[0], p[1]); pw.y = cvt_pk_bf16(p[2], p[3]); pw.z = cvt_pk_bf16(p[4], p[5]); pw.w = cvt_pk_bf16(p[6], p[7]);
        const bf16x8 pf = __builtin_bit_cast(bf16x8, pw);
#pragma unroll
        for (int dt = 0; dt < 8; ++dt) O[dt] = __builtin_amdgcn_mfma_f32_16x16x32_bf16(vf[dt], pf, O[dt], 0, 0, 0);
    }
}

constexpr int IMP_STRIDE = 264;
__device__ __forceinline__ void attention_phase(const Ctx& C, bf16_t* qo, const bf16_t* kc, const bf16_t* vcT, const bf16_t* ks, const bf16_t* vsT,
                                                const bf16_t* kw, const bf16_t* vwT, const float* gates, const float* rel_bias) {
    LAS float* tab = (LAS float*)C.lds;
    LAS float* imp = (LAS float*)(C.lds + 4096 + C.wave * 8192);
    LAS int* lst = (LAS int*)(C.lds + 4096 + C.wave * 8192 + 4 * IMP_STRIDE * 4);
    for (int i = C.tid; i < 512; i += NWAVES * 64) tab[i] = rel_bias[i] * 1.4426950408889634f;
    __syncthreads();
    const int lane = C.lane, fr = lane & 15, g = lane >> 4, qi = fr >> 2, hd = fr & 3;
    const int hk = (int)(blockIdx.x & 3), wl = (int)(blockIdx.x >> 2) * NWAVES + C.wave, nwl = C.NGW >> 2;
    for (int qg = wl; qg < T / 4; qg += nwl) {
        const int t0 = qg * 4, tq = t0 + qi, head = hk * 4 + hd, jt = t0 >> 6;
        bf16x8 qf[4];
        { const bf16_t* qp = qo + (size_t)tq * D + head * HD + 8 * g;
#pragma unroll
          for (int dc = 0; dc < 4; ++dc) qf[dc] = *(const bf16x8*)(qp + dc * 32); }
        const float g0 = gates[(size_t)tq * 48 + head * 3 + 0], g1 = gates[(size_t)tq * 48 + head * 3 + 1], g2 = gates[(size_t)tq * 48 + head * 3 + 2];
        f32x4 OA[8];
#pragma unroll
        for (int dt = 0; dt < 8; ++dt) OA[dt] = (f32x4){0.f, 0.f, 0.f, 0.f};
        f32x4 O[8];
        for (int i = lane; i < 4 * IMP_STRIDE; i += 64) imp[i] = 0.f;
        __builtin_amdgcn_wave_barrier(); asm volatile("s_waitcnt lgkmcnt(0)" ::: "memory");
        const bf16_t* Kc = kc + (size_t)hk * NCMP * HD; const bf16_t* Vc = vcT + (size_t)hk * HD * NCMP;
        const int ncv = (t0 + 3 >= 31) ? ((t0 + 3 - 31) >> 4) + 1 : 0;
        const int nst = (ncv + 31) >> 5;
        {
            float m = -1e30f, lsum = 0.f;
            for (int st = 0; st < nst; ++st) att_step<0>(Kc, Vc, NCMP, st * 32, tq, true, qf, m, lsum, O, 0.f, tab, hd + 0 * 16 + (hk * 4), imp + qi * IMP_STRIDE, g, fr);
            float l = lsum; l += __shfl_xor(l, 16); l += __shfl_xor(l, 32);
            const float inv = l > 0.f ? 1.f / l : 0.f;
#pragma unroll
            for (int dt = 0; dt < 8; ++dt) O[dt] = (f32x4){0.f, 0.f, 0.f, 0.f};
            for (int st = 0; st < nst; ++st) att_step<1>(Kc, Vc, NCMP, st * 32, tq, true, qf, m, lsum, O, inv, tab, hd + hk * 4, imp + qi * IMP_STRIDE, g, fr);
#pragma unroll
            for (int dt = 0; dt < 8; ++dt) OA[dt] = OA[dt] + O[dt] * g0;
        }
        __builtin_amdgcn_wave_barrier(); asm volatile("s_waitcnt lgkmcnt(0)" ::: "memory");
        int nlist = 0;
        const int ncand = jt - 2;
        if (ncand <= 13) {
            if (lane <= jt) lst[lane] = lane | (0xF << 16);
            nlist = jt + 1;
        } else {
            if (lane == 0) { lst[0] = 0 | (0xF << 16); lst[1] = (jt - 1) | (0xF << 16); lst[2] = jt | (0xF << 16); }
            nlist = 3;
            for (int qq = 0; qq < 4; ++qq) {
                float v[4];
#pragma unroll
                for (int k = 0; k < 4; ++k) { const int sblk = 4 * lane + k; const float x = imp[qq * IMP_STRIDE + sblk]; v[k] = (sblk >= 1 && sblk <= jt - 2) ? x : -1.f; }
                for (int r = 0; r < 13; ++r) {
                    float lm = fmaxf(fmaxf(v[0], v[1]), fmaxf(v[2], v[3]));
                    float wm = lm;
#pragma unroll
                    for (int o = 1; o < 64; o <<= 1) wm = fmaxf(wm, __shfl_xor(wm, o));
                    const unsigned long long bal = __ballot(lm == wm);
                    const int src = __ffsll((long long)bal) - 1;
                    if (lane == src) {
                        int k = (v[0] == wm) ? 0 : (v[1] == wm) ? 1 : (v[2] == wm) ? 2 : 3;
                        if (k == 0) v[0] = -2.f; else if (k == 1) v[1] = -2.f; else if (k == 2) v[2] = -2.f; else v[3] = -2.f;
                        lst[nlist + r] = (4 * lane + k) | ((1 << qq) << 16);
                    }
                }
                nlist += 13;
            }
        }
        __builtin_amdgcn_wave_barrier(); asm volatile("s_waitcnt lgkmcnt(0)" ::: "memory");
        {
            const bf16_t* Ks = ks + (size_t)hk * T * HD; const bf16_t* Vs = vsT + ((size_t)hk * 256 * 128 << 6);
            float m = -1e30f, lsum = 0.f;
#pragma unroll
            for (int dt = 0; dt < 8; ++dt) O[dt] = (f32x4){0.f, 0.f, 0.f, 0.f};
            for (int i = 0; i < nlist; ++i) {
                const int ent = __builtin_amdgcn_readfirstlane(lst[i]);
                const int blk = ent & 0xffff; const bool colok = ((ent >> (16 + qi)) & 1) != 0;
                const bf16_t* Vb = Vs + ((size_t)blk * 128 << 6) - blk * 64;
                att_step<3>(Ks, Vb, 64, blk * 64, tq, colok, qf, m, lsum, O, 0.f, tab, hd + hk * 4, imp, g, fr);
                att_step<3>(Ks, Vb, 64, blk * 64 + 32, tq, colok, qf, m, lsum, O, 0.f, tab, hd + hk * 4, imp, g, fr);
            }
            float l = lsum; l += __shfl_xor(l, 16); l += __shfl_xor(l, 32);
            const float sc = (l > 0.f ? 1.f / l : 0.f) * g1;
#pragma unroll
            for (int dt = 0; dt < 8; ++dt) OA[dt] = OA[dt] + O[dt] * sc;
        }
        {
            const bf16_t* Kw = kw + (size_t)hk * T * HD; const bf16_t* Vw = vwT + (size_t)hk * HD * T;
            float m = -1e30f, lsum = 0.f;
#pragma unroll
            for (int dt = 0; dt < 8; ++dt) O[dt] = (f32x4){0.f, 0.f, 0.f, 0.f};
            const int kstart = max(0, t0 - 511) & ~31;
            for (int k0 = kstart; k0 <= t0 + 3; k0 += 32) att_step<2>(Kw, Vw, T, k0, tq, true, qf, m, lsum, O, 0.f, tab, hd + hk * 4, imp, g, fr);
            float l = lsum; l += __shfl_xor(l, 16); l += __shfl_xor(l, 32);
            const float sc = (l > 0.f ? 1.f / l : 0.f) * g2;
#pragma unroll
            for (int dt = 0; dt < 8; ++dt) OA[dt] = OA[dt] + O[dt] * sc;
        }
        { bf16_t* op = qo + (size_t)tq * D + head * HD + 4 * g;
#pragma unroll
          for (int dt = 0; dt < 8; ++dt) { u32x2 w; w.x = cvt_pk_bf16(OA[dt][0], OA[dt][1]); w.y = cvt_pk_bf16(OA[dt][2], OA[dt][3]); *(u32x2*)(op + dt * 16) = w; } }
        __builtin_amdgcn_wave_barrier(); asm volatile("s_waitcnt lgkmcnt(0)" ::: "memory");
    }
}

__global__ void __launch_bounds__(NWAVES * 64, 2) fwd_megakernel(Args args) {
    extern __shared__ __attribute__((aligned(16))) unsigned char lds_raw[];
    __builtin_assume(__builtin_amdgcn_workitem_id_y() == 0); __builtin_assume(__builtin_amdgcn_workitem_id_z() == 0);
    cg::grid_group grid = cg::this_grid();
    Ctx C; C.lds = (LAS unsigned char*)lds_raw; C.tid = threadIdx.x; C.lane = C.tid & 63; C.wave = __builtin_amdgcn_readfirstlane(C.tid >> 6);
    const int G = args.G, bx = blockIdx.x;
    C.gw = bx * NWAVES + C.wave; C.NGW = G * NWAVES; C.gtid = bx * (NWAVES * 64) + C.tid; C.NT = G * NWAVES * 64;
    unsigned char* ws = args.ws;
#define x_in (args.in[0])
#define pin (args.in[1])
#define w_in (args.in[2])
#define conv_w (args.in[3])
#define pe_k (args.in[4])
#define w1_k (args.in[5])
#define w2_k (args.in[6])
#define pe_v (args.in[7])
#define w1_v (args.in[8])
#define w2_v (args.in[9])
#define w_conv_out (args.in[10])
#define w_attn_out (args.in[11])
#define w_mix_out (args.in[12])
#define ln1_g (args.in[13])
#define ln1_b (args.in[14])
#define w_up (args.in[15])
#define w_down (args.in[16])
#define w_ple (args.in[17])
#define w_ple_gate (args.in[18])
#define ln2_g (args.in[19])
#define ln2_b (args.in[20])
#define rel_bias (args.in[21])
#define BP(off) ((bf16_t*)(ws + (off)))
#define FP(off) ((float*)(ws + (off)))
#define XB BP(WS_XB)
#define WTIN BP(WS_WTIN)
#define WTVT BP(WS_WTVT)
#define WTMB BP(WS_WTMB)
#define W1K BP(WS_W1K)
#define W1V BP(WS_W1V)
#define BIASK FP(WS_BIASK)
#define BIASV FP(WS_BIASV)
#define HIDK BP(WS_HIDK)
#define HIDV BP(WS_HIDV)
#define KC BP(WS_KC)
#define VCT BP(WS_VCT)
#define GATES FP(WS_GATES)
#define BG BP(WS_BG)
#define ZZ BP(WS_ZZ)
#define Q BP(WS_Q)
#define KCS BP(WS_KCS)
#define VCS BP(WS_VCS)
#define KS BP(WS_KS)
#define KW BP(WS_KW)
#define VST BP(WS_VST)
#define VWT BP(WS_VWT)
#define SMA BP(WS_SMA)
#define SMB BP(WS_SMB)
#define WTCONV BP(WS_WTCONV)
#define WTATTN BP(WS_WTATTN)
#define WTMIX BP(WS_WTMIX)
#define WTGATE BP(WS_WTGATE)
#define WTPLE BP(WS_WTPLE)
#define PB BP(WS_PB)
#define WTUP BP(WS_WTUP)
#define WTDOWN BP(WS_WTDOWN)
#define PRE1 FP(WS_PRE1)
#define PRE2 FP(WS_PRE2)
#define X1B BP(WS_X1B)
#define H1 BP(WS_H1)
    const int lo = args.ph_lo, hi = args.ph_hi;
    unsigned* gbar = (unsigned*)(ws + 16384); int nbar = 0;
    if (lo == 12345) grid.sync();
#ifndef PHMASK
#define PHMASK 0xFFFF
#endif
#define IN(k) (((PHMASK >> (k)) & 1) && lo <= (k) && (k) < hi)
#define SEAM(k) do { if (IN(k) && IN((k) + 1)) { ++nbar; \
        asm volatile("s_waitcnt vmcnt(0) lgkmcnt(0)" ::: "memory"); __syncthreads(); \
        if (C.tid == 0) { __builtin_amdgcn_fence(__ATOMIC_RELEASE, "agent"); asm volatile("s_waitcnt vmcnt(0)" ::: "memory"); \
            __hip_atomic_fetch_add(gbar, 1u, __ATOMIC_RELAXED, __HIP_MEMORY_SCOPE_AGENT); \
            while (__hip_atomic_load(gbar, __ATOMIC_RELAXED, __HIP_MEMORY_SCOPE_AGENT) < (unsigned)(nbar * G)) __builtin_amdgcn_s_sleep(2); \
            __builtin_amdgcn_fence(__ATOMIC_ACQUIRE, "agent"); asm volatile("s_waitcnt vmcnt(0)" ::: "memory"); } \
        __syncthreads(); \
        __builtin_amdgcn_fence(__ATOMIC_ACQUIRE, "agent"); asm volatile("s_waitcnt vmcnt(0)" ::: "memory"); } } while (0)

    if (IN(0)) {
        cvt_job(C, x_in, XB, (size_t)T * D / 8);
        tr_job(C, w_in, D, NIN, 2048, 2048, WTIN, D, 0, 128, 256);
        tr_job(C, w_in, D, NIN, 4096, 2048, WTIN, D, 128, 128, 256);
        tr_job(C, w_in, D, NIN, 0, 2048, WTIN, D, 4096, 2048, 0);
        tr_job(C, w_in, D, NIN, 6144, 2048, WTIN, D, 6144, 2048, 0);
        tr_job(C, w_in, D, NIN, 8192, 512, WTIN, D, 8192, 512, 0);
        tr_job(C, w_in, D, NIN, 8704, 512, WTIN, D, 8704, 512, 0);
        tr_job(C, w_in, D, NIN, 9216, 512, WTIN, D, 9216, 512, 0);
        tr_job(C, w_in, D, NIN, 10240, 512, WTIN, D, 9728, 512, 0);
        tr_job(C, w_in, D, NIN, 11312, 2048, WTIN, D, 10240, 2048, 0);
        tr_job(C, w_in, D, NIN, 9728, 512, WTVT, D, 0, 512, 0);
        tr_job(C, w_in, D, NIN, 10752, 512, WTVT, D, 512, 512, 0);
        tr_job(C, w_in, D, NIN, 13360, 2048, WTMB, D, 0, 2048, 0);
        tr_job(C, w1_k, 4096, 256, 0, 256, W1K, 4096, 0, 256, 0);
        tr_job(C, w1_v, 4096, 256, 0, 256, W1V, 4096, 0, 256, 0);
        for (int i = C.gtid; i < 256 * D; i += C.NT) { const int r = i / D, k = i % D; const float v = (r < 48) ? w_in[(size_t)k * NIN + 11264 + r] : 0.f; WTIN[(size_t)(12288 + r) * D + k] = (bf16_t)(cvt_pk_bf16(v, 0.f) & 0xffff); }
        if (bx == G - 1) {
            const int n = C.tid & 255; const float* pe = (C.tid < 256) ? pe_k : pe_v; const float* w1 = (C.tid < 256) ? w1_k : w1_v; float s = 0.f;
            for (int j = 0; j < 4096; ++j) s += pe[j] * w1[(size_t)j * 256 + n];
            ((C.tid < 256) ? BIASK : BIASV)[n] = s;
        }
        asm volatile("s_waitcnt vmcnt(0) lgkmcnt(0)" ::: "memory"); __syncthreads();
    }
    SEAM(0);
    if (IN(1)) {
        { pg8::Gemm g{XB, WTIN, T, 12544, D, D, D}; pg8::StaticOrder S; S.init(T, 12544, G, bx);
          EpiInProj E{ZZ, BG, Q, KCS, SMA, GATES};
          pg8::gemm_phase(C.lds, g, S, E); }
        { pg8::Gemm g{WTVT, XB, 1024, T, D, D, D}; pg8::StaticOrder S; S.init(1024, T, G, (bx + 64) % G);
          pg8::EpiGen<FStoreVT> E{{VST}};
          pg8::gemm_phase(C.lds, g, S, E); }
    }
    SEAM(1);
    if (IN(2)) {
        if (bx < 32) {
            { pg8::Gemm g{KCS, W1K, 4096, 256, 4096, 2048, 4096}; pg8::StaticOrder S; S.init(4096, 256, G, bx < 16 ? bx : -1); S.G = 16;
              pg8::EpiGen<FGeluBias> E{{HIDK, 256, BIASK}}; pg8::gemm_phase(C.lds, g, S, E); }
            { pg8::Gemm g{VCS, W1V, 4096, 256, 4096, 2048, 4096}; pg8::StaticOrder S; S.init(4096, 256, G, (bx >= 16 && bx < 32) ? bx - 16 : -1); S.G = 16;
              pg8::EpiGen<FGeluBias> E{{HIDV, 256, BIASV}}; pg8::gemm_phase(C.lds, g, S, E); }
        } else
        for (size_t i = (size_t)(bx - 32) * (NWAVES * 64) + C.tid; i < (size_t)T * D / 8; i += (size_t)(G - 32) * (NWAVES * 64)) {
            const int t = (int)(i / (D / 8)), c8 = (int)(i % (D / 8)) * 8;
            f32x4 z0a, z0b, z1a = {0.f, 0.f, 0.f, 0.f}, z1b = z1a, z2a = z1a, z2b = z1a, ba, bb;
            unpack8(*(const u32x4*)(ZZ + (size_t)t * D + c8), z0a, z0b);
            if (t >= 1) unpack8(*(const u32x4*)(ZZ + (size_t)(t - 1) * D + c8), z1a, z1b);
            if (t >= 2) unpack8(*(const u32x4*)(ZZ + (size_t)(t - 2) * D + c8), z2a, z2b);
            unpack8(*(const u32x4*)(BG + (size_t)t * D + c8), ba, bb);
            const f32x4 w0a = *(const f32x4*)(conv_w + c8), w0b = *(const f32x4*)(conv_w + c8 + 4);
            const f32x4 w1a = *(const f32x4*)(conv_w + D + c8), w1b = *(const f32x4*)(conv_w + D + c8 + 4);
            const f32x4 w2a = *(const f32x4*)(conv_w + 2 * D + c8), w2b = *(const f32x4*)(conv_w + 2 * D + c8 + 4);
            const f32x4 ua = ba * (w0a * z2a + w1a * z1a + w2a * z0a), ub = bb * (w0b * z2b + w1b * z1b + w2b * z0b);
            *(u32x4*)(BG + (size_t)t * D + c8) = pack8(ua, ub);
        }
    }
    SEAM(2);
    if (IN(3)) {
        { pg8::Gemm g{XB, WTMB, T, D, D, D, D}; pg8::StaticOrder S; S.init(T, D, G, bx);
          pg8::EpiGen<FStoreBf16> E{{SMB, D, 1}}; pg8::gemm_phase(C.lds, g, S, E); }
    }
    SEAM(3);
    if (IN(4)) {
        for (int i = C.gtid; i < 4096 * HD; i += C.NT) {
            const int d = i & 127, row = i >> 7; const bf16_t* hp = HIDK + (size_t)row * 256; float s = 0.f;
            for (int j = 0; j < 256; j += 2) { const unsigned w = *(const unsigned*)(hp + j); s += bf_lo(w) * w2_k[(size_t)j * HD + d] + bf_hi(w) * w2_k[(size_t)(j + 1) * HD + d]; }
            KC[i] = (bf16_t)(cvt_pk_bf16(s, 0.f) & 0xffff);
        }
        for (int i = C.gtid; i < 4096 * HD; i += C.NT) {
            const int ii = i & 1023, d = (i >> 10) & 127, h = i >> 17; const bf16_t* hp = HIDV + (size_t)(h * 1024 + ii) * 256; float s = 0.f;
            for (int j = 0; j < 256; j += 2) { const unsigned w = *(const unsigned*)(hp + j); s += bf_lo(w) * w2_v[(size_t)j * HD + d] + bf_hi(w) * w2_v[(size_t)(j + 1) * HD + d]; }
            VCT[i] = (bf16_t)(cvt_pk_bf16(s, 0.f) & 0xffff);
        }
        tr_job(C, w_conv_out, D, D, 0, D, WTCONV, D, 0, D, 0);
        tr_job(C, w_attn_out, D, D, 0, D, WTATTN, D, 0, D, 0);
        tr_job(C, w_mix_out, D, D, 0, D, WTMIX, D, 0, D, 0);
        tr_job(C, w_ple_gate, D, D, 0, D, WTGATE, D, 0, D, 0);
        tr_job(C, w_ple, PLE, D, 0, D, WTPLE, PLE, 0, D, 0);
        tr_job(C, w_up, D, FF, 0, FF, WTUP, D, 0, FF, 0);
        tr_job(C, w_down, FF, D, 0, D, WTDOWN, FF, 0, D, 0);
        cvt_job(C, pin, PB, (size_t)T * PLE / 8);
        asm volatile("s_waitcnt vmcnt(0) lgkmcnt(0)" ::: "memory"); __syncthreads();
    }
    SEAM(4);
    if (IN(5)) {
        attention_phase(C, Q, KC, VCT, KS, VST, KW, VWT, GATES, rel_bias);
        asm volatile("s_waitcnt vmcnt(0) lgkmcnt(0)" ::: "memory"); __syncthreads();
    }
    SEAM(5);
    if (IN(6)) { pg8::Gemm g{BG, WTCONV, T, D, D, D, D}; pg8::StaticOrder S; S.init(T, D, G, bx); pg8::EpiGen<FMulInplace> E{{SMA, D}}; pg8::gemm_phase(C.lds, g, S, E); }
    SEAM(6);
    if (IN(7)) { pg8::Gemm g{Q, WTATTN, T, D, D, D, D}; pg8::StaticOrder S; S.init(T, D, G, bx); pg8::EpiGen<FMulAddInplace> E{{SMB, SMA, D}}; pg8::gemm_phase(C.lds, g, S, E); }
    SEAM(7);
    if (IN(8)) { pg8::Gemm g{SMB, WTMIX, T, D, D, D, D}; pg8::StaticOrder S; S.init(T, D, G, bx); pg8::EpiGen<FResidF32> E{{PRE1, x_in, D}}; pg8::gemm_phase(C.lds, g, S, E); }
    SEAM(8);
    if (IN(9)) ln_rows<true>(C, PRE1, ln1_g, ln1_b, X1B);
    SEAM(9);
    if (IN(10)) {
        { pg8::Gemm g{X1B, WTGATE, T, D, D, D, D}; pg8::StaticOrder S; S.init(T, D, G, bx); pg8::EpiGen<FSigmoidF32> E{{PRE2, D}}; pg8::gemm_phase(C.lds, g, S, E); }
        { pg8::Gemm g{X1B, WTUP, T / 2, FF, D, D, D}; pg8::StaticOrder S; S.init(T / 2, FF, G, bx); pg8::EpiGen<FStoreBf16> E{{H1, FF, 2}}; pg8::gemm_phase(C.lds, g, S, E); }
    }
    SEAM(10);
    if (IN(11)) { pg8::Gemm g{PB, WTPLE, T, D, PLE, PLE, PLE}; pg8::StaticOrder S; S.init(T, D, G, bx); pg8::EpiGen<FPle> E{{PRE2, X1B, D}}; pg8::gemm_phase(C.lds, g, S, E); }
    SEAM(11);
    if (IN(12)) { pg8::Gemm g{H1, WTDOWN, T / 2, D, FF, FF, FF}; pg8::StaticOrder S; S.init(T / 2, D, G, bx); pg8::EpiGen<FAccF32> E{{PRE2, D}}; pg8::gemm_phase(C.lds, g, S, E); }
    SEAM(12);
    if (IN(13)) { pg8::Gemm g{X1B + (size_t)(T / 2) * D, WTUP, T / 2, FF, D, D, D}; pg8::StaticOrder S; S.init(T / 2, FF, G, bx); pg8::EpiGen<FStoreBf16> E{{H1, FF, 2}}; pg8::gemm_phase(C.lds, g, S, E); }
    SEAM(13);
    if (IN(14)) { pg8::Gemm g{H1, WTDOWN, T / 2, D, FF, FF, FF}; pg8::StaticOrder S; S.init(T / 2, D, G, bx); pg8::EpiGen<FAccF32> E{{PRE2 + (size_t)(T / 2) * D, D}}; pg8::gemm_phase(C.lds, g, S, E); }
    SEAM(14);
    if (IN(15)) ln_rows<false>(C, PRE2, ln2_g, ln2_b, args.out);
#undef IN
#undef SEAM
}

extern "C" void kernel_launch(void* const* d_in, const int* in_sizes, int n_in, void* d_out, int out_size, void* d_ws, size_t ws_size, hipStream_t stream) {
    static int grid = 0;
    if (grid == 0) {
        if (n_in != 22 || ws_size < WS_END) { fprintf(stderr, "kernel_launch: need 22 inputs and >= %zu bytes of workspace (got %d, %zu)\n", (size_t)WS_END, n_in, ws_size); grid = -1; return; }
        int dev = 0, cus = 0, per_cu = 0;
        hipGetDevice(&dev); hipDeviceGetAttribute(&cus, hipDeviceAttributeMultiprocessorCount, dev);
        if (hipFuncSetAttribute((const void*)fwd_megakernel, hipFuncAttributeMaxDynamicSharedMemorySize, LDS_BYTES) != hipSuccess) { fprintf(stderr, "kernel_launch: hipFuncSetAttribute failed\n"); grid = -1; return; }
        if (hipOccupancyMaxActiveBlocksPerMultiprocessor(&per_cu, (const void*)fwd_megakernel, NWAVES * 64, LDS_BYTES) != hipSuccess || per_cu < 1) { fprintf(stderr, "kernel_launch: occupancy query says %d\n", per_cu); per_cu = 1; }
        (void)hipGetLastError();
        grid = cus * 1;
    }
    if (grid < 0) return;
    Args a{};
    for (int i = 0; i < 22; ++i) a.in[i] = (const float*)d_in[i];
    a.out = (float*)d_out; a.ws = (unsigned char*)d_ws; a.G = grid; a.pad = 0;
#if MK_PER_PHASE
    for (int ph = 0; ph < 16; ++ph) { a.ph_lo = ph; a.ph_hi = ph + 1; void* kargs[] = {&a};
        hipError_t e = hipLaunchCooperativeKernel((const void*)fwd_megakernel, dim3(grid), dim3(NWAVES * 64), kargs, LDS_BYTES, stream);
        if (e != hipSuccess) { fprintf(stderr, "kernel_launch: launch failed: %s\n", hipGetErrorString(e)); break; } }
#else
    (void)hipMemsetAsync((char*)d_ws + 16384, 0, 256, stream);
    a.ph_lo = 0; a.ph_hi = 16; void* kargs[] = {&a};
    hipError_t e = hipLaunchCooperativeKernel((const void*)fwd_megakernel, dim3(grid), dim3(NWAVES * 64), kargs, LDS_BYTES, stream);
    if (e != hipSuccess) fprintf(stderr, "kernel_launch: cooperative launch failed: %s (grid %d)\n", hipGetErrorString(e), grid);
#endif
}
```

```cpp
#include <hip/hip_runtime.h>
#include <hip/hip_cooperative_groups.h>
#include <cstdio>
#include <cstdint>
namespace cg = cooperative_groups;

#define LAS __attribute__((address_space(3)))
typedef unsigned short bf16_t;
typedef short bf16x8 __attribute__((ext_vector_type(8)));
typedef float f32x4 __attribute__((ext_vector_type(4)));
typedef float f32x2 __attribute__((ext_vector_type(2)));
typedef unsigned u32x4 __attribute__((ext_vector_type(4)));
typedef unsigned u32x2 __attribute__((ext_vector_type(2)));

#ifndef MK_PER_PHASE
#define MK_PER_PHASE 0
#endif

constexpr int T = 16384, D = 2048, NIN = 15408, FF = 8192, PLE = 256, HK = 4, HD = 128, NCMP = 1024;
constexpr float DN_ALPHA = 1.189207115002721f;
constexpr float LN_EPS = 1e-5f;
constexpr int NWAVES = 8;
constexpr int LDS_BYTES = 147456;

constexpr size_t MiB = 1u << 20;
constexpr size_t WS_BIASK = 0, WS_BIASV = 4096;
constexpr size_t WS_XB = 1 * MiB;
constexpr size_t WS_WTUP = 1 * MiB, WS_WTDOWN = 33 * MiB;
constexpr size_t WS_WTIN = 65 * MiB;
constexpr size_t WS_WTVT = 114 * MiB;
constexpr size_t WS_WTMB = 118 * MiB;
constexpr size_t WS_WTCONV = 65 * MiB, WS_WTATTN = 73 * MiB, WS_WTMIX = 81 * MiB, WS_WTGATE = 89 * MiB, WS_WTPLE = 97 * MiB, WS_PB = 98 * MiB;
constexpr size_t WS_W1K = 126 * MiB, WS_W1V = 128 * MiB;
constexpr size_t WS_HIDK = 130 * MiB, WS_HIDV = 132 * MiB;
constexpr size_t WS_KC = 134 * MiB, WS_VCT = 135 * MiB;
constexpr size_t WS_GATES = 136 * MiB;
constexpr size_t WS_BG = 140 * MiB;
constexpr size_t WS_X1B = 140 * MiB;
constexpr size_t WS_ZZ = 204 * MiB;
constexpr size_t WS_SMB = 204 * MiB, WS_H1 = 204 * MiB;
constexpr size_t WS_Q = 268 * MiB;
constexpr size_t WS_KCS = 332 * MiB, WS_VCS = 348 * MiB, WS_KS = 364 * MiB, WS_KW = 380 * MiB, WS_VST = 396 * MiB, WS_VWT = 412 * MiB;
constexpr size_t WS_SMA = 428 * MiB;
constexpr size_t WS_PRE1 = 300 * MiB, WS_PRE2 = 364 * MiB;
constexpr size_t WS_END = 492 * MiB;

typedef __bf16 bf16x2_t __attribute__((ext_vector_type(2)));
__device__ __forceinline__ unsigned cvt_pk_bf16(float lo, float hi) { f32x2 v = {lo, hi}; bf16x2_t b = __builtin_convertvector(v, bf16x2_t); return __builtin_bit_cast(unsigned, b); }
__device__ __forceinline__ float bf_lo(unsigned w) { return __uint_as_float(w << 16); }
__device__ __forceinline__ float bf_hi(unsigned w) { return __uint_as_float(w & 0xffff0000u); }
__device__ __forceinline__ float fast_sigmoid(float x) { return __builtin_amdgcn_rcpf(1.f + __expf(-x)); }
__device__ __forceinline__ u32x4 pack8(const f32x4& a, const f32x4& b) { u32x4 w; w.x = cvt_pk_bf16(a[0], a[1]); w.y = cvt_pk_bf16(a[2], a[3]); w.z = cvt_pk_bf16(b[0], b[1]); w.w = cvt_pk_bf16(b[2], b[3]); return w; }
__device__ __forceinline__ void unpack8(const u32x4& w, f32x4& a, f32x4& b) { a[0] = bf_lo(w.x); a[1] = bf_hi(w.x); a[2] = bf_lo(w.y); a[3] = bf_hi(w.y); b[0] = bf_lo(w.z); b[1] = bf_hi(w.z); b[2] = bf_lo(w.w); b[3] = bf_hi(w.w); }

namespace pg8 {
constexpr int BM = 256, BK = 64, HALF = 128, HTB = HALF * BK * 2, STAGE_BYTES = 8 * HTB, NXCD = 8, WGM = 8;
__host__ __device__ __forceinline__ int lds_byte(int r, int c) { const int st = (r >> 4) * 2 + (c >> 5), rr = r & 15, cc = c & 31, ob = rr * 64 + cc * 2; return st * 1024 + (ob ^ (((ob >> 9) & 1) << 5)); }
__host__ __device__ __forceinline__ void stage_rc(int b, int& R, int& C) { const int st = b / 1024, sb = b % 1024, swz = sb ^ (((sb >> 9) & 1) << 5); R = (st >> 1) * 16 + swz / 64; C = (st & 1) * 32 + (swz % 64) / 2; }
__host__ __device__ __forceinline__ int perm32(int rho) { const int n = rho >> 4, i = rho & 15; return 8 * (i >> 2) + 4 * n + (i & 3); }

struct Unit { int pm, pn; };
struct Gemm { const bf16_t* A; const bf16_t* Bt; int M, N, K, lda, ldb; };

struct StaticOrder {
    int nM, nN, nwg, G, c;
    __device__ void init(int M, int N, int G_, int c_) { nM = M / BM; nN = N / BM; nwg = nM * nN; G = G_; c = c_; }
    __device__ bool next(int i, Unit& u) const {
        const long L = (long)i * G + c; if (c < 0 || L >= nwg) return false;
        int wgid = (int)L; { const int q = nwg / NXCD, r = nwg % NXCD, xcd = wgid % NXCD, off = wgid / NXCD; wgid = (xcd < r ? xcd * (q + 1) : r * (q + 1) + (xcd - r) * q) + off; }
        const int nig = WGM * nN, gid = wgid / nig, fm = gid * WGM, gsz = (nM - fm) < WGM ? (nM - fm) : WGM;
        u.pm = fm + ((wgid % nig) % gsz); u.pn = (wgid % nig) / gsz; return true;
    }
};

template <class F> struct EpiGen {
    F f;
    __device__ __forceinline__ void operator()(const f32x4 (&acc)[2][2][4][2], const Unit& u, int wr, int wc, int fr, int fq) const {
        const int row0 = u.pm * BM + wr * 64 + fr, col0 = u.pn * BM + wc * 32 + 8 * fq;
#pragma unroll
        for (int ai = 0; ai < 2; ++ai)
#pragma unroll
            for (int m = 0; m < 4; ++m) {
                const int row = row0 + ai * HALF + m * 16;
#pragma unroll
                for (int bj = 0; bj < 2; ++bj) f(row, col0 + bj * HALF, acc[ai][bj][m][0], acc[ai][bj][m][1]);
            }
    }
};

template <class Epi, class Sched>
__device__ __forceinline__ void gemm_phase(LAS unsigned char* lds, const Gemm g, const Sched& S, const Epi& E) {
    const int tid = threadIdx.x, wid = __builtin_amdgcn_readfirstlane(tid >> 6), lane = tid & 63, wr = wid >> 2, wc = wid & 3, fr = lane & 15, fq = lane >> 4;
    const int K = g.K, nt = K / BK;
    unsigned voffA[2], voffB[2];
#pragma unroll
    for (int i = 0; i < 2; ++i) { int R, C; stage_rc(tid * 16 + i * 8192, R, C); const int Rb = (R & ~31) + perm32(R & 31);
        voffA[i] = (unsigned)(R * g.lda + C) * 2u; voffB[i] = (unsigned)(Rb * g.ldb + C) * 2u; }
    const size_t kstep = (size_t)(BK * 2);
    const size_t hstepA = (size_t)HALF * g.lda * 2, hstepB = (size_t)HALF * g.ldb * 2;
    const size_t tstepA = 2 * hstepA, tstepB = 2 * hstepB;
    const unsigned ldsw = (unsigned)wid * 1024u;
    const int aoff = lds_byte(wr * 64 + fr, fq * 8), boff = lds_byte(wc * 32 + fr, fq * 8);
#define PG8_SA(b, h) (((b) * 2 + (h)) * HTB)
#define PG8_SB(b, h) ((4 + (b) * 2 + (h)) * HTB)
#define PG8_STAGE(bufoff, gbase, voff) do { _Pragma("unroll") for (int _i = 0; _i < 2; ++_i) \
        __builtin_amdgcn_global_load_lds((const unsigned*)((const char*)(gbase) + (voff)[_i]), (LAS unsigned*)(lds + (bufoff) + ldsw + _i * 8192), 16, 0, 0); } while (0)
#define PG8_LDA(dst, b, h) do { _Pragma("unroll") for (int m = 0; m < 4; ++m) _Pragma("unroll") for (int k = 0; k < 2; ++k) dst[m][k] = *(const LAS bf16x8*)(lds + PG8_SA(b, h) + aoff + m * 2048 + k * 1024); } while (0)
#define PG8_LDB(dst, b, h) do { _Pragma("unroll") for (int n = 0; n < 2; ++n) _Pragma("unroll") for (int k = 0; k < 2; ++k) dst[n][k] = *(const LAS bf16x8*)(lds + PG8_SB(b, h) + boff + n * 2048 + k * 1024); } while (0)
#define PG8_MMA(ai, bj, At, Bt) do { __builtin_amdgcn_s_setprio(1); _Pragma("unroll") for (int m = 0; m < 4; ++m) _Pragma("unroll") for (int n = 0; n < 2; ++n) _Pragma("unroll") for (int k = 0; k < 2; ++k) \
        acc[ai][bj][m][n] = __builtin_amdgcn_mfma_f32_16x16x32_bf16(Bt[n][k], At[m][k], acc[ai][bj][m][n], 0, 0, 0); __builtin_amdgcn_s_setprio(0); } while (0)
#define PG8_WAIT_V(n) asm volatile("s_waitcnt vmcnt(" #n ")" ::: "memory")
#define PG8_WAIT_L(n) asm volatile("s_waitcnt lgkmcnt(" #n ")" ::: "memory")
#define PG8_BAR __builtin_amdgcn_s_barrier()
#define PG8_SCHED __builtin_amdgcn_sched_barrier(0)
    Unit cur, nxt; int ui = 0;
    if (!S.next(0, cur)) return;
    f32x4 acc[2][2][4][2];
#pragma unroll
    for (int a = 0; a < 2; ++a)
#pragma unroll
        for (int b = 0; b < 2; ++b)
#pragma unroll
            for (int m = 0; m < 4; ++m)
#pragma unroll
                for (int n = 0; n < 2; ++n) acc[a][b][m][n] = (f32x4){0.f, 0.f, 0.f, 0.f};
    bf16x8 At[4][2], B0[2][2], B1[2][2];
    const char* cA = (const char*)g.A + (size_t)cur.pm * tstepA; const char* cB = (const char*)g.Bt + (size_t)cur.pn * tstepB;
    PG8_STAGE(PG8_SB(0, 0), cB, voffB); PG8_STAGE(PG8_SB(0, 1), cB + hstepB, voffB); PG8_STAGE(PG8_SA(0, 0), cA, voffA); PG8_STAGE(PG8_SA(0, 1), cA + hstepA, voffA);
    if (wr == 1) PG8_BAR;
    PG8_WAIT_V(2); PG8_BAR;
    PG8_STAGE(PG8_SB(1, 0), cB + kstep, voffB); PG8_STAGE(PG8_SA(1, 0), cA + kstep, voffA); PG8_STAGE(PG8_SB(1, 1), cB + hstepB + kstep, voffB);
    PG8_WAIT_V(6); PG8_BAR;
    for (;;) {
        const bool has_next = S.next(ui + 1, nxt);
        const char* nA = has_next ? (const char*)g.A + (size_t)nxt.pm * tstepA : cA; const char* nB = has_next ? (const char*)g.Bt + (size_t)nxt.pn * tstepB : cB;
        for (int t = 0; t < nt; t += 2) {
            const bool last = (t == nt - 2);
            const char* a1 = cA + (size_t)(t + 1) * kstep;
            const char* a2 = last ? nA : cA + (size_t)(t + 2) * kstep; const char* b2 = last ? nB : cB + (size_t)(t + 2) * kstep;
            const char* a3 = a2 + kstep; const char* b3 = b2 + kstep;
            PG8_LDB(B0, 0, 0); PG8_LDB(B1, 0, 1); PG8_SCHED; PG8_LDA(At, 0, 0); PG8_STAGE(PG8_SA(1, 1), a1 + hstepA, voffA);
            PG8_WAIT_V(8); PG8_WAIT_L(0); PG8_BAR; PG8_MMA(0, 0, At, B0); PG8_MMA(0, 1, At, B1); PG8_BAR; PG8_SCHED;
            PG8_LDA(At, 0, 1); PG8_STAGE(PG8_SB(0, 0), b2, voffB); PG8_STAGE(PG8_SB(0, 1), b2 + hstepB, voffB); PG8_STAGE(PG8_SA(0, 0), a2, voffA);
            PG8_WAIT_V(8); PG8_WAIT_L(0); PG8_BAR; PG8_MMA(1, 0, At, B0); PG8_MMA(1, 1, At, B1); PG8_BAR; PG8_SCHED;
            PG8_LDB(B0, 1, 0); PG8_LDB(B1, 1, 1); PG8_SCHED; PG8_LDA(At, 1, 0); PG8_STAGE(PG8_SA(0, 1), a2 + hstepA, voffA);
            PG8_WAIT_V(8); PG8_WAIT_L(0); PG8_BAR; PG8_MMA(0, 0, At, B0); PG8_MMA(0, 1, At, B1); PG8_BAR; PG8_SCHED;
            PG8_LDA(At, 1, 1); PG8_STAGE(PG8_SB(1, 0), b3, voffB); PG8_STAGE(PG8_SB(1, 1), b3 + hstepB, voffB); PG8_STAGE(PG8_SA(1, 0), a3, voffA);
            PG8_WAIT_V(8); PG8_WAIT_L(0); PG8_BAR; PG8_MMA(1, 0, At, B0); PG8_MMA(1, 1, At, B1); PG8_BAR; PG8_SCHED;
        }
        if (wr == 0) PG8_BAR;
        E(acc, cur, wr, wc, fr, fq);
        if (!has_next) break;
#pragma unroll
        for (int a = 0; a < 2; ++a)
#pragma unroll
            for (int b = 0; b < 2; ++b)
#pragma unroll
                for (int m = 0; m < 4; ++m)
#pragma unroll
                    for (int n = 0; n < 2; ++n) acc[a][b][m][n] = (f32x4){0.f, 0.f, 0.f, 0.f};
        cur = nxt; cA = nA; cB = nB; ++ui;
        if (wr == 1) PG8_BAR;
    }
    PG8_WAIT_V(0);
    PG8_BAR;
#undef PG8_SA
#undef PG8_SB
#undef PG8_STAGE
#undef PG8_LDA
#undef PG8_LDB
#undef PG8_MMA
#undef PG8_WAIT_V
#undef PG8_WAIT_L
#undef PG8_BAR
#undef PG8_SCHED
}
}

struct FStoreBf16 {
    bf16_t* O; int ldc; int act;
    __device__ __forceinline__ void operator()(int row, int col, f32x4 a, f32x4 b) const {
        if (act == 1) { for (int i = 0; i < 4; ++i) { a[i] = fast_sigmoid(a[i]); b[i] = fast_sigmoid(b[i]); } }
        else if (act == 2) { for (int i = 0; i < 4; ++i) { float x = fmaxf(a[i], 0.f), y = fmaxf(b[i], 0.f); a[i] = x * x; b[i] = y * y; } }
        *(u32x4*)(O + (size_t)row * ldc + col) = pack8(a, b);
    }
};
struct FStoreVT {
    bf16_t* O;
    __device__ __forceinline__ void operator()(int row, int col, f32x4 a, f32x4 b) const {
        if (row < 512) { const int hk = row >> 7, d = row & 127; *(u32x4*)(O + (size_t)hk * ((size_t)T * 128) + ((size_t)(col >> 5) << 12) + (d >> 4) * 512 + (d & 15) * 32 + (col & 31)) = pack8(a, b); }
        else *(u32x4*)(O + (size_t)row * T + col) = pack8(a, b);
    }
};
struct FGeluBias {
    bf16_t* O; int ldc; const float* bias;
    __device__ __forceinline__ void operator()(int row, int col, f32x4 a, f32x4 b) const {
        const f32x4 b0 = *(const f32x4*)(bias + col), b1 = *(const f32x4*)(bias + col + 4);
        a = a + b0; b = b + b1;
        for (int i = 0; i < 4; ++i) {
            float x = a[i]; a[i] = x * __builtin_amdgcn_rcpf(1.f + __expf(-1.5957691216057308f * (x + 0.044715f * x * x * x)));
            float y = b[i]; b[i] = y * __builtin_amdgcn_rcpf(1.f + __expf(-1.5957691216057308f * (y + 0.044715f * y * y * y)));
        }
        *(u32x4*)(O + (size_t)row * ldc + col) = pack8(a, b);
    }
};
struct FMulInplace {
    bf16_t* O; int ldc;
    __device__ __forceinline__ void operator()(int row, int col, f32x4 a, f32x4 b) const {
        bf16_t* p = O + (size_t)row * ldc + col; f32x4 g0, g1; unpack8(*(const u32x4*)p, g0, g1);
        *(u32x4*)p = pack8(a * g0, b * g1);
    }
};
struct FMulAddInplace {
    bf16_t* O; const bf16_t* Y; int ldc;
    __device__ __forceinline__ void operator()(int row, int col, f32x4 a, f32x4 b) const {
        bf16_t* p = O + (size_t)row * ldc + col; f32x4 g0, g1, y0, y1; unpack8(*(const u32x4*)p, g0, g1); unpack8(*(const u32x4*)(Y + (size_t)row * ldc + col), y0, y1);
        *(u32x4*)p = pack8(a * g0 + y0, b * g1 + y1);
    }
};
struct FResidF32 {
    float* P; const float* X; int ldc;
    __device__ __forceinline__ void operator()(int row, int col, f32x4 a, f32x4 b) const {
        const size_t o = (size_t)row * ldc + col;
        const f32x4 x0 = *(const f32x4*)(X + o), x1 = *(const f32x4*)(X + o + 4);
        *(f32x4*)(P + o) = x0 * DN_ALPHA + a; *(f32x4*)(P + o + 4) = x1 * DN_ALPHA + b;
    }
};
struct FSigmoidF32 {
    float* P; int ldc;
    __device__ __forceinline__ void operator()(int row, int col, f32x4 a, f32x4 b) const {
        for (int i = 0; i < 4; ++i) { a[i] = fast_sigmoid(a[i]); b[i] = fast_sigmoid(b[i]); }
        const size_t o = (size_t)row * ldc + col; *(f32x4*)(P + o) = a; *(f32x4*)(P + o + 4) = b;
    }
};
struct FPle {
    float* P; const bf16_t* X; int ldc;
    __device__ __forceinline__ void operator()(int row, int col, f32x4 a, f32x4 b) const {
        const size_t o = (size_t)row * ldc + col; f32x4 x0, x1; unpack8(*(const u32x4*)(X + o), x0, x1);
        const f32x4 p0 = *(const f32x4*)(P + o), p1 = *(const f32x4*)(P + o + 4);
        *(f32x4*)(P + o) = a * p0 + x0 * DN_ALPHA; *(f32x4*)(P + o + 4) = b * p1 + x1 * DN_ALPHA;
    }
};
struct FAccF32 {
    float* P; int ldc;
    __device__ __forceinline__ void operator()(int row, int col, f32x4 a, f32x4 b) const {
        const size_t o = (size_t)row * ldc + col;
        *(f32x4*)(P + o) = *(const f32x4*)(P + o) + a; *(f32x4*)(P + o + 4) = *(const f32x4*)(P + o + 4) + b;
    }
};
struct EpiInProj {
    bf16_t *zz, *bg, *q, *kv, *sma; float* gates;
    __device__ __forceinline__ void operator()(const f32x4 (&acc)[2][2][4][2], const pg8::Unit& u, int wr, int wc, int fr, int fq) const {
        const int row0 = u.pm * 256 + wr * 64 + fr, cw = wc * 32 + 8 * fq; const int pn = u.pn;
        if (pn < 16) {
#pragma unroll
            for (int ai = 0; ai < 2; ++ai)
#pragma unroll
                for (int m = 0; m < 4; ++m) { const int row = row0 + ai * 128 + m * 16;
                    *(u32x4*)(zz + (size_t)row * D + pn * 128 + cw) = pack8(acc[ai][0][m][0] * acc[ai][1][m][0], acc[ai][0][m][1] * acc[ai][1][m][1]); }
        } else if (pn < 32) {
            bf16_t* O = (pn < 24) ? bg : q; const int c0 = ((pn - 16) & 7) * 256 + cw;
#pragma unroll
            for (int ai = 0; ai < 2; ++ai)
#pragma unroll
                for (int m = 0; m < 4; ++m) { const int row = row0 + ai * 128 + m * 16;
#pragma unroll
                    for (int bj = 0; bj < 2; ++bj) *(u32x4*)(O + (size_t)row * D + c0 + bj * 128) = pack8(acc[ai][bj][m][0], acc[ai][bj][m][1]); }
        } else if (pn < 40) {
            const int c0 = (pn - 32) * 256; const int b = c0 >> 9, h0 = (c0 & 511) >> 7;
            bf16_t* O = kv + (size_t)b * ((size_t)T * 512);
#pragma unroll
            for (int ai = 0; ai < 2; ++ai)
#pragma unroll
                for (int m = 0; m < 4; ++m) { const int row = row0 + ai * 128 + m * 16;
#pragma unroll
                    for (int bj = 0; bj < 2; ++bj) {
                        const size_t off = (b == 2) ? (((size_t)(row >> 5) << 12) + ((row >> 2) & 1) * 2048 + (cw >> 5) * 512 + (4 * ((row & 31) >> 3) + (row & 3)) * 32 + (cw & 31))
                                                    : ((size_t)row * 128 + cw);
                        *(u32x4*)(O + (size_t)(h0 + bj) * ((size_t)T * 128) + off) = pack8(acc[ai][bj][m][0], acc[ai][bj][m][1]); } }
        } else if (pn < 48) {
            const int c0 = (pn - 40) * 256 + cw;
#pragma unroll
            for (int ai = 0; ai < 2; ++ai)
#pragma unroll
                for (int m = 0; m < 4; ++m) { const int row = row0 + ai * 128 + m * 16;
#pragma unroll
                    for (int bj = 0; bj < 2; ++bj) { f32x4 a = acc[ai][bj][m][0], b = acc[ai][bj][m][1];
                        for (int i = 0; i < 4; ++i) { a[i] = fast_sigmoid(a[i]); b[i] = fast_sigmoid(b[i]); }
                        *(u32x4*)(sma + (size_t)row * D + c0 + bj * 128) = pack8(a, b); } }
        } else {
            if (cw < 48) {
#pragma unroll
                for (int ai = 0; ai < 2; ++ai)
#pragma unroll
                    for (int m = 0; m < 4; ++m) { const int row = row0 + ai * 128 + m * 16; f32x4 a = acc[ai][0][m][0], b = acc[ai][0][m][1];
                        for (int i = 0; i < 4; ++i) { a[i] = fast_sigmoid(a[i]); b[i] = fast_sigmoid(b[i]); }
                        *(f32x4*)(gates + (size_t)row * 48 + cw) = a; *(f32x4*)(gates + (size_t)row * 48 + cw + 4) = b; }
            }
        }
    }
};

struct Args {
    const float* in[22]; float* out; unsigned char* ws; int ph_lo, ph_hi, G, pad;
};

struct Ctx { int tid, lane, wave, gw, NGW, gtid, NT; LAS unsigned char* lds; };

__device__ __forceinline__ void tr_item(const float* W, int ldw, int k0, int nsrc0, bf16_t* WT, int ldt, int drow0, LAS float* scr, int lane) {
#pragma unroll 8
    for (int i = 0; i < 32; ++i) { const int kk = 2 * i + (lane >> 5); scr[kk * 33 + (lane & 31)] = W[(size_t)(k0 + kk) * ldw + nsrc0 + (lane & 31)]; }
    asm volatile("s_waitcnt lgkmcnt(0)" ::: "memory");
    const int c = lane & 7;
#pragma unroll
    for (int j = 0; j < 4; ++j) { const int n = (lane >> 3) + 8 * j; const LAS float* s = scr + (8 * c) * 33 + n;
        u32x4 o; o.x = cvt_pk_bf16(s[0 * 33], s[1 * 33]); o.y = cvt_pk_bf16(s[2 * 33], s[3 * 33]); o.z = cvt_pk_bf16(s[4 * 33], s[5 * 33]); o.w = cvt_pk_bf16(s[6 * 33], s[7 * 33]);
        *(u32x4*)(WT + (size_t)(drow0 + n) * ldt + k0 + 8 * c) = o; }
    asm volatile("s_waitcnt lgkmcnt(0)" ::: "memory");
}
__device__ __forceinline__ void tr_job(const Ctx& C, const float* W, int K, int ldw, int ncol0, int ncols, bf16_t* WT, int ldt, int drow0, int grp, int grp_stride) {
    LAS float* scr = (LAS float*)(C.lds + C.wave * 16384);
    const int nblk = ncols / 32, items = (K / 64) * nblk;
    for (int it = C.gw; it < items; it += C.NGW) {
        const int kb = it / nblk, n = (it % nblk) * 32; const int drow = drow0 + (n / grp) * grp_stride + (n % grp);
        tr_item(W, ldw, kb * 64, ncol0 + n, WT, ldt, drow, scr, C.lane);
    }
}
__device__ __forceinline__ void cvt_job(const Ctx& C, const float* X, bf16_t* O, size_t n8) {
    for (size_t i = C.gtid; i < n8; i += C.NT) { const f32x4 a = *(const f32x4*)(X + i * 8), b = *(const f32x4*)(X + i * 8 + 4); *(u32x4*)(O + i * 8) = pack8(a, b); }
}

template <bool OUT_BF16>
__device__ __forceinline__ void ln_rows(const Ctx& C, const float* P, const float* gam, const float* bet, void* outp) {
    for (int r = C.gw; r < T; r += C.NGW) {
        const f32x4* xr = (const f32x4*)(P + (size_t)r * D) + C.lane;
        f32x4 v[8]; float s = 0.f;
#pragma unroll
        for (int j = 0; j < 8; ++j) { v[j] = xr[64 * j]; s += (v[j][0] + v[j][1]) + (v[j][2] + v[j][3]); }
#pragma unroll
        for (int o = 1; o < 64; o <<= 1) s += __shfl_xor(s, o);
        const float mean = s * (1.f / D); float s2 = 0.f;
#pragma unroll
        for (int j = 0; j < 8; ++j) { v[j] = v[j] - mean; s2 += (v[j][0] * v[j][0] + v[j][1] * v[j][1]) + (v[j][2] * v[j][2] + v[j][3] * v[j][3]); }
#pragma unroll
        for (int o = 1; o < 64; o <<= 1) s2 += __shfl_xor(s2, o);
        const float rstd = 1.f / sqrtf(s2 * (1.f / D) + LN_EPS);
#pragma unroll
        for (int j = 0; j < 8; ++j) {
            const f32x4 gg = *((const f32x4*)gam + C.lane + 64 * j), bb = *((const f32x4*)bet + C.lane + 64 * j);
            const f32x4 y = v[j] * rstd * gg + bb;
            if (OUT_BF16) { u32x2 w; w.x = cvt_pk_bf16(y[0], y[1]); w.y = cvt_pk_bf16(y[2], y[3]); *((u32x2*)((bf16_t*)outp + (size_t)r * D) + C.lane + 64 * j) = w; }
            else *((f32x4*)((float*)outp + (size_t)r * D) + C.lane + 64 * j) = y;
        }
    }
}

constexpr float SC_LOG2E = 0.08838834764831845f * 1.4426950408889634f;
__device__ __forceinline__ int rel_bucket(int n) {
    const int e = 31 - __builtin_clz((unsigned)(n | 1));
    const int odd = ((unsigned)n * (unsigned)n >= (1u << (2 * e + 1))) ? 1 : 0;
    const int lg = min(31, 8 + 2 * e + odd);
    return n < 16 ? n : lg;
}
template <int MODE>
__device__ __forceinline__ void att_step(const bf16_t* __restrict__ Kp, const bf16_t* __restrict__ VTp, int ldv, int key0, int tq, bool colok,
                                         const bf16x8 (&qf)[4], float& m, float& lsum, f32x4 (&O)[8], float inv_l,
                                         const LAS float* tab, int hd16, LAS float* impq, int g, int fr) {
    bf16x8 ka[4], kb[4], vf[8];
    if (MODE == 3) {
        const bf16_t* kq = Kp + ((size_t)(key0 >> 5) << 12) + fr * 32 + 8 * g;
#pragma unroll
        for (int dc = 0; dc < 4; ++dc) { ka[dc] = *(const bf16x8*)(kq + dc * 512); kb[dc] = *(const bf16x8*)(kq + 2048 + dc * 512); }
        const bf16_t* vq = VTp + ((size_t)(key0 >> 5) << 12) + fr * 32 + 8 * g;
#pragma unroll
        for (int dt = 0; dt < 8; ++dt) vf[dt] = *(const bf16x8*)(vq + dt * 512);
    } else {
        const bf16_t* kpa = Kp + (size_t)(key0 + 8 * (fr >> 2) + (fr & 3)) * HD + 8 * g;
#pragma unroll
        for (int dc = 0; dc < 4; ++dc) { ka[dc] = *(const bf16x8*)(kpa + dc * 32); kb[dc] = *(const bf16x8*)(kpa + 4 * HD + dc * 32); }
        if (MODE != 0) { const bf16_t* vp = VTp + (size_t)fr * ldv + key0 + 8 * g;
#pragma unroll
            for (int dt = 0; dt < 8; ++dt) vf[dt] = *(const bf16x8*)(vp + (size_t)dt * 16 * ldv); }
    }
    f32x4 sa = {0.f, 0.f, 0.f, 0.f}, sb = {0.f, 0.f, 0.f, 0.f};
#pragma unroll
    for (int dc = 0; dc < 4; ++dc) { sa = __builtin_amdgcn_mfma_f32_16x16x32_bf16(ka[dc], qf[dc], sa, 0, 0, 0); sb = __builtin_amdgcn_mfma_f32_16x16x32_bf16(kb[dc], qf[dc], sb, 0, 0, 0); }
    float s[8]; bool ok[8];
#pragma unroll
    for (int e = 0; e < 8; ++e) {
        const int idx = key0 + 8 * g + e;
        const int dist = (MODE < 2) ? (tq - 31 - 16 * idx) : (tq - idx);
        ok[e] = (MODE < 2) ? (dist >= 0) : (MODE == 2 ? (dist >= 0 && dist < 512) : (dist >= 0 && colok));
        const int bk = rel_bucket(max(dist, 0));
        const float sv = (e < 4 ? sa[e & 3] : sb[e & 3]) * SC_LOG2E + tab[bk * 16 + hd16];
        s[e] = ok[e] ? sv : -1e30f;
    }
    float p[8];
    if (MODE != 1) {
        float mx = fmaxf(fmaxf(fmaxf(s[0], s[1]), fmaxf(s[2], s[3])), fmaxf(fmaxf(s[4], s[5]), fmaxf(s[6], s[7])));
        mx = fmaxf(mx, __shfl_xor(mx, 16)); mx = fmaxf(mx, __shfl_xor(mx, 32));
        const float mn = fmaxf(m, mx); const float alpha = __builtin_amdgcn_exp2f(m - mn); m = mn;
        float ps = 0.f;
#pragma unroll
        for (int e = 0; e < 8; ++e) { p[e] = ok[e] ? __builtin_amdgcn_exp2f(s[e] - mn) : 0.f; ps += p[e]; }
        lsum = lsum * alpha + ps;
        if (MODE != 0) {
#pragma unroll
            for (int dt = 0; dt < 8; ++dt) O[dt] = O[dt] * alpha;
        }
    } else {
#pragma unroll
        for (int e = 0; e < 8; ++e) p[e] = ok[e] ? __builtin_amdgcn_exp2f(s[e] - m) * inv_l : 0.f;
        const int G2 = (key0 >> 2) + 2 * g;
        atomicAdd((float*)(impq + G2), (p[0] + p[1]) + (p[2] + p[3]));
        atomicAdd((float*)(impq + G2 + 1), (p[3] + p[4]) + (p[5] + p[6]) + p[7]);
        atomicAdd((float*)(impq + G2 + 2), p[7]);
    }
    if (MODE != 0) {
        u32x4 pw; pw.x = cvt_pk_bf16(p[0], p[1]); pw.y = cvt_pk_bf16(p[2], p[3]); pw.z = cvt_pk_bf16(p[4], p[5]); pw.w = cvt_pk_bf16(p[6], p[7]);
        const bf16x8 pf = __builtin_bit_cast(bf16x8, pw);
#pragma unroll
        for (int dt = 0; dt < 8; ++dt) O[dt] = __builtin_amdgcn_mfma_f32_16x16x32_bf16(vf[dt], pf, O[dt], 0, 0, 0);
    }
}

constexpr int IMP_STRIDE = 264;
__device__ __forceinline__ void attention_phase(const Ctx& C, bf16_t* qo, const bf16_t* kc, const bf16_t* vcT, const bf16_t* ks, const bf16_t* vsT,
                                                const bf16_t* kw, const bf16_t* vwT, const float* gates, const float* rel_bias) {
    LAS float* tab = (LAS float*)C.lds;
    LAS float* imp = (LAS float*)(C.lds + 4096 + C.wave * 8192);
    LAS int* lst = (LAS int*)(C.lds + 4096 + C.wave * 8192 + 4 * IMP_STRIDE * 4);
    for (int i = C.tid; i < 512; i += NWAVES * 64) tab[i] = rel_bias[i] * 1.4426950408889634f;
    __syncthreads();
    const int lane = C.lane, fr = lane & 15, g = lane >> 4, qi = fr >> 2, hd = fr & 3;
    const int hk = (int)(blockIdx.x & 3), wl = (int)(blockIdx.x >> 2) * NWAVES + C.wave, nwl = C.NGW >> 2;
    for (int qg = wl; qg < T / 4; qg += nwl) {
        const int t0 = qg * 4, tq = t0 + qi, head = hk * 4 + hd, jt = t0 >> 6;
        bf16x8 qf[4];
        { const bf16_t* qp = qo + (size_t)tq * D + head * HD + 8 * g;
#pragma unroll
          for (int dc = 0; dc < 4; ++dc) qf[dc] = *(const bf16x8*)(qp + dc * 32); }
        const float g0 = gates[(size_t)tq * 48 + head * 3 + 0], g1 = gates[(size_t)tq * 48 + head * 3 + 1], g2 = gates[(size_t)tq * 48 + head * 3 + 2];
        f32x4 OA[8];
#pragma unroll
        for (int dt = 0; dt < 8; ++dt) OA[dt] = (f32x4){0.f, 0.f, 0.f, 0.f};
        f32x4 O[8];
        for (int i = lane; i < 4 * IMP_STRIDE; i += 64) imp[i] = 0.f;
        __builtin_amdgcn_wave_barrier(); asm volatile("s_waitcnt lgkmcnt(0)" ::: "memory");
        const bf16_t* Kc = kc + (size_t)hk * NCMP * HD; const bf16_t* Vc = vcT + (size_t)hk * HD * NCMP;
        const int ncv = (t0 + 3 >= 31) ? ((t0 + 3 - 31) >> 4) + 1 : 0;
        const int nst = (ncv + 31) >> 5;
        {
            float m = -1e30f, lsum = 0.f;
            for (int st = 0; st < nst; ++st) att_step<0>(Kc, Vc, NCMP, st * 32, tq, true, qf, m, lsum, O, 0.f, tab, hd + 0 * 16 + (hk * 4), imp + qi * IMP_STRIDE, g, fr);
            float l = lsum; l += __shfl_xor(l, 16); l += __shfl_xor(l, 32);
            const float inv = l > 0.f ? 1.f / l : 0.f;
#pragma unroll
            for (int dt = 0; dt < 8; ++dt) O[dt] = (f32x4){0.f, 0.f, 0.f, 0.f};
            for (int st = 0; st < nst; ++st) att_step<1>(Kc, Vc, NCMP, st * 32, tq, true, qf, m, lsum, O, inv, tab, hd + hk * 4, imp + qi * IMP_STRIDE, g, fr);
#pragma unroll
            for (int dt = 0; dt < 8; ++dt) OA[dt] = OA[dt] + O[dt] * g0;
        }
        __builtin_amdgcn_wave_barrier(); asm volatile("s_waitcnt lgkmcnt(0)" ::: "memory");
        int nlist = 0;
        const int ncand = jt - 2;
        if (ncand <= 13) {
            if (lane <= jt) lst[lane] = lane | (0xF << 16);
            nlist = jt + 1;
        } else {
            if (lane == 0) { lst[0] = 0 | (0xF << 16); lst[1] = (jt - 1) | (0xF << 16); lst[2] = jt | (0xF << 16); }
            nlist = 3;
            for (int qq = 0; qq < 4; ++qq) {
                float v[4];
#pragma unroll
                for (int k = 0; k < 4; ++k) { const int sblk = 4 * lane + k; const float x = imp[qq * IMP_STRIDE + sblk]; v[k] = (sblk >= 1 && sblk <= jt - 2) ? x : -1.f; }
                for (int r = 0; r < 13; ++r) {
                    float lm = fmaxf(fmaxf(v[0], v[1]), fmaxf(v[2], v[3]));
                    float wm = lm;
#pragma unroll
                    for (int o = 1; o < 64; o <<= 1) wm = fmaxf(wm, __shfl_xor(wm, o));
                    const unsigned long long bal = __ballot(lm == wm);
                    const int src = __ffsll((long long)bal) - 1;
                    if (lane == src) {
                        int k = (v[0] == wm) ? 0 : (v[1] == wm) ? 1 : (v[2] == wm) ? 2 : 3;
                        if (k == 0) v[0] = -2.f; else if (k == 1) v[1] = -2.f; else if (k == 2) v[2] = -2.f; else v[3] = -2.f;
                        lst[nlist + r] = (4 * lane + k) | ((1 << qq) << 16);
                    }
                }
                nlist += 13;
            }
        }
        __builtin_amdgcn_wave_barrier(); asm volatile("s_waitcnt lgkmcnt(0)" ::: "memory");
        {
            const bf16_t* Ks = ks + (size_t)hk * T * HD; const bf16_t* Vs = vsT + (size_t)hk * T * HD;
            float m = -1e30f, lsum = 0.f;
#pragma unroll
            for (int dt = 0; dt < 8; ++dt) O[dt] = (f32x4){0.f, 0.f, 0.f, 0.f};
            for (int i = 0; i < nlist; ++i) {
                const int ent = __builtin_amdgcn_readfirstlane(lst[i]);
                const int blk = ent & 0xffff; const bool colok = ((ent >> (16 + qi)) & 1) != 0;
                att_step<3>(Ks, Vs, 0, blk * 64, tq, colok, qf, m, lsum, O, 0.f, tab, hd + hk * 4, imp, g, fr);
                att_step<3>(Ks, Vs, 0, blk * 64 + 32, tq, colok, qf, m, lsum, O, 0.f, tab, hd + hk * 4, imp, g, fr);
            }
            float l = lsum; l += __shfl_xor(l, 16); l += __shfl_xor(l, 32);
            const float sc = (l > 0.f ? 1.f / l : 0.f) * g1;
#pragma unroll
            for (int dt = 0; dt < 8; ++dt) OA[dt] = OA[dt] + O[dt] * sc;
        }
        {
            const bf16_t* Kw = kw + (size_t)hk * T * HD; const bf16_t* Vw = vwT + (size_t)hk * HD * T;
            float m = -1e30f, lsum = 0.f;
#pragma unroll
            for (int dt = 0; dt < 8; ++dt) O[dt] = (f32x4){0.f, 0.f, 0.f, 0.f};
            const int kstart = max(0, t0 - 511) & ~31;
            for (int k0 = kstart; k0 <= t0 + 3; k0 += 32) att_step<2>(Kw, Vw, T, k0, tq, true, qf, m, lsum, O, 0.f, tab, hd + hk * 4, imp, g, fr);
            float l = lsum; l += __shfl_xor(l, 16); l += __shfl_xor(l, 32);
            const float sc = (l > 0.f ? 1.f / l : 0.f) * g2;
#pragma unroll
            for (int dt = 0; dt < 8; ++dt) OA[dt] = OA[dt] + O[dt] * sc;
        }
        { bf16_t* op = qo + (size_t)tq * D + head * HD + 4 * g;
#pragma unroll
          for (int dt = 0; dt < 8; ++dt) { u32x2 w; w.x = cvt_pk_bf16(OA[dt][0], OA[dt][1]); w.y = cvt_pk_bf16(OA[dt][2], OA[dt][3]); *(u32x2*)(op + dt * 16) = w; } }
        __builtin_amdgcn_wave_barrier(); asm volatile("s_waitcnt lgkmcnt(0)" ::: "memory");
    }
}

__global__ void __launch_bounds__(NWAVES * 64, 2) fwd_megakernel(Args args) {
    extern __shared__ __attribute__((aligned(16))) unsigned char lds_raw[];
    __builtin_assume(__builtin_amdgcn_workitem_id_y() == 0); __builtin_assume(__builtin_amdgcn_workitem_id_z() == 0);
    cg::grid_group grid = cg::this_grid();
    Ctx C; C.lds = (LAS unsigned char*)lds_raw; C.tid = threadIdx.x; C.lane = C.tid & 63; C.wave = __builtin_amdgcn_readfirstlane(C.tid >> 6);
    const int G = args.G, bx = blockIdx.x;
    C.gw = bx * NWAVES + C.wave; C.NGW = G * NWAVES; C.gtid = bx * (NWAVES * 64) + C.tid; C.NT = G * NWAVES * 64;
    unsigned char* ws = args.ws;
#define x_in (args.in[0])
#define pin (args.in[1])
#define w_in (args.in[2])
#define conv_w (args.in[3])
#define pe_k (args.in[4])
#define w1_k (args.in[5])
#define w2_k (args.in[6])
#define pe_v (args.in[7])
#define w1_v (args.in[8])
#define w2_v (args.in[9])
#define w_conv_out (args.in[10])
#define w_attn_out (args.in[11])
#define w_mix_out (args.in[12])
#define ln1_g (args.in[13])
#define ln1_b (args.in[14])
#define w_up (args.in[15])
#define w_down (args.in[16])
#define w_ple (args.in[17])
#define w_ple_gate (args.in[18])
#define ln2_g (args.in[19])
#define ln2_b (args.in[20])
#define rel_bias (args.in[21])
#define BP(off) ((bf16_t*)(ws + (off)))
#define FP(off) ((float*)(ws + (off)))
#define XB BP(WS_XB)
#define WTIN BP(WS_WTIN)
#define WTVT BP(WS_WTVT)
#define WTMB BP(WS_WTMB)
#define W1K BP(WS_W1K)
#define W1V BP(WS_W1V)
#define BIASK FP(WS_BIASK)
#define BIASV FP(WS_BIASV)
#define HIDK BP(WS_HIDK)
#define HIDV BP(WS_HIDV)
#define KC BP(WS_KC)
#define VCT BP(WS_VCT)
#define GATES FP(WS_GATES)
#define BG BP(WS_BG)
#define ZZ BP(WS_ZZ)
#define Q BP(WS_Q)
#define KCS BP(WS_KCS)
#define VCS BP(WS_VCS)
#define KS BP(WS_KS)
#define KW BP(WS_KW)
#define VST BP(WS_VST)
#define VWT BP(WS_VWT)
#define SMA BP(WS_SMA)
#define SMB BP(WS_SMB)
#define WTCONV BP(WS_WTCONV)
#define WTATTN BP(WS_WTATTN)
#define WTMIX BP(WS_WTMIX)
#define WTGATE BP(WS_WTGATE)
#define WTPLE BP(WS_WTPLE)
#define PB BP(WS_PB)
#define WTUP BP(WS_WTUP)
#define WTDOWN BP(WS_WTDOWN)
#define PRE1 FP(WS_PRE1)
#define PRE2 FP(WS_PRE2)
#define X1B BP(WS_X1B)
#define H1 BP(WS_H1)
    const int lo = args.ph_lo, hi = args.ph_hi;
    unsigned* gbar = (unsigned*)(ws + 16384); int nbar = 0;
    if (lo == 12345) grid.sync();
#ifndef PHMASK
#define PHMASK 0xFFFF
#endif
#define IN(k) (((PHMASK >> (k)) & 1) && lo <= (k) && (k) < hi)
#define SEAM(k) do { if (IN(k) && IN((k) + 1)) { ++nbar; \
        asm volatile("s_waitcnt vmcnt(0) lgkmcnt(0)" ::: "memory"); __syncthreads(); \
        if (C.tid == 0) { __builtin_amdgcn_fence(__ATOMIC_RELEASE, "agent"); asm volatile("s_waitcnt vmcnt(0)" ::: "memory"); \
            __hip_atomic_fetch_add(gbar, 1u, __ATOMIC_RELAXED, __HIP_MEMORY_SCOPE_AGENT); \
            while (__hip_atomic_load(gbar, __ATOMIC_RELAXED, __HIP_MEMORY_SCOPE_AGENT) < (unsigned)(nbar * G)) __builtin_amdgcn_s_sleep(2); \
            __builtin_amdgcn_fence(__ATOMIC_ACQUIRE, "agent"); asm volatile("s_waitcnt vmcnt(0)" ::: "memory"); } \
        __syncthreads(); \
        __builtin_amdgcn_fence(__ATOMIC_ACQUIRE, "agent"); asm volatile("s_waitcnt vmcnt(0)" ::: "memory"); } } while (0)

    if (IN(0)) {
        cvt_job(C, x_in, XB, (size_t)T * D / 8);
        tr_job(C, w_in, D, NIN, 2048, 2048, WTIN, D, 0, 128, 256);
        tr_job(C, w_in, D, NIN, 4096, 2048, WTIN, D, 128, 128, 256);
        tr_job(C, w_in, D, NIN, 0, 2048, WTIN, D, 4096, 2048, 0);
        tr_job(C, w_in, D, NIN, 6144, 2048, WTIN, D, 6144, 2048, 0);
        tr_job(C, w_in, D, NIN, 8192, 512, WTIN, D, 8192, 512, 0);
        tr_job(C, w_in, D, NIN, 8704, 512, WTIN, D, 8704, 512, 0);
        tr_job(C, w_in, D, NIN, 9216, 512, WTIN, D, 9216, 512, 0);
        tr_job(C, w_in, D, NIN, 10240, 512, WTIN, D, 9728, 512, 0);
        tr_job(C, w_in, D, NIN, 11312, 2048, WTIN, D, 10240, 2048, 0);
        tr_job(C, w_in, D, NIN, 9728, 512, WTVT, D, 0, 512, 0);
        tr_job(C, w_in, D, NIN, 10752, 512, WTVT, D, 512, 512, 0);
        tr_job(C, w_in, D, NIN, 13360, 2048, WTMB, D, 0, 2048, 0);
        tr_job(C, w1_k, 4096, 256, 0, 256, W1K, 4096, 0, 256, 0);
        tr_job(C, w1_v, 4096, 256, 0, 256, W1V, 4096, 0, 256, 0);
        for (int i = C.gtid; i < 256 * D; i += C.NT) { const int r = i / D, k = i % D; const float v = (r < 48) ? w_in[(size_t)k * NIN + 11264 + r] : 0.f; WTIN[(size_t)(12288 + r) * D + k] = (bf16_t)(cvt_pk_bf16(v, 0.f) & 0xffff); }
        if (bx == G - 1) {
            const int n = C.tid & 255; const float* pe = (C.tid < 256) ? pe_k : pe_v; const float* w1 = (C.tid < 256) ? w1_k : w1_v; float s = 0.f;
            for (int j = 0; j < 4096; ++j) s += pe[j] * w1[(size_t)j * 256 + n];
            ((C.tid < 256) ? BIASK : BIASV)[n] = s;
        }
        asm volatile("s_waitcnt vmcnt(0) lgkmcnt(0)" ::: "memory"); __syncthreads();
    }
    SEAM(0);
    if (IN(1)) {
        { pg8::Gemm g{XB, WTIN, T, 12544, D, D, D}; pg8::StaticOrder S; S.init(T, 12544, G, bx);
          EpiInProj E{ZZ, BG, Q, KCS, SMA, GATES};
          pg8::gemm_phase(C.lds, g, S, E); }
        { pg8::Gemm g{WTVT, XB, 1024, T, D, D, D}; pg8::StaticOrder S; S.init(1024, T, G, (bx + 64) % G);
          pg8::EpiGen<FStoreVT> E{{VST}};
          pg8::gemm_phase(C.lds, g, S, E); }
    }
    SEAM(1);
    if (IN(2)) {
        if (bx < 32) {
            { pg8::Gemm g{KCS, W1K, 4096, 256, 4096, 2048, 4096}; pg8::StaticOrder S; S.init(4096, 256, G, bx < 16 ? bx : -1); S.G = 16;
              pg8::EpiGen<FGeluBias> E{{HIDK, 256, BIASK}}; pg8::gemm_phase(C.lds, g, S, E); }
            { pg8::Gemm g{VCS, W1V, 4096, 256, 4096, 2048, 4096}; pg8::StaticOrder S; S.init(4096, 256, G, (bx >= 16 && bx < 32) ? bx - 16 : -1); S.G = 16;
              pg8::EpiGen<FGeluBias> E{{HIDV, 256, BIASV}}; pg8::gemm_phase(C.lds, g, S, E); }
        } else
        for (size_t i = (size_t)(bx - 32) * (NWAVES * 64) + C.tid; i < (size_t)T * D / 8; i += (size_t)(G - 32) * (NWAVES * 64)) {
            const int t = (int)(i / (D / 8)), c8 = (int)(i % (D / 8)) * 8;
            f32x4 z0a, z0b, z1a = {0.f, 0.f, 0.f, 0.f}, z1b = z1a, z2a = z1a, z2b = z1a, ba, bb;
            unpack8(*(const u32x4*)(ZZ + (size_t)t * D + c8), z0a, z0b);
            if (t >= 1) unpack8(*(const u32x4*)(ZZ + (size_t)(t - 1) * D + c8), z1a, z1b);
            if (t >= 2) unpack8(*(const u32x4*)(ZZ + (size_t)(t - 2) * D + c8), z2a, z2b);
            unpack8(*(const u32x4*)(BG + (size_t)t * D + c8), ba, bb);
            const f32x4 w0a = *(const f32x4*)(conv_w + c8), w0b = *(const f32x4*)(conv_w + c8 + 4);
            const f32x4 w1a = *(const f32x4*)(conv_w + D + c8), w1b = *(const f32x4*)(conv_w + D + c8 + 4);
            const f32x4 w2a = *(const f32x4*)(conv_w + 2 * D + c8), w2b = *(const f32x4*)(conv_w + 2 * D + c8 + 4);
            const f32x4 ua = ba * (w0a * z2a + w1a * z1a + w2a * z0a), ub = bb * (w0b * z2b + w1b * z1b + w2b * z0b);
            *(u32x4*)(BG + (size_t)t * D + c8) = pack8(ua, ub);
        }
    }
    SEAM(2);
    if (IN(3)) {
        { pg8::Gemm g{XB, WTMB, T, D, D, D, D}; pg8::StaticOrder S; S.init(T, D, G, bx);
          pg8::EpiGen<FStoreBf16> E{{SMB, D, 1}}; pg8::gemm_phase(C.lds, g, S, E); }
    }
    SEAM(3);
    if (IN(4)) {
        for (int i = C.gtid; i < 4096 * HD; i += C.NT) {
            const int d = i & 127, row = i >> 7; const bf16_t* hp = HIDK + (size_t)row * 256; float s = 0.f;
            for (int j = 0; j < 256; j += 2) { const unsigned w = *(const unsigned*)(hp + j); s += bf_lo(w) * w2_k[(size_t)j * HD + d] + bf_hi(w) * w2_k[(size_t)(j + 1) * HD + d]; }
            KC[i] = (bf16_t)(cvt_pk_bf16(s, 0.f) & 0xffff);
        }
        for (int i = C.gtid; i < 4096 * HD; i += C.NT) {
            const int ii = i & 1023, d = (i >> 10) & 127, h = i >> 17; const bf16_t* hp = HIDV + (size_t)(h * 1024 + ii) * 256; float s = 0.f;
            for (int j = 0; j < 256; j += 2) { const unsigned w = *(const unsigned*)(hp + j); s += bf_lo(w) * w2_v[(size_t)j * HD + d] + bf_hi(w) * w2_v[(size_t)(j + 1) * HD + d]; }
            VCT[i] = (bf16_t)(cvt_pk_bf16(s, 0.f) & 0xffff);
        }
        tr_job(C, w_conv_out, D, D, 0, D, WTCONV, D, 0, D, 0);
        tr_job(C, w_attn_out, D, D, 0, D, WTATTN, D, 0, D, 0);
        tr_job(C, w_mix_out, D, D, 0, D, WTMIX, D, 0, D, 0);
        tr_job(C, w_ple_gate, D, D, 0, D, WTGATE, D, 0, D, 0);
        tr_job(C, w_ple, PLE, D, 0, D, WTPLE, PLE, 0, D, 0);
        tr_job(C, w_up, D, FF, 0, FF, WTUP, D, 0, FF, 0);
        tr_job(C, w_down, FF, D, 0, D, WTDOWN, FF, 0, D, 0);
        cvt_job(C, pin, PB, (size_t)T * PLE / 8);
        asm volatile("s_waitcnt vmcnt(0) lgkmcnt(0)" ::: "memory"); __syncthreads();
    }
    SEAM(4);
    if (IN(5)) {
        attention_phase(C, Q, KC, VCT, KS, VST, KW, VWT, GATES, rel_bias);
        asm volatile("s_waitcnt vmcnt(0) lgkmcnt(0)" ::: "memory"); __syncthreads();
    }
    SEAM(5);
    if (IN(6)) { pg8::Gemm g{BG, WTCONV, T, D, D, D, D}; pg8::StaticOrder S; S.init(T, D, G, bx); pg8::EpiGen<FMulInplace> E{{SMA, D}}; pg8::gemm_phase(C.lds, g, S, E); }
    SEAM(6);
    if (IN(7)) { pg8::Gemm g{Q, WTATTN, T, D, D, D, D}; pg8::StaticOrder S; S.init(T, D, G, bx); pg8::EpiGen<FMulAddInplace> E{{SMB, SMA, D}}; pg8::gemm_phase(C.lds, g, S, E); }
    SEAM(7);
    if (IN(8)) { pg8::Gemm g{SMB, WTMIX, T, D, D, D, D}; pg8::StaticOrder S; S.init(T, D, G, bx); pg8::EpiGen<FResidF32> E{{PRE1, x_in, D}}; pg8::gemm_phase(C.lds, g, S, E); }
    SEAM(8);
    if (IN(9)) ln_rows<true>(C, PRE1, ln1_g, ln1_b, X1B);
    SEAM(9);
    if (IN(10)) {
        { pg8::Gemm g{X1B, WTGATE, T, D, D, D, D}; pg8::StaticOrder S; S.init(T, D, G, bx); pg8::EpiGen<FSigmoidF32> E{{PRE2, D}}; pg8::gemm_phase(C.lds, g, S, E); }
        { pg8::Gemm g{X1B, WTUP, T / 2, FF, D, D, D}; pg8::StaticOrder S; S.init(T / 2, FF, G, bx); pg8::EpiGen<FStoreBf16> E{{H1, FF, 2}}; pg8::gemm_phase(C.lds, g, S, E); }
    }
    SEAM(10);
    if (IN(11)) { pg8::Gemm g{PB, WTPLE, T, D, PLE, PLE, PLE}; pg8::StaticOrder S; S.init(T, D, G, bx); pg8::EpiGen<FPle> E{{PRE2, X1B, D}}; pg8::gemm_phase(C.lds, g, S, E); }
    SEAM(11);
    if (IN(12)) { pg8::Gemm g{H1, WTDOWN, T / 2, D, FF, FF, FF}; pg8::StaticOrder S; S.init(T / 2, D, G, bx); pg8::EpiGen<FAccF32> E{{PRE2, D}}; pg8::gemm_phase(C.lds, g, S, E); }
    SEAM(12);
    if (IN(13)) { pg8::Gemm g{X1B + (size_t)(T / 2) * D, WTUP, T / 2, FF, D, D, D}; pg8::StaticOrder S; S.init(T / 2, FF, G, bx); pg8::EpiGen<FStoreBf16> E{{H1, FF, 2}}; pg8::gemm_phase(C.lds, g, S, E); }
    SEAM(13);
    if (IN(14)) { pg8::Gemm g{H1, WTDOWN, T / 2, D, FF, FF, FF}; pg8::StaticOrder S; S.init(T / 2, D, G, bx); pg8::EpiGen<FAccF32> E{{PRE2 + (size_t)(T / 2) * D, D}}; pg8::gemm_phase(C.lds, g, S, E); }
    SEAM(14);
    if (IN(15)) ln_rows<false>(C, PRE2, ln2_g, ln2_b, args.out);
#undef IN
#undef SEAM
}

extern "C" void kernel_launch(void* const* d_in, const int* in_sizes, int n_in, void* d_out, int out_size, void* d_ws, size_t ws_size, hipStream_t stream) {
    static int grid = 0;
    if (grid == 0) {
        if (n_in != 22 || ws_size < WS_END) { fprintf(stderr, "kernel_launch: need 22 inputs and >= %zu bytes of workspace (got %d, %zu)\n", (size_t)WS_END, n_in, ws_size); grid = -1; return; }
        int dev = 0, cus = 0, per_cu = 0;
        hipGetDevice(&dev); hipDeviceGetAttribute(&cus, hipDeviceAttributeMultiprocessorCount, dev);
        if (hipFuncSetAttribute((const void*)fwd_megakernel, hipFuncAttributeMaxDynamicSharedMemorySize, LDS_BYTES) != hipSuccess) { fprintf(stderr, "kernel_launch: hipFuncSetAttribute failed\n"); grid = -1; return; }
        if (hipOccupancyMaxActiveBlocksPerMultiprocessor(&per_cu, (const void*)fwd_megakernel, NWAVES * 64, LDS_BYTES) != hipSuccess || per_cu < 1) { fprintf(stderr, "kernel_launch: occupancy query says %d\n", per_cu); per_cu = 1; }
        (void)hipGetLastError();
        grid = cus * 1;
    }
    if (grid < 0) return;
    Args a{};
    for (int i = 0; i < 22; ++i) a.in[i] = (const float*)d_in[i];
    a.out = (float*)d_out; a.ws = (unsigned char*)d_ws; a.G = grid; a.pad = 0;
#if MK_PER_PHASE
    for (int ph = 0; ph < 16; ++ph) { a.ph_lo = ph; a.ph_hi = ph + 1; void* kargs[] = {&a};
        hipError_t e = hipLaunchCooperativeKernel((const void*)fwd_megakernel, dim3(grid), dim3(NWAVES * 64), kargs, LDS_BYTES, stream);
        if (e != hipSuccess) { fprintf(stderr, "kernel_launch: launch failed: %s\n", hipGetErrorString(e)); break; } }
#else
    (void)hipMemsetAsync((char*)d_ws + 16384, 0, 256, stream);
    a.ph_lo = 0; a.ph_hi = 16; void* kargs[] = {&a};
    hipError_t e = hipLaunchCooperativeKernel((const void*)fwd_megakernel, dim3(grid), dim3(NWAVES * 64), kargs, LDS_BYTES, stream);
    if (e != hipSuccess) fprintf(stderr, "kernel_launch: cooperative launch failed: %s (grid %d)\n", hipGetErrorString(e), grid);
#endif
}
```

```cpp
#include <hip/hip_runtime.h>
#include <hip/hip_cooperative_groups.h>
#include <cstdio>
#include <cstdint>
namespace cg = cooperative_groups;

#define LAS __attribute__((address_space(3)))
typedef unsigned short bf16_t;
typedef short bf16x8 __attribute__((ext_vector_type(8)));
typedef float f32x4 __attribute__((ext_vector_type(4)));
typedef float f32x2 __attribute__((ext_vector_type(2)));
typedef unsigned u32x4 __attribute__((ext_vector_type(4)));
typedef unsigned u32x2 __attribute__((ext_vector_type(2)));

#ifndef MK_PER_PHASE
#define MK_PER_PHASE 0
#endif

constexpr int T = 16384, D = 2048, NIN = 15408, FF = 8192, PLE = 256, HK = 4, HD = 128, NCMP = 1024;
constexpr float DN_ALPHA = 1.189207115002721f;
constexpr float LN_EPS = 1e-5f;
constexpr int NWAVES = 8;
constexpr int LDS_BYTES = 147456;

constexpr size_t MiB = 1u << 20;
constexpr size_t WS_BIASK = 0, WS_BIASV = 4096;
constexpr size_t WS_XB = 1 * MiB;
constexpr size_t WS_WTUP = 1 * MiB, WS_WTDOWN = 33 * MiB;
constexpr size_t WS_WTIN = 65 * MiB;
constexpr size_t WS_WTVT = 114 * MiB;
constexpr size_t WS_WTMB = 118 * MiB;
constexpr size_t WS_WTCONV = 65 * MiB, WS_WTATTN = 73 * MiB, WS_WTMIX = 81 * MiB, WS_WTGATE = 89 * MiB, WS_WTPLE = 97 * MiB, WS_PB = 98 * MiB;
constexpr size_t WS_W1K = 126 * MiB, WS_W1V = 128 * MiB;
constexpr size_t WS_HIDK = 130 * MiB, WS_HIDV = 132 * MiB;
constexpr size_t WS_KC = 134 * MiB, WS_VCT = 135 * MiB;
constexpr size_t WS_GATES = 136 * MiB;
constexpr size_t WS_BG = 140 * MiB;
constexpr size_t WS_X1B = 140 * MiB;
constexpr size_t WS_ZZ = 204 * MiB;
constexpr size_t WS_SMB = 204 * MiB, WS_H1 = 204 * MiB;
constexpr size_t WS_Q = 268 * MiB;
constexpr size_t WS_KCS = 332 * MiB, WS_VCS = 348 * MiB, WS_KS = 364 * MiB, WS_KW = 380 * MiB, WS_VST = 396 * MiB, WS_VWT = 412 * MiB;
constexpr size_t WS_SMA = 428 * MiB;
constexpr size_t WS_PRE1 = 300 * MiB, WS_PRE2 = 364 * MiB;
constexpr size_t WS_END = 492 * MiB;

typedef __bf16 bf16x2_t __attribute__((ext_vector_type(2)));
__device__ __forceinline__ unsigned cvt_pk_bf16(float lo, float hi) { f32x2 v = {lo, hi}; bf16x2_t b = __builtin_convertvector(v, bf16x2_t); return __builtin_bit_cast(unsigned, b); }
__device__ __forceinline__ float bf_lo(unsigned w) { return __uint_as_float(w << 16); }
__device__ __forceinline__ float bf_hi(unsigned w) { return __uint_as_float(w & 0xffff0000u); }
__device__ __forceinline__ float fast_sigmoid(float x) { return __builtin_amdgcn_rcpf(1.f + __expf(-x)); }
__device__ __forceinline__ u32x4 pack8(const f32x4& a, const f32x4& b) { u32x4 w; w.x = cvt_pk_bf16(a[0], a[1]); w.y = cvt_pk_bf16(a[2], a[3]); w.z = cvt_pk_bf16(b[0], b[1]); w.w = cvt_pk_bf16(b[2], b[3]); return w; }
__device__ __forceinline__ void unpack8(const u32x4& w, f32x4& a, f32x4& b) { a[0] = bf_lo(w.x); a[1] = bf_hi(w.x); a[2] = bf_lo(w.y); a[3] = bf_hi(w.y); b[0] = bf_lo(w.z); b[1] = bf_hi(w.z); b[2] = bf_lo(w.w); b[3] = bf_hi(w.w); }

namespace pg8 {
constexpr int BM = 256, BK = 64, HALF = 128, HTB = HALF * BK * 2, STAGE_BYTES = 8 * HTB, NXCD = 8, WGM = 8;
__host__ __device__ __forceinline__ int lds_byte(int r, int c) { const int st = (r >> 4) * 2 + (c >> 5), rr = r & 15, cc = c & 31, ob = rr * 64 + cc * 2; return st * 1024 + (ob ^ (((ob >> 9) & 1) << 5)); }
__host__ __device__ __forceinline__ void stage_rc(int b, int& R, int& C) { const int st = b / 1024, sb = b % 1024, swz = sb ^ (((sb >> 9) & 1) << 5); R = (st >> 1) * 16 + swz / 64; C = (st & 1) * 32 + (swz % 64) / 2; }
__host__ __device__ __forceinline__ int perm32(int rho) { const int n = rho >> 4, i = rho & 15; return 8 * (i >> 2) + 4 * n + (i & 3); }

struct Unit { int pm, pn; };
struct Gemm { const bf16_t* A; const bf16_t* Bt; int M, N, K, lda, ldb; };

struct StaticOrder {
    int nM, nN, nwg, G, c;
    __device__ void init(int M, int N, int G_, int c_) { nM = M / BM; nN = N / BM; nwg = nM * nN; G = G_; c = c_; }
    __device__ bool next(int i, Unit& u) const {
        const long L = (long)i * G + c; if (c < 0 || L >= nwg) return false;
        int wgid = (int)L; { const int q = nwg / NXCD, r = nwg % NXCD, xcd = wgid % NXCD, off = wgid / NXCD; wgid = (xcd < r ? xcd * (q + 1) : r * (q + 1) + (xcd - r) * q) + off; }
        const int nig = WGM * nN, gid = wgid / nig, fm = gid * WGM, gsz = (nM - fm) < WGM ? (nM - fm) : WGM;
        u.pm = fm + ((wgid % nig) % gsz); u.pn = (wgid % nig) / gsz; return true;
    }
};

template <class F> struct EpiGen {
    F f;
    __device__ __forceinline__ void operator()(const f32x4 (&acc)[2][2][4][2], const Unit& u, int wr, int wc, int fr, int fq) const {
        const int row0 = u.pm * BM + wr * 64 + fr, col0 = u.pn * BM + wc * 32 + 8 * fq;
#pragma unroll
        for (int ai = 0; ai < 2; ++ai)
#pragma unroll
            for (int m = 0; m < 4; ++m) {
                const int row = row0 + ai * HALF + m * 16;
#pragma unroll
                for (int bj = 0; bj < 2; ++bj) f(row, col0 + bj * HALF, acc[ai][bj][m][0], acc[ai][bj][m][1]);
            }
    }
};

template <class Epi, class Sched>
__device__ __forceinline__ void gemm_phase(LAS unsigned char* lds, const Gemm g, const Sched& S, const Epi& E) {
    const int tid = threadIdx.x, wid = __builtin_amdgcn_readfirstlane(tid >> 6), lane = tid & 63, wr = wid >> 2, wc = wid & 3, fr = lane & 15, fq = lane >> 4;
    const int K = g.K, nt = K / BK;
    unsigned voffA[2], voffB[2];
#pragma unroll
    for (int i = 0; i < 2; ++i) { int R, C; stage_rc(tid * 16 + i * 8192, R, C); const int Rb = (R & ~31) + perm32(R & 31);
        voffA[i] = (unsigned)(R * g.lda + C) * 2u; voffB[i] = (unsigned)(Rb * g.ldb + C) * 2u; }
    const size_t kstep = (size_t)(BK * 2);
    const size_t hstepA = (size_t)HALF * g.lda * 2, hstepB = (size_t)HALF * g.ldb * 2;
    const size_t tstepA = 2 * hstepA, tstepB = 2 * hstepB;
    const unsigned ldsw = (unsigned)wid * 1024u;
    const int aoff = lds_byte(wr * 64 + fr, fq * 8), boff = lds_byte(wc * 32 + fr, fq * 8);
#define PG8_SA(b, h) (((b) * 2 + (h)) * HTB)
#define PG8_SB(b, h) ((4 + (b) * 2 + (h)) * HTB)
#define PG8_STAGE(bufoff, gbase, voff) do { _Pragma("unroll") for (int _i = 0; _i < 2; ++_i) \
        __builtin_amdgcn_global_load_lds((const unsigned*)((const char*)(gbase) + (voff)[_i]), (LAS unsigned*)(lds + (bufoff) + ldsw + _i * 8192), 16, 0, 0); } while (0)
#define PG8_LDA(dst, b, h) do { _Pragma("unroll") for (int m = 0; m < 4; ++m) _Pragma("unroll") for (int k = 0; k < 2; ++k) dst[m][k] = *(const LAS bf16x8*)(lds + PG8_SA(b, h) + aoff + m * 2048 + k * 1024); } while (0)
#define PG8_LDB(dst, b, h) do { _Pragma("unroll") for (int n = 0; n < 2; ++n) _Pragma("unroll") for (int k = 0; k < 2; ++k) dst[n][k] = *(const LAS bf16x8*)(lds + PG8_SB(b, h) + boff + n * 2048 + k * 1024); } while (0)
#define PG8_MMA(ai, bj, At, Bt) do { __builtin_amdgcn_s_setprio(1); _Pragma("unroll") for (int m = 0; m < 4; ++m) _Pragma("unroll") for (int n = 0; n < 2; ++n) _Pragma("unroll") for (int k = 0; k < 2; ++k) \
        acc[ai][bj][m][n] = __builtin_amdgcn_mfma_f32_16x16x32_bf16(Bt[n][k], At[m][k], acc[ai][bj][m][n], 0, 0, 0); __builtin_amdgcn_s_setprio(0); } while (0)
#define PG8_WAIT_V(n) asm volatile("s_waitcnt vmcnt(" #n ")" ::: "memory")
#define PG8_WAIT_L(n) asm volatile("s_waitcnt lgkmcnt(" #n ")" ::: "memory")
#define PG8_BAR __builtin_amdgcn_s_barrier()
#define PG8_SCHED __builtin_amdgcn_sched_barrier(0)
    Unit cur, nxt; int ui = 0;
    if (!S.next(0, cur)) return;
    f32x4 acc[2][2][4][2];
#pragma unroll
    for (int a = 0; a < 2; ++a)
#pragma unroll
        for (int b = 0; b < 2; ++b)
#pragma unroll
            for (int m = 0; m < 4; ++m)
#pragma unroll
                for (int n = 0; n < 2; ++n) acc[a][b][m][n] = (f32x4){0.f, 0.f, 0.f, 0.f};
    bf16x8 At[4][2], B0[2][2], B1[2][2];
    const char* cA = (const char*)g.A + (size_t)cur.pm * tstepA; const char* cB = (const char*)g.Bt + (size_t)cur.pn * tstepB;
    PG8_STAGE(PG8_SB(0, 0), cB, voffB); PG8_STAGE(PG8_SB(0, 1), cB + hstepB, voffB); PG8_STAGE(PG8_SA(0, 0), cA, voffA); PG8_STAGE(PG8_SA(0, 1), cA + hstepA, voffA);
    if (wr == 1) PG8_BAR;
    PG8_WAIT_V(2); PG8_BAR;
    PG8_STAGE(PG8_SB(1, 0), cB + kstep, voffB); PG8_STAGE(PG8_SA(1, 0), cA + kstep, voffA); PG8_STAGE(PG8_SB(1, 1), cB + hstepB + kstep, voffB);
    PG8_WAIT_V(6); PG8_BAR;
    for (;;) {
        const bool has_next = S.next(ui + 1, nxt);
        const char* nA = has_next ? (const char*)g.A + (size_t)nxt.pm * tstepA : cA; const char* nB = has_next ? (const char*)g.Bt + (size_t)nxt.pn * tstepB : cB;
        for (int t = 0; t < nt; t += 2) {
            const bool last = (t == nt - 2);
            const char* a1 = cA + (size_t)(t + 1) * kstep;
            const char* a2 = last ? nA : cA + (size_t)(t + 2) * kstep; const char* b2 = last ? nB : cB + (size_t)(t + 2) * kstep;
            const char* a3 = a2 + kstep; const char* b3 = b2 + kstep;
            PG8_LDB(B0, 0, 0); PG8_LDB(B1, 0, 1); PG8_SCHED; PG8_LDA(At, 0, 0); PG8_STAGE(PG8_SA(1, 1), a1 + hstepA, voffA);
            PG8_WAIT_V(8); PG8_WAIT_L(0); PG8_BAR; PG8_MMA(0, 0, At, B0); PG8_MMA(0, 1, At, B1); PG8_BAR; PG8_SCHED;
            PG8_LDA(At, 0, 1); PG8_STAGE(PG8_SB(0, 0), b2, voffB); PG8_STAGE(PG8_SB(0, 1), b2 + hstepB, voffB); PG8_STAGE(PG8_SA(0, 0), a2, voffA);
            PG8_WAIT_V(8); PG8_WAIT_L(0); PG8_BAR; PG8_MMA(1, 0, At, B0); PG8_MMA(1, 1, At, B1); PG8_BAR; PG8_SCHED;
            PG8_LDB(B0, 1, 0); PG8_LDB(B1, 1, 1); PG8_SCHED; PG8_LDA(At, 1, 0); PG8_STAGE(PG8_SA(0, 1), a2 + hstepA, voffA);
            PG8_WAIT_V(8); PG8_WAIT_L(0); PG8_BAR; PG8_MMA(0, 0, At, B0); PG8_MMA(0, 1, At, B1); PG8_BAR; PG8_SCHED;
            PG8_LDA(At, 1, 1); PG8_STAGE(PG8_SB(1, 0), b3, voffB); PG8_STAGE(PG8_SB(1, 1), b3 + hstepB, voffB); PG8_STAGE(PG8_SA(1, 0), a3, voffA);
            PG8_WAIT_V(8); PG8_WAIT_L(0); PG8_BAR; PG8_MMA(1, 0, At, B0); PG8_MMA(1, 1, At, B1); PG8_BAR; PG8_SCHED;
        }
        if (wr == 0) PG8_BAR;
        E(acc, cur, wr, wc, fr, fq);
        if (!has_next) break;
#pragma unroll
        for (int a = 0; a < 2; ++a)
#pragma unroll
            for (int b = 0; b < 2; ++b)
#pragma unroll
                for (int m = 0; m < 4; ++m)
#pragma unroll
                    for (int n = 0; n < 2; ++n) acc[a][b][m][n] = (f32x4){0.f, 0.f, 0.f, 0.f};
        cur = nxt; cA = nA; cB = nB; ++ui;
        if (wr == 1) PG8_BAR;
    }
    PG8_WAIT_V(0);
    PG8_BAR;
#undef PG8_SA
#undef PG8_SB
#undef PG8_STAGE
#undef PG8_LDA
#undef PG8_LDB
#undef PG8_MMA
#undef PG8_WAIT_V
#undef PG8_WAIT_L
#undef PG8_BAR
#undef PG8_SCHED
}
}

struct FStoreBf16 {
    bf16_t* O; int ldc; int act;
    __device__ __forceinline__ void operator()(int row, int col, f32x4 a, f32x4 b) const {
        if (act == 1) { for (int i = 0; i < 4; ++i) { a[i] = fast_sigmoid(a[i]); b[i] = fast_sigmoid(b[i]); } }
        else if (act == 2) { for (int i = 0; i < 4; ++i) { float x = fmaxf(a[i], 0.f), y = fmaxf(b[i], 0.f); a[i] = x * x; b[i] = y * y; } }
        *(u32x4*)(O + (size_t)row * ldc + col) = pack8(a, b);
    }
};
struct FStoreVT {
    bf16_t* O;
    __device__ __forceinline__ void operator()(int row, int col, f32x4 a, f32x4 b) const {
        if (row < 512) { const int hk = row >> 7, d = row & 127; *(u32x4*)(O + (size_t)hk * ((size_t)T * 128) + ((size_t)(col >> 5) << 12) + (d >> 4) * 512 + (d & 15) * 32 + (col & 31)) = pack8(a, b); }
        else { const int hk = (row - 512) >> 7, d = row & 127; *(u32x4*)(O + (size_t)512 * T + (size_t)hk * ((size_t)T * 128) + ((size_t)(col >> 5) << 12) + (d >> 4) * 512 + (d & 15) * 32 + (col & 31)) = pack8(a, b); }
    }
};
struct FGeluBias {
    bf16_t* O; int ldc; const float* bias;
    __device__ __forceinline__ void operator()(int row, int col, f32x4 a, f32x4 b) const {
        const f32x4 b0 = *(const f32x4*)(bias + col), b1 = *(const f32x4*)(bias + col + 4);
        a = a + b0; b = b + b1;
        for (int i = 0; i < 4; ++i) {
            float x = a[i]; a[i] = x * __builtin_amdgcn_rcpf(1.f + __expf(-1.5957691216057308f * (x + 0.044715f * x * x * x)));
            float y = b[i]; b[i] = y * __builtin_amdgcn_rcpf(1.f + __expf(-1.5957691216057308f * (y + 0.044715f * y * y * y)));
        }
        *(u32x4*)(O + (size_t)row * ldc + col) = pack8(a, b);
    }
};
struct FMulInplace {
    bf16_t* O; int ldc;
    __device__ __forceinline__ void operator()(int row, int col, f32x4 a, f32x4 b) const {
        bf16_t* p = O + (size_t)row * ldc + col; f32x4 g0, g1; unpack8(*(const u32x4*)p, g0, g1);
        *(u32x4*)p = pack8(a * g0, b * g1);
    }
};
struct FMulAddInplace {
    bf16_t* O; const bf16_t* Y; int ldc;
    __device__ __forceinline__ void operator()(int row, int col, f32x4 a, f32x4 b) const {
        bf16_t* p = O + (size_t)row * ldc + col; f32x4 g0, g1, y0, y1; unpack8(*(const u32x4*)p, g0, g1); unpack8(*(const u32x4*)(Y + (size_t)row * ldc + col), y0, y1);
        *(u32x4*)p = pack8(a * g0 + y0, b * g1 + y1);
    }
};
struct FResidF32 {
    float* P; const float* X; int ldc;
    __device__ __forceinline__ void operator()(int row, int col, f32x4 a, f32x4 b) const {
        const size_t o = (size_t)row * ldc + col;
        const f32x4 x0 = *(const f32x4*)(X + o), x1 = *(const f32x4*)(X + o + 4);
        *(f32x4*)(P + o) = x0 * DN_ALPHA + a; *(f32x4*)(P + o + 4) = x1 * DN_ALPHA + b;
    }
};
struct FSigmoidF32 {
    float* P; int ldc;
    __device__ __forceinline__ void operator()(int row, int col, f32x4 a, f32x4 b) const {
        for (int i = 0; i < 4; ++i) { a[i] = fast_sigmoid(a[i]); b[i] = fast_sigmoid(b[i]); }
        const size_t o = (size_t)row * ldc + col; *(f32x4*)(P + o) = a; *(f32x4*)(P + o + 4) = b;
    }
};
struct FPle {
    float* P; const bf16_t* X; int ldc;
    __device__ __forceinline__ void operator()(int row, int col, f32x4 a, f32x4 b) const {
        const size_t o = (size_t)row * ldc + col; f32x4 x0, x1; unpack8(*(const u32x4*)(X + o), x0, x1);
        const f32x4 p0 = *(const f32x4*)(P + o), p1 = *(const f32x4*)(P + o + 4);
        *(f32x4*)(P + o) = a * p0 + x0 * DN_ALPHA; *(f32x4*)(P + o + 4) = b * p1 + x1 * DN_ALPHA;
    }
};
struct FAccF32 {
    float* P; int ldc;
    __device__ __forceinline__ void operator()(int row, int col, f32x4 a, f32x4 b) const {
        const size_t o = (size_t)row * ldc + col;
        *(f32x4*)(P + o) = *(const f32x4*)(P + o) + a; *(f32x4*)(P + o + 4) = *(const f32x4*)(P + o + 4) + b;
    }
};
struct EpiInProj {
    bf16_t *zz, *bg, *q, *kv, *sma; float* gates;
    __device__ __forceinline__ void operator()(const f32x4 (&acc)[2][2][4][2], const pg8::Unit& u, int wr, int wc, int fr, int fq) const {
        const int row0 = u.pm * 256 + wr * 64 + fr, cw = wc * 32 + 8 * fq; const int pn = u.pn;
        if (pn < 16) {
#pragma unroll
            for (int ai = 0; ai < 2; ++ai)
#pragma unroll
                for (int m = 0; m < 4; ++m) { const int row = row0 + ai * 128 + m * 16;
                    *(u32x4*)(zz + (size_t)row * D + pn * 128 + cw) = pack8(acc[ai][0][m][0] * acc[ai][1][m][0], acc[ai][0][m][1] * acc[ai][1][m][1]); }
        } else if (pn < 32) {
            bf16_t* O = (pn < 24) ? bg : q; const int c0 = ((pn - 16) & 7) * 256 + cw;
#pragma unroll
            for (int ai = 0; ai < 2; ++ai)
#pragma unroll
                for (int m = 0; m < 4; ++m) { const int row = row0 + ai * 128 + m * 16;
#pragma unroll
                    for (int bj = 0; bj < 2; ++bj) *(u32x4*)(O + (size_t)row * D + c0 + bj * 128) = pack8(acc[ai][bj][m][0], acc[ai][bj][m][1]); }
        } else if (pn < 40) {
            const int c0 = (pn - 32) * 256; const int b = c0 >> 9, h0 = (c0 & 511) >> 7;
            bf16_t* O = kv + (size_t)b * ((size_t)T * 512);
#pragma unroll
            for (int ai = 0; ai < 2; ++ai)
#pragma unroll
                for (int m = 0; m < 4; ++m) { const int row = row0 + ai * 128 + m * 16;
#pragma unroll
                    for (int bj = 0; bj < 2; ++bj) {
                        const size_t off = (b >= 2) ? (((size_t)(row >> 5) << 12) + ((row >> 2) & 1) * 2048 + (cw >> 5) * 512 + (4 * ((row & 31) >> 3) + (row & 3)) * 32 + (cw & 31))
                                                    : ((size_t)row * 128 + cw);
                        *(u32x4*)(O + (size_t)(h0 + bj) * ((size_t)T * 128) + off) = pack8(acc[ai][bj][m][0], acc[ai][bj][m][1]); } }
        } else if (pn < 48) {
            const int c0 = (pn - 40) * 256 + cw;
#pragma unroll
            for (int ai = 0; ai < 2; ++ai)
#pragma unroll
                for (int m = 0; m < 4; ++m) { const int row = row0 + ai * 128 + m * 16;
#pragma unroll
                    for (int bj = 0; bj < 2; ++bj) { f32x4 a = acc[ai][bj][m][0], b = acc[ai][bj][m][1];
                        for (int i = 0; i < 4; ++i) { a[i] = fast_sigmoid(a[i]); b[i] = fast_sigmoid(b[i]); }
                        *(u32x4*)(sma + (size_t)row * D + c0 + bj * 128) = pack8(a, b); } }
        } else {
            if (cw < 48) {
#pragma unroll
                for (int ai = 0; ai < 2; ++ai)
#pragma unroll
                    for (int m = 0; m < 4; ++m) { const int row = row0 + ai * 128 + m * 16; f32x4 a = acc[ai][0][m][0], b = acc[ai][0][m][1];
                        for (int i = 0; i < 4; ++i) { a[i] = fast_sigmoid(a[i]); b[i] = fast_sigmoid(b[i]); }
                        *(f32x4*)(gates + (size_t)row * 48 + cw) = a; *(f32x4*)(gates + (size_t)row * 48 + cw + 4) = b; }
            }
        }
    }
};

struct Args {
    const float* in[22]; float* out; unsigned char* ws; int ph_lo, ph_hi, G, pad;
};

struct Ctx { int tid, lane, wave, gw, NGW, gtid, NT; LAS unsigned char* lds; };

__device__ __forceinline__ void tr_item(const float* W, int ldw, int k0, int nsrc0, bf16_t* WT, int ldt, int drow0, LAS float* scr, int lane) {
#pragma unroll 8
    for (int i = 0; i < 32; ++i) { const int kk = 2 * i + (lane >> 5); scr[kk * 33 + (lane & 31)] = W[(size_t)(k0 + kk) * ldw + nsrc0 + (lane & 31)]; }
    asm volatile("s_waitcnt lgkmcnt(0)" ::: "memory");
    const int c = lane & 7;
#pragma unroll
    for (int j = 0; j < 4; ++j) { const int n = (lane >> 3) + 8 * j; const LAS float* s = scr + (8 * c) * 33 + n;
        u32x4 o; o.x = cvt_pk_bf16(s[0 * 33], s[1 * 33]); o.y = cvt_pk_bf16(s[2 * 33], s[3 * 33]); o.z = cvt_pk_bf16(s[4 * 33], s[5 * 33]); o.w = cvt_pk_bf16(s[6 * 33], s[7 * 33]);
        *(u32x4*)(WT + (size_t)(drow0 + n) * ldt + k0 + 8 * c) = o; }
    asm volatile("s_waitcnt lgkmcnt(0)" ::: "memory");
}
__device__ __forceinline__ void tr_job(const Ctx& C, const float* W, int K, int ldw, int ncol0, int ncols, bf16_t* WT, int ldt, int drow0, int grp, int grp_stride) {
    LAS float* scr = (LAS float*)(C.lds + C.wave * 16384);
    const int nblk = ncols / 32, items = (K / 64) * nblk;
    for (int it = C.gw; it < items; it += C.NGW) {
        const int kb = it / nblk, n = (it % nblk) * 32; const int drow = drow0 + (n / grp) * grp_stride + (n % grp);
        tr_item(W, ldw, kb * 64, ncol0 + n, WT, ldt, drow, scr, C.lane);
    }
}
__device__ __forceinline__ void cvt_job(const Ctx& C, const float* X, bf16_t* O, size_t n8) {
    for (size_t i = C.gtid; i < n8; i += C.NT) { const f32x4 a = *(const f32x4*)(X + i * 8), b = *(const f32x4*)(X + i * 8 + 4); *(u32x4*)(O + i * 8) = pack8(a, b); }
}

template <bool OUT_BF16>
__device__ __forceinline__ void ln_rows(const Ctx& C, const float* P, const float* gam, const float* bet, void* outp) {
    for (int r = C.gw; r < T; r += C.NGW) {
        const f32x4* xr = (const f32x4*)(P + (size_t)r * D) + C.lane;
        f32x4 v[8]; float s = 0.f;
#pragma unroll
        for (int j = 0; j < 8; ++j) { v[j] = xr[64 * j]; s += (v[j][0] + v[j][1]) + (v[j][2] + v[j][3]); }
#pragma unroll
        for (int o = 1; o < 64; o <<= 1) s += __shfl_xor(s, o);
        const float mean = s * (1.f / D); float s2 = 0.f;
#pragma unroll
        for (int j = 0; j < 8; ++j) { v[j] = v[j] - mean; s2 += (v[j][0] * v[j][0] + v[j][1] * v[j][1]) + (v[j][2] * v[j][2] + v[j][3] * v[j][3]); }
#pragma unroll
        for (int o = 1; o < 64; o <<= 1) s2 += __shfl_xor(s2, o);
        const float rstd = 1.f / sqrtf(s2 * (1.f / D) + LN_EPS);
#pragma unroll
        for (int j = 0; j < 8; ++j) {
            const f32x4 gg = *((const f32x4*)gam + C.lane + 64 * j), bb = *((const f32x4*)bet + C.lane + 64 * j);
            const f32x4 y = v[j] * rstd * gg + bb;
            if (OUT_BF16) { u32x2 w; w.x = cvt_pk_bf16(y[0], y[1]); w.y = cvt_pk_bf16(y[2], y[3]); *((u32x2*)((bf16_t*)outp + (size_t)r * D) + C.lane + 64 * j) = w; }
            else *((f32x4*)((float*)outp + (size_t)r * D) + C.lane + 64 * j) = y;
        }
    }
}

constexpr float SC_LOG2E = 0.08838834764831845f * 1.4426950408889634f;
__device__ __forceinline__ int rel_bucket(int n) {
    const int e = 31 - __builtin_clz((unsigned)(n | 1));
    const int odd = ((unsigned)n * (unsigned)n >= (1u << (2 * e + 1))) ? 1 : 0;
    const int lg = min(31, 8 + 2 * e + odd);
    return n < 16 ? n : lg;
}
template <int MODE>
__device__ __forceinline__ void att_step(const bf16_t* __restrict__ Kp, const bf16_t* __restrict__ VTp, int ldv, int key0, int tq, bool colok,
                                         const bf16x8 (&qf)[4], float& m, float& lsum, f32x4 (&O)[8], float inv_l,
                                         const LAS float* tab, int hd16, LAS float* impq, int g, int fr) {
    bf16x8 ka[4], kb[4], vf[8];
    {
        const bf16_t* kq = Kp + ((size_t)(key0 >> 5) << 12) + fr * 32 + 8 * g;
#pragma unroll
        for (int dc = 0; dc < 4; ++dc) { ka[dc] = *(const bf16x8*)(kq + dc * 512); kb[dc] = *(const bf16x8*)(kq + 2048 + dc * 512); }
        if (MODE != 0) { const bf16_t* vq = VTp + ((size_t)(key0 >> 5) << 12) + fr * 32 + 8 * g;
#pragma unroll
            for (int dt = 0; dt < 8; ++dt) vf[dt] = *(const bf16x8*)(vq + dt * 512); }
    }
    f32x4 sa = {0.f, 0.f, 0.f, 0.f}, sb = {0.f, 0.f, 0.f, 0.f};
#pragma unroll
    for (int dc = 0; dc < 4; ++dc) { sa = __builtin_amdgcn_mfma_f32_16x16x32_bf16(ka[dc], qf[dc], sa, 0, 0, 0); sb = __builtin_amdgcn_mfma_f32_16x16x32_bf16(kb[dc], qf[dc], sb, 0, 0, 0); }
    float s[8]; bool ok[8];
#pragma unroll
    for (int e = 0; e < 8; ++e) {
        const int idx = key0 + 8 * g + e;
        const int dist = (MODE < 2) ? (tq - 31 - 16 * idx) : (tq - idx);
        ok[e] = (MODE < 2) ? (dist >= 0) : (MODE == 2 ? (dist >= 0 && dist < 512) : (dist >= 0 && colok));
        const int bk = rel_bucket(max(dist, 0));
        const float sv = (e < 4 ? sa[e & 3] : sb[e & 3]) * SC_LOG2E + tab[bk * 16 + hd16];
        s[e] = ok[e] ? sv : -1e30f;
    }
    float p[8];
    if (MODE != 1) {
        float mx = fmaxf(fmaxf(fmaxf(s[0], s[1]), fmaxf(s[2], s[3])), fmaxf(fmaxf(s[4], s[5]), fmaxf(s[6], s[7])));
        mx = fmaxf(mx, __shfl_xor(mx, 16)); mx = fmaxf(mx, __shfl_xor(mx, 32));
        const float mn = fmaxf(m, mx); const float alpha = __builtin_amdgcn_exp2f(m - mn); m = mn;
        float ps = 0.f;
#pragma unroll
        for (int e = 0; e < 8; ++e) { p[e] = ok[e] ? __builtin_amdgcn_exp2f(s[e] - mn) : 0.f; ps += p[e]; }
        lsum = lsum * alpha + ps;
        if (MODE != 0) {
#pragma unroll
            for (int dt = 0; dt < 8; ++dt) O[dt] = O[dt] * alpha;
        }
    } else {
#pragma unroll
        for (int e = 0; e < 8; ++e) p[e] = ok[e] ? __builtin_amdgcn_exp2f(s[e] - m) * inv_l : 0.f;
        const int G2 = (key0 >> 2) + 2 * g;
        atomicAdd((float*)(impq + G2), (p[0] + p[1]) + (p[2] + p[3]));
        atomicAdd((float*)(impq + G2 + 1), (p[3] + p[4]) + (p[5] + p[6]) + p[7]);
        atomicAdd((float*)(impq + G2 + 2), p[7]);
    }
    if (MODE != 0) {
        u32x4 pw; pw.x = cvt_pk_bf16(p[0], p[1]); pw.y = cvt_pk_bf16(p[2], p[3]); pw.z = cvt_pk_bf16(p[4], p[5]); pw.w = cvt_pk_bf16(p[6], p[7]);
        const bf16x8 pf = __builtin_bit_cast(bf16x8, pw);
#pragma unroll
        for (int dt = 0; dt < 8; ++dt) O[dt] = __builtin_amdgcn_mfma_f32_16x16x32_bf16(vf[dt], pf, O[dt], 0, 0, 0);
    }
}

constexpr int IMP_STRIDE = 264;
__device__ __forceinline__ void attention_phase(const Ctx& C, bf16_t* qo, const bf16_t* kc, const bf16_t* vcT, const bf16_t* ks, const bf16_t* vsT,
                                                const bf16_t* kw, const bf16_t* vwT, const float* gates, const float* rel_bias) {
    LAS float* tab = (LAS float*)C.lds;
    LAS float* imp = (LAS float*)(C.lds + 4096 + C.wave * 8192);
    LAS int* lst = (LAS int*)(C.lds + 4096 + C.wave * 8192 + 4 * IMP_STRIDE * 4);
    for (int i = C.tid; i < 512; i += NWAVES * 64) tab[i] = rel_bias[i] * 1.4426950408889634f;
    __syncthreads();
    const int lane = C.lane, fr = lane & 15, g = lane >> 4, qi = fr >> 2, hd = fr & 3;
    const int hk = (int)(blockIdx.x & 3), wl = (int)(blockIdx.x >> 2) * NWAVES + C.wave, nwl = C.NGW >> 2;
    for (int qg = wl; qg < T / 4; qg += nwl) {
        const int t0 = qg * 4, tq = t0 + qi, head = hk * 4 + hd, jt = t0 >> 6;
        bf16x8 qf[4];
        { const bf16_t* qp = qo + (size_t)tq * D + head * HD + 8 * g;
#pragma unroll
          for (int dc = 0; dc < 4; ++dc) qf[dc] = *(const bf16x8*)(qp + dc * 32); }
        const float g0 = gates[(size_t)tq * 48 + head * 3 + 0], g1 = gates[(size_t)tq * 48 + head * 3 + 1], g2 = gates[(size_t)tq * 48 + head * 3 + 2];
        f32x4 OA[8];
#pragma unroll
        for (int dt = 0; dt < 8; ++dt) OA[dt] = (f32x4){0.f, 0.f, 0.f, 0.f};
        f32x4 O[8];
        for (int i = lane; i < 4 * IMP_STRIDE; i += 64) imp[i] = 0.f;
        __builtin_amdgcn_wave_barrier(); asm volatile("s_waitcnt lgkmcnt(0)" ::: "memory");
        const bf16_t* Kc = kc + (size_t)hk * NCMP * HD; const bf16_t* Vc = vcT + (size_t)hk * HD * NCMP;
        const int ncv = (t0 + 3 >= 31) ? ((t0 + 3 - 31) >> 4) + 1 : 0;
        const int nst = (ncv + 31) >> 5;
        {
            float m = -1e30f, lsum = 0.f;
            for (int st = 0; st < nst; ++st) att_step<0>(Kc, Vc, NCMP, st * 32, tq, true, qf, m, lsum, O, 0.f, tab, hd + 0 * 16 + (hk * 4), imp + qi * IMP_STRIDE, g, fr);
            float l = lsum; l += __shfl_xor(l, 16); l += __shfl_xor(l, 32);
            const float inv = l > 0.f ? 1.f / l : 0.f;
#pragma unroll
            for (int dt = 0; dt < 8; ++dt) O[dt] = (f32x4){0.f, 0.f, 0.f, 0.f};
            for (int st = 0; st < nst; ++st) att_step<1>(Kc, Vc, NCMP, st * 32, tq, true, qf, m, lsum, O, inv, tab, hd + hk * 4, imp + qi * IMP_STRIDE, g, fr);
#pragma unroll
            for (int dt = 0; dt < 8; ++dt) OA[dt] = OA[dt] + O[dt] * g0;
        }
        __builtin_amdgcn_wave_barrier(); asm volatile("s_waitcnt lgkmcnt(0)" ::: "memory");
        int nlist = 0;
        const int ncand = jt - 2;
        if (ncand <= 13) {
            if (lane <= jt) lst[lane] = lane | (0xF << 16);
            nlist = jt + 1;
        } else {
            if (lane == 0) { lst[0] = 0 | (0xF << 16); lst[1] = (jt - 1) | (0xF << 16); lst[2] = jt | (0xF << 16); }
            nlist = 3;
            for (int qq = 0; qq < 4; ++qq) {
                float v[4];
#pragma unroll
                for (int k = 0; k < 4; ++k) { const int sblk = 4 * lane + k; const float x = imp[qq * IMP_STRIDE + sblk]; v[k] = (sblk >= 1 && sblk <= jt - 2) ? x : -1.f; }
                for (int r = 0; r < 13; ++r) {
                    float lm = fmaxf(fmaxf(v[0], v[1]), fmaxf(v[2], v[3]));
                    float wm = lm;
#pragma unroll
                    for (int o = 1; o < 64; o <<= 1) wm = fmaxf(wm, __shfl_xor(wm, o));
                    const unsigned long long bal = __ballot(lm == wm);
                    const int src = __ffsll((long long)bal) - 1;
                    if (lane == src) {
                        int k = (v[0] == wm) ? 0 : (v[1] == wm) ? 1 : (v[2] == wm) ? 2 : 3;
                        if (k == 0) v[0] = -2.f; else if (k == 1) v[1] = -2.f; else if (k == 2) v[2] = -2.f; else v[3] = -2.f;
                        lst[nlist + r] = (4 * lane + k) | ((1 << qq) << 16);
                    }
                }
                nlist += 13;
            }
        }
        __builtin_amdgcn_wave_barrier(); asm volatile("s_waitcnt lgkmcnt(0)" ::: "memory");
        {
            const bf16_t* Ks = ks + (size_t)hk * T * HD; const bf16_t* Vs = vsT + (size_t)hk * T * HD;
            float m = -1e30f, lsum = 0.f;
#pragma unroll
            for (int dt = 0; dt < 8; ++dt) O[dt] = (f32x4){0.f, 0.f, 0.f, 0.f};
            for (int i = 0; i < nlist; ++i) {
                const int ent = __builtin_amdgcn_readfirstlane(lst[i]);
                const int blk = ent & 0xffff; const bool colok = ((ent >> (16 + qi)) & 1) != 0;
                att_step<3>(Ks, Vs, 0, blk * 64, tq, colok, qf, m, lsum, O, 0.f, tab, hd + hk * 4, imp, g, fr);
                att_step<3>(Ks, Vs, 0, blk * 64 + 32, tq, colok, qf, m, lsum, O, 0.f, tab, hd + hk * 4, imp, g, fr);
            }
            float l = lsum; l += __shfl_xor(l, 16); l += __shfl_xor(l, 32);
            const float sc = (l > 0.f ? 1.f / l : 0.f) * g1;
#pragma unroll
            for (int dt = 0; dt < 8; ++dt) OA[dt] = OA[dt] + O[dt] * sc;
        }
        {
            const bf16_t* Kw = kw + (size_t)hk * T * HD; const bf16_t* Vw = vwT + (size_t)hk * HD * T;
            float m = -1e30f, lsum = 0.f;
#pragma unroll
            for (int dt = 0; dt < 8; ++dt) O[dt] = (f32x4){0.f, 0.f, 0.f, 0.f};
            const int kstart = max(0, t0 - 511) & ~31;
            for (int k0 = kstart; k0 <= t0 + 3; k0 += 32) att_step<2>(Kw, Vw, T, k0, tq, true, qf, m, lsum, O, 0.f, tab, hd + hk * 4, imp, g, fr);
            float l = lsum; l += __shfl_xor(l, 16); l += __shfl_xor(l, 32);
            const float sc = (l > 0.f ? 1.f / l : 0.f) * g2;
#pragma unroll
            for (int dt = 0; dt < 8; ++dt) OA[dt] = OA[dt] + O[dt] * sc;
        }
        { bf16_t* op = qo + (size_t)tq * D + head * HD + 4 * g;
#pragma unroll
          for (int dt = 0; dt < 8; ++dt) { u32x2 w; w.x = cvt_pk_bf16(OA[dt][0], OA[dt][1]); w.y = cvt_pk_bf16(OA[dt][2], OA[dt][3]); *(u32x2*)(op + dt * 16) = w; } }
        __builtin_amdgcn_wave_barrier(); asm volatile("s_waitcnt lgkmcnt(0)" ::: "memory");
    }
}

__global__ void __launch_bounds__(NWAVES * 64, 2) fwd_megakernel(Args args) {
    extern __shared__ __attribute__((aligned(16))) unsigned char lds_raw[];
    __builtin_assume(__builtin_amdgcn_workitem_id_y() == 0); __builtin_assume(__builtin_amdgcn_workitem_id_z() == 0);
    cg::grid_group grid = cg::this_grid();
    Ctx C; C.lds = (LAS unsigned char*)lds_raw; C.tid = threadIdx.x; C.lane = C.tid & 63; C.wave = __builtin_amdgcn_readfirstlane(C.tid >> 6);
    const int G = args.G, bx = blockIdx.x;
    C.gw = bx * NWAVES + C.wave; C.NGW = G * NWAVES; C.gtid = bx * (NWAVES * 64) + C.tid; C.NT = G * NWAVES * 64;
    unsigned char* ws = args.ws;
#define x_in (args.in[0])
#define pin (args.in[1])
#define w_in (args.in[2])
#define conv_w (args.in[3])
#define pe_k (args.in[4])
#define w1_k (args.in[5])
#define w2_k (args.in[6])
#define pe_v (args.in[7])
#define w1_v (args.in[8])
#define w2_v (args.in[9])
#define w_conv_out (args.in[10])
#define w_attn_out (args.in[11])
#define w_mix_out (args.in[12])
#define ln1_g (args.in[13])
#define ln1_b (args.in[14])
#define w_up (args.in[15])
#define w_down (args.in[16])
#define w_ple (args.in[17])
#define w_ple_gate (args.in[18])
#define ln2_g (args.in[19])
#define ln2_b (args.in[20])
#define rel_bias (args.in[21])
#define BP(off) ((bf16_t*)(ws + (off)))
#define FP(off) ((float*)(ws + (off)))
#define XB BP(WS_XB)
#define WTIN BP(WS_WTIN)
#define WTVT BP(WS_WTVT)
#define WTMB BP(WS_WTMB)
#define W1K BP(WS_W1K)
#define W1V BP(WS_W1V)
#define BIASK FP(WS_BIASK)
#define BIASV FP(WS_BIASV)
#define HIDK BP(WS_HIDK)
#define HIDV BP(WS_HIDV)
#define KC BP(WS_KC)
#define VCT BP(WS_VCT)
#define GATES FP(WS_GATES)
#define BG BP(WS_BG)
#define ZZ BP(WS_ZZ)
#define Q BP(WS_Q)
#define KCS BP(WS_KCS)
#define VCS BP(WS_VCS)
#define KS BP(WS_KS)
#define KW BP(WS_KW)
#define VST BP(WS_VST)
#define VWT BP(WS_VWT)
#define SMA BP(WS_SMA)
#define SMB BP(WS_SMB)
#define WTCONV BP(WS_WTCONV)
#define WTATTN BP(WS_WTATTN)
#define WTMIX BP(WS_WTMIX)
#define WTGATE BP(WS_WTGATE)
#define WTPLE BP(WS_WTPLE)
#define PB BP(WS_PB)
#define WTUP BP(WS_WTUP)
#define WTDOWN BP(WS_WTDOWN)
#define PRE1 FP(WS_PRE1)
#define PRE2 FP(WS_PRE2)
#define X1B BP(WS_X1B)
#define H1 BP(WS_H1)
    const int lo = args.ph_lo, hi = args.ph_hi;
    unsigned* gbar = (unsigned*)(ws + 16384); int nbar = 0;
    if (lo == 12345) grid.sync();
#ifndef PHMASK
#define PHMASK 0xFFFF
#endif
#define IN(k) (((PHMASK >> (k)) & 1) && lo <= (k) && (k) < hi)
#define SEAM(k) do { if (IN(k) && IN((k) + 1)) { ++nbar; \
        asm volatile("s_waitcnt vmcnt(0) lgkmcnt(0)" ::: "memory"); __syncthreads(); \
        if (C.tid == 0) { __builtin_amdgcn_fence(__ATOMIC_RELEASE, "agent"); asm volatile("s_waitcnt vmcnt(0)" ::: "memory"); \
            __hip_atomic_fetch_add(gbar, 1u, __ATOMIC_RELAXED, __HIP_MEMORY_SCOPE_AGENT); \
            while (__hip_atomic_load(gbar, __ATOMIC_RELAXED, __HIP_MEMORY_SCOPE_AGENT) < (unsigned)(nbar * G)) __builtin_amdgcn_s_sleep(2); \
            __builtin_amdgcn_fence(__ATOMIC_ACQUIRE, "agent"); asm volatile("s_waitcnt vmcnt(0)" ::: "memory"); } \
        __syncthreads(); \
        __builtin_amdgcn_fence(__ATOMIC_ACQUIRE, "agent"); asm volatile("s_waitcnt vmcnt(0)" ::: "memory"); } } while (0)

    if (IN(0)) {
        cvt_job(C, x_in, XB, (size_t)T * D / 8);
        tr_job(C, w_in, D, NIN, 2048, 2048, WTIN, D, 0, 128, 256);
        tr_job(C, w_in, D, NIN, 4096, 2048, WTIN, D, 128, 128, 256);
        tr_job(C, w_in, D, NIN, 0, 2048, WTIN, D, 4096, 2048, 0);
        tr_job(C, w_in, D, NIN, 6144, 2048, WTIN, D, 6144, 2048, 0);
        tr_job(C, w_in, D, NIN, 8192, 512, WTIN, D, 8192, 512, 0);
        tr_job(C, w_in, D, NIN, 8704, 512, WTIN, D, 8704, 512, 0);
        tr_job(C, w_in, D, NIN, 9216, 512, WTIN, D, 9216, 512, 0);
        tr_job(C, w_in, D, NIN, 10240, 512, WTIN, D, 9728, 512, 0);
        tr_job(C, w_in, D, NIN, 11312, 2048, WTIN, D, 10240, 2048, 0);
        tr_job(C, w_in, D, NIN, 9728, 512, WTVT, D, 0, 512, 0);
        tr_job(C, w_in, D, NIN, 10752, 512, WTVT, D, 512, 512, 0);
        tr_job(C, w_in, D, NIN, 13360, 2048, WTMB, D, 0, 2048, 0);
        tr_job(C, w1_k, 4096, 256, 0, 256, W1K, 4096, 0, 256, 0);
        tr_job(C, w1_v, 4096, 256, 0, 256, W1V, 4096, 0, 256, 0);
        for (int i = C.gtid; i < 256 * D; i += C.NT) { const int r = i / D, k = i % D; const float v = (r < 48) ? w_in[(size_t)k * NIN + 11264 + r] : 0.f; WTIN[(size_t)(12288 + r) * D + k] = (bf16_t)(cvt_pk_bf16(v, 0.f) & 0xffff); }
        if (bx == G - 1) {
            const int n = C.tid & 255; const float* pe = (C.tid < 256) ? pe_k : pe_v; const float* w1 = (C.tid < 256) ? w1_k : w1_v; float s = 0.f;
            for (int j = 0; j < 4096; ++j) s += pe[j] * w1[(size_t)j * 256 + n];
            ((C.tid < 256) ? BIASK : BIASV)[n] = s;
        }
        asm volatile("s_waitcnt vmcnt(0) lgkmcnt(0)" ::: "memory"); __syncthreads();
    }
    SEAM(0);
    if (IN(1)) {
        { pg8::Gemm g{XB, WTIN, T, 12544, D, D, D}; pg8::StaticOrder S; S.init(T, 12544, G, bx);
          EpiInProj E{ZZ, BG, Q, KCS, SMA, GATES};
          pg8::gemm_phase(C.lds, g, S, E); }
        { pg8::Gemm g{WTVT, XB, 1024, T, D, D, D}; pg8::StaticOrder S; S.init(1024, T, G, (bx + 64) % G);
          pg8::EpiGen<FStoreVT> E{{VST}};
          pg8::gemm_phase(C.lds, g, S, E); }
    }
    SEAM(1);
    if (IN(2)) {
        if (bx < 32) {
            { pg8::Gemm g{KCS, W1K, 4096, 256, 4096, 2048, 4096}; pg8::StaticOrder S; S.init(4096, 256, G, bx < 16 ? bx : -1); S.G = 16;
              pg8::EpiGen<FGeluBias> E{{HIDK, 256, BIASK}}; pg8::gemm_phase(C.lds, g, S, E); }
            { pg8::Gemm g{VCS, W1V, 4096, 256, 4096, 2048, 4096}; pg8::StaticOrder S; S.init(4096, 256, G, (bx >= 16 && bx < 32) ? bx - 16 : -1); S.G = 16;
              pg8::EpiGen<FGeluBias> E{{HIDV, 256, BIASV}}; pg8::gemm_phase(C.lds, g, S, E); }
        } else
        for (size_t i = (size_t)(bx - 32) * (NWAVES * 64) + C.tid; i < (size_t)T * D / 8; i += (size_t)(G - 32) * (NWAVES * 64)) {
            const int t = (int)(i / (D / 8)), c8 = (int)(i % (D / 8)) * 8;
            f32x4 z0a, z0b, z1a = {0.f, 0.f, 0.f, 0.f}, z1b = z1a, z2a = z1a, z2b = z1a, ba, bb;
            unpack8(*(const u32x4*)(ZZ + (size_t)t * D + c8), z0a, z0b);
            if (t >= 1) unpack8(*(const u32x4*)(ZZ + (size_t)(t - 1) * D + c8), z1a, z1b);
            if (t >= 2) unpack8(*(const u32x4*)(ZZ + (size_t)(t - 2) * D + c8), z2a, z2b);
            unpack8(*(const u32x4*)(BG + (size_t)t * D + c8), ba, bb);
            const f32x4 w0a = *(const f32x4*)(conv_w + c8), w0b = *(const f32x4*)(conv_w + c8 + 4);
            const f32x4 w1a = *(const f32x4*)(conv_w + D + c8), w1b = *(const f32x4*)(conv_w + D + c8 + 4);
            const f32x4 w2a = *(const f32x4*)(conv_w + 2 * D + c8), w2b = *(const f32x4*)(conv_w + 2 * D + c8 + 4);
            const f32x4 ua = ba * (w0a * z2a + w1a * z1a + w2a * z0a), ub = bb * (w0b * z2b + w1b * z1b + w2b * z0b);
            *(u32x4*)(BG + (size_t)t * D + c8) = pack8(ua, ub);
        }
    }
    SEAM(2);
    if (IN(3)) {
        { pg8::Gemm g{XB, WTMB, T, D, D, D, D}; pg8::StaticOrder S; S.init(T, D, G, bx);
          pg8::EpiGen<FStoreBf16> E{{SMB, D, 1}}; pg8::gemm_phase(C.lds, g, S, E); }
    }
    SEAM(3);
    if (IN(4)) {
        for (int i = C.gtid; i < 4096 * HD; i += C.NT) {
            const int d = i & 127, row = i >> 7; const bf16_t* hp = HIDK + (size_t)row * 256; float s = 0.f;
            for (int j = 0; j < 256; j += 2) { const unsigned w = *(const unsigned*)(hp + j); s += bf_lo(w) * w2_k[(size_t)j * HD + d] + bf_hi(w) * w2_k[(size_t)(j + 1) * HD + d]; }
            { const int h = row >> 10, c = row & 1023; KC[(size_t)h * 131072 + ((size_t)(c >> 5) << 12) + ((c >> 2) & 1) * 2048 + (d >> 5) * 512 + (4 * ((c & 31) >> 3) + (c & 3)) * 32 + (d & 31)] = (bf16_t)(cvt_pk_bf16(s, 0.f) & 0xffff); }
        }
        for (int i = C.gtid; i < 4096 * HD; i += C.NT) {
            const int ii = i & 1023, d = (i >> 10) & 127, h = i >> 17; const bf16_t* hp = HIDV + (size_t)(h * 1024 + ii) * 256; float s = 0.f;
            for (int j = 0; j < 256; j += 2) { const unsigned w = *(const unsigned*)(hp + j); s += bf_lo(w) * w2_v[(size_t)j * HD + d] + bf_hi(w) * w2_v[(size_t)(j + 1) * HD + d]; }
            VCT[(size_t)h * 131072 + ((size_t)(ii >> 5) << 12) + (d >> 4) * 512 + (d & 15) * 32 + (ii & 31)] = (bf16_t)(cvt_pk_bf16(s, 0.f) & 0xffff);
        }
        tr_job(C, w_conv_out, D, D, 0, D, WTCONV, D, 0, D, 0);
        tr_job(C, w_attn_out, D, D, 0, D, WTATTN, D, 0, D, 0);
        tr_job(C, w_mix_out, D, D, 0, D, WTMIX, D, 0, D, 0);
        tr_job(C, w_ple_gate, D, D, 0, D, WTGATE, D, 0, D, 0);
        tr_job(C, w_ple, PLE, D, 0, D, WTPLE, PLE, 0, D, 0);
        tr_job(C, w_up, D, FF, 0, FF, WTUP, D, 0, FF, 0);
        tr_job(C, w_down, FF, D, 0, D, WTDOWN, FF, 0, D, 0);
        cvt_job(C, pin, PB, (size_t)T * PLE / 8);
        asm volatile("s_waitcnt vmcnt(0) lgkmcnt(0)" ::: "memory"); __syncthreads();
    }
    SEAM(4);
    if (IN(5)) {
        attention_phase(C, Q, KC, VCT, KS, VST, KW, VWT, GATES, rel_bias);
        asm volatile("s_waitcnt vmcnt(0) lgkmcnt(0)" ::: "memory"); __syncthreads();
    }
    SEAM(5);
    if (IN(6)) { pg8::Gemm g{BG, WTCONV, T, D, D, D, D}; pg8::StaticOrder S; S.init(T, D, G, bx); pg8::EpiGen<FMulInplace> E{{SMA, D}}; pg8::gemm_phase(C.lds, g, S, E); }
    SEAM(6);
    if (IN(7)) { pg8::Gemm g{Q, WTATTN, T, D, D, D, D}; pg8::StaticOrder S; S.init(T, D, G, bx); pg8::EpiGen<FMulAddInplace> E{{SMB, SMA, D}}; pg8::gemm_phase(C.lds, g, S, E); }
    SEAM(7);
    if (IN(8)) { pg8::Gemm g{SMB, WTMIX, T, D, D, D, D}; pg8::StaticOrder S; S.init(T, D, G, bx); pg8::EpiGen<FResidF32> E{{PRE1, x_in, D}}; pg8::gemm_phase(C.lds, g, S, E); }
    SEAM(8);
    if (IN(9)) ln_rows<true>(C, PRE1, ln1_g, ln1_b, X1B);
    SEAM(9);
    if (IN(10)) {
        { pg8::Gemm g{X1B, WTGATE, T, D, D, D, D}; pg8::StaticOrder S; S.init(T, D, G, bx); pg8::EpiGen<FSigmoidF32> E{{PRE2, D}}; pg8::gemm_phase(C.lds, g, S, E); }
        { pg8::Gemm g{X1B, WTUP, T / 2, FF, D, D, D}; pg8::StaticOrder S; S.init(T / 2, FF, G, bx); pg8::EpiGen<FStoreBf16> E{{H1, FF, 2}}; pg8::gemm_phase(C.lds, g, S, E); }
    }
    SEAM(10);
    if (IN(11)) { pg8::Gemm g{PB, WTPLE, T, D, PLE, PLE, PLE}; pg8::StaticOrder S; S.init(T, D, G, bx); pg8::EpiGen<FPle> E{{PRE2, X1B, D}}; pg8::gemm_phase(C.lds, g, S, E); }
    SEAM(11);
    if (IN(12)) { pg8::Gemm g{H1, WTDOWN, T / 2, D, FF, FF, FF}; pg8::StaticOrder S; S.init(T / 2, D, G, bx); pg8::EpiGen<FAccF32> E{{PRE2, D}}; pg8::gemm_phase(C.lds, g, S, E); }
    SEAM(12);
    if (IN(13)) { pg8::Gemm g{X1B + (size_t)(T / 2) * D, WTUP, T / 2, FF, D, D, D}; pg8::StaticOrder S; S.init(T / 2, FF, G, bx); pg8::EpiGen<FStoreBf16> E{{H1, FF, 2}}; pg8::gemm_phase(C.lds, g, S, E); }
    SEAM(13);
    if (IN(14)) { pg8::Gemm g{H1, WTDOWN, T / 2, D, FF, FF, FF}; pg8::StaticOrder S; S.init(T / 2, D, G, bx); pg8::EpiGen<FAccF32> E{{PRE2 + (size_t)(T / 2) * D, D}}; pg8::gemm_phase(C.lds, g, S, E); }
    SEAM(14);
    if (IN(15)) ln_rows<false>(C, PRE2, ln2_g, ln2_b, args.out);
#undef IN
#undef SEAM
}

extern "C" void kernel_launch(void* const* d_in, const int* in_sizes, int n_in, void* d_out, int out_size, void* d_ws, size_t ws_size, hipStream_t stream) {
    static int grid = 0;
    if (grid == 0) {
        if (n_in != 22 || ws_size < WS_END) { fprintf(stderr, "kernel_launch: need 22 inputs and >= %zu bytes of workspace (got %d, %zu)\n", (size_t)WS_END, n_in, ws_size); grid = -1; return; }
        int dev = 0, cus = 0, per_cu = 0;
        hipGetDevice(&dev); hipDeviceGetAttribute(&cus, hipDeviceAttributeMultiprocessorCount, dev);
        if (hipFuncSetAttribute((const void*)fwd_megakernel, hipFuncAttributeMaxDynamicSharedMemorySize, LDS_BYTES) != hipSuccess) { fprintf(stderr, "kernel_launch: hipFuncSetAttribute failed\n"); grid = -1; return; }
        if (hipOccupancyMaxActiveBlocksPerMultiprocessor(&per_cu, (const void*)fwd_megakernel, NWAVES * 64, LDS_BYTES) != hipSuccess || per_cu < 1) { fprintf(stderr, "kernel_launch: occupancy query says %d\n", per_cu); per_cu = 1; }
        (void)hipGetLastError();
        grid = cus * 1;
    }
    if (grid < 0) return;
    Args a{};
    for (int i = 0; i < 22; ++i) a.in[i] = (const float*)d_in[i];
    a.out = (float*)d_out; a.ws = (unsigned char*)d_ws; a.G = grid; a.pad = 0;
#if MK_PER_PHASE
    for (int ph = 0; ph < 16; ++ph) { a.ph_lo = ph; a.ph_hi = ph + 1; void* kargs[] = {&a};
        hipError_t e = hipLaunchCooperativeKernel((const void*)fwd_megakernel, dim3(grid), dim3(NWAVES * 64), kargs, LDS_BYTES, stream);
        if (e != hipSuccess) { fprintf(stderr, "kernel_launch: launch failed: %s\n", hipGetErrorString(e)); break; } }
#else
    (void)hipMemsetAsync((char*)d_ws + 16384, 0, 256, stream);
    a.ph_lo = 0; a.ph_hi = 16; void* kargs[] = {&a};
    hipError_t e = hipLaunchCooperativeKernel((const void*)fwd_megakernel, dim3(grid), dim3(NWAVES * 64), kargs, LDS_BYTES, stream);
    if (e != hipSuccess) fprintf(stderr, "kernel_launch: cooperative launch failed: %s (grid %d)\n", hipGetErrorString(e), grid);
#endif
}
```

```cpp
#include <hip/hip_runtime.h>
#include <hip/hip_cooperative_groups.h>
#include <cstdio>
#include <cstdint>
namespace cg = cooperative_groups;

#define LAS __attribute__((address_space(3)))
typedef unsigned short bf16_t;
typedef short bf16x8 __attribute__((ext_vector_type(8)));
typedef float f32x4 __attribute__((ext_vector_type(4)));
typedef float f32x2 __attribute__((ext_vector_type(2)));
typedef unsigned u32x4 __attribute__((ext_vector_type(4)));
typedef unsigned u32x2 __attribute__((ext_vector_type(2)));

#ifndef MK_PER_PHASE
#define MK_PER_PHASE 0
#endif

constexpr int T = 16384, D = 2048, NIN = 15408, FF = 8192, PLE = 256, HK = 4, HD = 128, NCMP = 1024;
constexpr float DN_ALPHA = 1.189207115002721f;
constexpr float LN_EPS = 1e-5f;
constexpr int NWAVES = 8;
constexpr int LDS_BYTES = 147456;

constexpr size_t MiB = 1u << 20;
constexpr size_t WS_BIASK = 0, WS_BIASV = 4096;
constexpr size_t WS_XB = 1 * MiB;
constexpr size_t WS_WTUP = 1 * MiB, WS_WTDOWN = 33 * MiB;
constexpr size_t WS_WTIN = 65 * MiB;
constexpr size_t WS_WTVT = 114 * MiB;
constexpr size_t WS_WTMB = 118 * MiB;
constexpr size_t WS_WTCONV = 65 * MiB, WS_WTATTN = 73 * MiB, WS_WTMIX = 81 * MiB, WS_WTGATE = 89 * MiB, WS_WTPLE = 97 * MiB, WS_PB = 98 * MiB;
constexpr size_t WS_W1K = 126 * MiB, WS_W1V = 128 * MiB;
constexpr size_t WS_HIDK = 130 * MiB, WS_HIDV = 132 * MiB;
constexpr size_t WS_KC = 134 * MiB, WS_VCT = 135 * MiB;
constexpr size_t WS_GATES = 136 * MiB;
constexpr size_t WS_BG = 140 * MiB;
constexpr size_t WS_X1B = 140 * MiB;
constexpr size_t WS_ZZ = 204 * MiB;
constexpr size_t WS_SMB = 204 * MiB, WS_H1 = 204 * MiB;
constexpr size_t WS_Q = 268 * MiB;
constexpr size_t WS_KCS = 332 * MiB, WS_VCS = 348 * MiB, WS_KS = 364 * MiB, WS_KW = 380 * MiB, WS_VST = 396 * MiB, WS_VWT = 412 * MiB;
constexpr size_t WS_SMA = 428 * MiB;
constexpr size_t WS_PRE1 = 300 * MiB, WS_PRE2 = 364 * MiB;
constexpr size_t WS_END = 492 * MiB;

typedef __bf16 bf16x2_t __attribute__((ext_vector_type(2)));
__device__ __forceinline__ unsigned cvt_pk_bf16(float lo, float hi) { f32x2 v = {lo, hi}; bf16x2_t b = __builtin_convertvector(v, bf16x2_t); return __builtin_bit_cast(unsigned, b); }
__device__ __forceinline__ float bf_lo(unsigned w) { return __uint_as_float(w << 16); }
__device__ __forceinline__ float bf_hi(unsigned w) { return __uint_as_float(w & 0xffff0000u); }
__device__ __forceinline__ float fast_sigmoid(float x) { return __builtin_amdgcn_rcpf(1.f + __expf(-x)); }
__device__ __forceinline__ u32x4 pack8(const f32x4& a, const f32x4& b) { u32x4 w; w.x = cvt_pk_bf16(a[0], a[1]); w.y = cvt_pk_bf16(a[2], a[3]); w.z = cvt_pk_bf16(b[0], b[1]); w.w = cvt_pk_bf16(b[2], b[3]); return w; }
__device__ __forceinline__ void unpack8(const u32x4& w, f32x4& a, f32x4& b) { a[0] = bf_lo(w.x); a[1] = bf_hi(w.x); a[2] = bf_lo(w.y); a[3] = bf_hi(w.y); b[0] = bf_lo(w.z); b[1] = bf_hi(w.z); b[2] = bf_lo(w.w); b[3] = bf_hi(w.w); }

__device__ __forceinline__ long pack8_fp8(float a0, float a1, float a2, float a3, float a4, float a5, float a6, float a7) {
    int lo = __builtin_amdgcn_cvt_pk_fp8_f32(a0, a1, 0, false); lo = __builtin_amdgcn_cvt_pk_fp8_f32(a2, a3, lo, true);
    int hi = __builtin_amdgcn_cvt_pk_fp8_f32(a4, a5, 0, false); hi = __builtin_amdgcn_cvt_pk_fp8_f32(a6, a7, hi, true);
    return (long)(((unsigned long long)(unsigned)hi << 32) | (unsigned long long)(unsigned)lo);
}

namespace pg8 {
constexpr int BM = 256, BK = 64, HALF = 128, HTB = HALF * BK * 2, STAGE_BYTES = 8 * HTB, NXCD = 8, WGM = 8;
__host__ __device__ __forceinline__ int lds_byte(int r, int c) { const int st = (r >> 4) * 2 + (c >> 5), rr = r & 15, cc = c & 31, ob = rr * 64 + cc * 2; return st * 1024 + (ob ^ (((ob >> 9) & 1) << 5)); }
__host__ __device__ __forceinline__ void stage_rc(int b, int& R, int& C) { const int st = b / 1024, sb = b % 1024, swz = sb ^ (((sb >> 9) & 1) << 5); R = (st >> 1) * 16 + swz / 64; C = (st & 1) * 32 + (swz % 64) / 2; }
__host__ __device__ __forceinline__ int perm32(int rho) { const int n = rho >> 4, i = rho & 15; return 8 * (i >> 2) + 4 * n + (i & 3); }

struct Unit { int pm, pn; };
struct Gemm { const bf16_t* A; const bf16_t* Bt; int M, N, K, lda, ldb; };

struct StaticOrder {
    int nM, nN, nwg, G, c;
    __device__ void init(int M, int N, int G_, int c_) { nM = M / BM; nN = N / BM; nwg = nM * nN; G = G_; c = c_; }
    __device__ bool next(int i, Unit& u) const {
        const long L = (long)i * G + c; if (c < 0 || L >= nwg) return false;
        int wgid = (int)L; { const int q = nwg / NXCD, r = nwg % NXCD, xcd = wgid % NXCD, off = wgid / NXCD; wgid = (xcd < r ? xcd * (q + 1) : r * (q + 1) + (xcd - r) * q) + off; }
        const int nig = WGM * nN, gid = wgid / nig, fm = gid * WGM, gsz = (nM - fm) < WGM ? (nM - fm) : WGM;
        u.pm = fm + ((wgid % nig) % gsz); u.pn = (wgid % nig) / gsz; return true;
    }
};

template <class F> struct EpiGen {
    F f;
    __device__ __forceinline__ void operator()(const f32x4 (&acc)[2][2][4][2], const Unit& u, int wr, int wc, int fr, int fq) const {
        const int row0 = u.pm * BM + wr * 64 + fr, col0 = u.pn * BM + wc * 32 + 8 * fq;
#pragma unroll
        for (int ai = 0; ai < 2; ++ai)
#pragma unroll
            for (int m = 0; m < 4; ++m) {
                const int row = row0 + ai * HALF + m * 16;
#pragma unroll
                for (int bj = 0; bj < 2; ++bj) f(row, col0 + bj * HALF, acc[ai][bj][m][0], acc[ai][bj][m][1]);
            }
    }
};

template <class Epi, class Sched>
__device__ __forceinline__ void gemm_phase(LAS unsigned char* lds, const Gemm g, const Sched& S, const Epi& E) {
    const int tid = threadIdx.x, wid = __builtin_amdgcn_readfirstlane(tid >> 6), lane = tid & 63, wr = wid >> 2, wc = wid & 3, fr = lane & 15, fq = lane >> 4;
    const int K = g.K, nt = K / BK;
    unsigned voffA[2], voffB[2];
#pragma unroll
    for (int i = 0; i < 2; ++i) { int R, C; stage_rc(tid * 16 + i * 8192, R, C); const int Rb = (R & ~31) + perm32(R & 31);
        voffA[i] = (unsigned)(R * g.lda + C) * 2u; voffB[i] = (unsigned)(Rb * g.ldb + C) * 2u; }
    const size_t kstep = (size_t)(BK * 2);
    const size_t hstepA = (size_t)HALF * g.lda * 2, hstepB = (size_t)HALF * g.ldb * 2;
    const size_t tstepA = 2 * hstepA, tstepB = 2 * hstepB;
    const unsigned ldsw = (unsigned)wid * 1024u;
    const int aoff = lds_byte(wr * 64 + fr, fq * 8), boff = lds_byte(wc * 32 + fr, fq * 8);
#define PG8_SA(b, h) (((b) * 2 + (h)) * HTB)
#define PG8_SB(b, h) ((4 + (b) * 2 + (h)) * HTB)
#define PG8_STAGE(bufoff, gbase, voff) do { _Pragma("unroll") for (int _i = 0; _i < 2; ++_i) \
        __builtin_amdgcn_global_load_lds((const unsigned*)((const char*)(gbase) + (voff)[_i]), (LAS unsigned*)(lds + (bufoff) + ldsw + _i * 8192), 16, 0, 0); } while (0)
#define PG8_LDA(dst, b, h) do { _Pragma("unroll") for (int m = 0; m < 4; ++m) _Pragma("unroll") for (int k = 0; k < 2; ++k) dst[m][k] = *(const LAS bf16x8*)(lds + PG8_SA(b, h) + aoff + m * 2048 + k * 1024); } while (0)
#define PG8_LDB(dst, b, h) do { _Pragma("unroll") for (int n = 0; n < 2; ++n) _Pragma("unroll") for (int k = 0; k < 2; ++k) dst[n][k] = *(const LAS bf16x8*)(lds + PG8_SB(b, h) + boff + n * 2048 + k * 1024); } while (0)
#define PG8_MMA(ai, bj, At, Bt) do { __builtin_amdgcn_s_setprio(1); _Pragma("unroll") for (int m = 0; m < 4; ++m) _Pragma("unroll") for (int n = 0; n < 2; ++n) _Pragma("unroll") for (int k = 0; k < 2; ++k) \
        acc[ai][bj][m][n] = __builtin_amdgcn_mfma_f32_16x16x32_bf16(Bt[n][k], At[m][k], acc[ai][bj][m][n], 0, 0, 0); __builtin_amdgcn_s_setprio(0); } while (0)
#define PG8_WAIT_V(n) asm volatile("s_waitcnt vmcnt(" #n ")" ::: "memory")
#define PG8_WAIT_L(n) asm volatile("s_waitcnt lgkmcnt(" #n ")" ::: "memory")
#define PG8_BAR __builtin_amdgcn_s_barrier()
#define PG8_SCHED __builtin_amdgcn_sched_barrier(0)
    Unit cur, nxt; int ui = 0;
    if (!S.next(0, cur)) return;
    f32x4 acc[2][2][4][2];
#pragma unroll
    for (int a = 0; a < 2; ++a)
#pragma unroll
        for (int b = 0; b < 2; ++b)
#pragma unroll
            for (int m = 0; m < 4; ++m)
#pragma unroll
                for (int n = 0; n < 2; ++n) acc[a][b][m][n] = (f32x4){0.f, 0.f, 0.f, 0.f};
    bf16x8 At[4][2], B0[2][2], B1[2][2];
    const char* cA = (const char*)g.A + (size_t)cur.pm * tstepA; const char* cB = (const char*)g.Bt + (size_t)cur.pn * tstepB;
    PG8_STAGE(PG8_SB(0, 0), cB, voffB); PG8_STAGE(PG8_SB(0, 1), cB + hstepB, voffB); PG8_STAGE(PG8_SA(0, 0), cA, voffA); PG8_STAGE(PG8_SA(0, 1), cA + hstepA, voffA);
    if (wr == 1) PG8_BAR;
    PG8_WAIT_V(2); PG8_BAR;
    PG8_STAGE(PG8_SB(1, 0), cB + kstep, voffB); PG8_STAGE(PG8_SA(1, 0), cA + kstep, voffA); PG8_STAGE(PG8_SB(1, 1), cB + hstepB + kstep, voffB);
    PG8_WAIT_V(6); PG8_BAR;
    for (;;) {
        const bool has_next = S.next(ui + 1, nxt);
        const char* nA = has_next ? (const char*)g.A + (size_t)nxt.pm * tstepA : cA; const char* nB = has_next ? (const char*)g.Bt + (size_t)nxt.pn * tstepB : cB;
        for (int t = 0; t < nt; t += 2) {
            const bool last = (t == nt - 2);
            const char* a1 = cA + (size_t)(t + 1) * kstep;
            const char* a2 = last ? nA : cA + (size_t)(t + 2) * kstep; const char* b2 = last ? nB : cB + (size_t)(t + 2) * kstep;
            const char* a3 = a2 + kstep; const char* b3 = b2 + kstep;
            PG8_LDB(B0, 0, 0); PG8_LDB(B1, 0, 1); PG8_SCHED; PG8_LDA(At, 0, 0); PG8_STAGE(PG8_SA(1, 1), a1 + hstepA, voffA);
            PG8_WAIT_V(8); PG8_WAIT_L(0); PG8_BAR; PG8_MMA(0, 0, At, B0); PG8_MMA(0, 1, At, B1); PG8_BAR; PG8_SCHED;
            PG8_LDA(At, 0, 1); PG8_STAGE(PG8_SB(0, 0), b2, voffB); PG8_STAGE(PG8_SB(0, 1), b2 + hstepB, voffB); PG8_STAGE(PG8_SA(0, 0), a2, voffA);
            PG8_WAIT_V(8); PG8_WAIT_L(0); PG8_BAR; PG8_MMA(1, 0, At, B0); PG8_MMA(1, 1, At, B1); PG8_BAR; PG8_SCHED;
            PG8_LDB(B0, 1, 0); PG8_LDB(B1, 1, 1); PG8_SCHED; PG8_LDA(At, 1, 0); PG8_STAGE(PG8_SA(0, 1), a2 + hstepA, voffA);
            PG8_WAIT_V(8); PG8_WAIT_L(0); PG8_BAR; PG8_MMA(0, 0, At, B0); PG8_MMA(0, 1, At, B1); PG8_BAR; PG8_SCHED;
            PG8_LDA(At, 1, 1); PG8_STAGE(PG8_SB(1, 0), b3, voffB); PG8_STAGE(PG8_SB(1, 1), b3 + hstepB, voffB); PG8_STAGE(PG8_SA(1, 0), a3, voffA);
            PG8_WAIT_V(8); PG8_WAIT_L(0); PG8_BAR; PG8_MMA(1, 0, At, B0); PG8_MMA(1, 1, At, B1); PG8_BAR; PG8_SCHED;
        }
        if (wr == 0) PG8_BAR;
        E(acc, cur, wr, wc, fr, fq);
        if (!has_next) break;
#pragma unroll
        for (int a = 0; a < 2; ++a)
#pragma unroll
            for (int b = 0; b < 2; ++b)
#pragma unroll
                for (int m = 0; m < 4; ++m)
#pragma unroll
                    for (int n = 0; n < 2; ++n) acc[a][b][m][n] = (f32x4){0.f, 0.f, 0.f, 0.f};
        cur = nxt; cA = nA; cB = nB; ++ui;
        if (wr == 1) PG8_BAR;
    }
    PG8_WAIT_V(0);
    PG8_BAR;
#undef PG8_SA
#undef PG8_SB
#undef PG8_STAGE
#undef PG8_LDA
#undef PG8_LDB
#undef PG8_MMA
#undef PG8_WAIT_V
#undef PG8_WAIT_L
#undef PG8_BAR
#undef PG8_SCHED
}
}

struct FStoreBf16 {
    bf16_t* O; int ldc; int act;
    __device__ __forceinline__ void operator()(int row, int col, f32x4 a, f32x4 b) const {
        if (act == 1) { for (int i = 0; i < 4; ++i) { a[i] = fast_sigmoid(a[i]); b[i] = fast_sigmoid(b[i]); } }
        else if (act == 2) { for (int i = 0; i < 4; ++i) { float x = fmaxf(a[i], 0.f), y = fmaxf(b[i], 0.f); a[i] = x * x; b[i] = y * y; } }
        *(u32x4*)(O + (size_t)row * ldc + col) = pack8(a, b);
    }
};
struct FStoreVT {
    bf16_t* O; unsigned char* O8;
    __device__ __forceinline__ void operator()(int row, int col, f32x4 a, f32x4 b) const {
        if (row < 512) { const int hk = row >> 7, d = row & 127; *(long*)(O8 + (size_t)hk * ((size_t)T * 128) + ((size_t)(col >> 5) << 12) + (d >> 4) * 512 + (d & 15) * 32 + (col & 31)) = pack8_fp8(a[0], a[1], a[2], a[3], b[0], b[1], b[2], b[3]); *(u32x4*)(O + (size_t)hk * ((size_t)T * 128) + ((size_t)(col >> 5) << 12) + (d >> 4) * 512 + (d & 15) * 32 + (col & 31)) = pack8(a, b); }
        else { const int hk = (row - 512) >> 7, d = row & 127; *(u32x4*)(O + (size_t)512 * T + (size_t)hk * ((size_t)T * 128) + ((size_t)(col >> 5) << 12) + (d >> 4) * 512 + (d & 15) * 32 + (col & 31)) = pack8(a, b); }
    }
};
struct FGeluBias {
    bf16_t* O; int ldc; const float* bias;
    __device__ __forceinline__ void operator()(int row, int col, f32x4 a, f32x4 b) const {
        const f32x4 b0 = *(const f32x4*)(bias + col), b1 = *(const f32x4*)(bias + col + 4);
        a = a + b0; b = b + b1;
        for (int i = 0; i < 4; ++i) {
            float x = a[i]; a[i] = x * __builtin_amdgcn_rcpf(1.f + __expf(-1.5957691216057308f * (x + 0.044715f * x * x * x)));
            float y = b[i]; b[i] = y * __builtin_amdgcn_rcpf(1.f + __expf(-1.5957691216057308f * (y + 0.044715f * y * y * y)));
        }
        *(u32x4*)(O + (size_t)row * ldc + col) = pack8(a, b);
    }
};
struct FMulInplace {
    bf16_t* O; int ldc;
    __device__ __forceinline__ void operator()(int row, int col, f32x4 a, f32x4 b) const {
        bf16_t* p = O + (size_t)row * ldc + col; f32x4 g0, g1; unpack8(*(const u32x4*)p, g0, g1);
        *(u32x4*)p = pack8(a * g0, b * g1);
    }
};
struct FMulAddInplace {
    bf16_t* O; const bf16_t* Y; int ldc;
    __device__ __forceinline__ void operator()(int row, int col, f32x4 a, f32x4 b) const {
        bf16_t* p = O + (size_t)row * ldc + col; f32x4 g0, g1, y0, y1; unpack8(*(const u32x4*)p, g0, g1); unpack8(*(const u32x4*)(Y + (size_t)row * ldc + col), y0, y1);
        *(u32x4*)p = pack8(a * g0 + y0, b * g1 + y1);
    }
};
struct FResidF32 {
    float* P; const float* X; int ldc;
    __device__ __forceinline__ void operator()(int row, int col, f32x4 a, f32x4 b) const {
        const size_t o = (size_t)row * ldc + col;
        const f32x4 x0 = *(const f32x4*)(X + o), x1 = *(const f32x4*)(X + o + 4);
        *(f32x4*)(P + o) = x0 * DN_ALPHA + a; *(f32x4*)(P + o + 4) = x1 * DN_ALPHA + b;
    }
};
struct FSigmoidF32 {
    float* P; int ldc;
    __device__ __forceinline__ void operator()(int row, int col, f32x4 a, f32x4 b) const {
        for (int i = 0; i < 4; ++i) { a[i] = fast_sigmoid(a[i]); b[i] = fast_sigmoid(b[i]); }
        const size_t o = (size_t)row * ldc + col; *(f32x4*)(P + o) = a; *(f32x4*)(P + o + 4) = b;
    }
};
struct FPle {
    float* P; const bf16_t* X; int ldc;
    __device__ __forceinline__ void operator()(int row, int col, f32x4 a, f32x4 b) const {
        const size_t o = (size_t)row * ldc + col; f32x4 x0, x1; unpack8(*(const u32x4*)(X + o), x0, x1);
        const f32x4 p0 = *(const f32x4*)(P + o), p1 = *(const f32x4*)(P + o + 4);
        *(f32x4*)(P + o) = a * p0 + x0 * DN_ALPHA; *(f32x4*)(P + o + 4) = b * p1 + x1 * DN_ALPHA;
    }
};
struct FAccF32 {
    float* P; int ldc;
    __device__ __forceinline__ void operator()(int row, int col, f32x4 a, f32x4 b) const {
        const size_t o = (size_t)row * ldc + col;
        *(f32x4*)(P + o) = *(const f32x4*)(P + o) + a; *(f32x4*)(P + o + 4) = *(const f32x4*)(P + o + 4) + b;
    }
};
struct EpiInProj {
    bf16_t *zz, *bg, *q, *kv, *sma; float* gates; unsigned char* ks8;
    __device__ __forceinline__ void operator()(const f32x4 (&acc)[2][2][4][2], const pg8::Unit& u, int wr, int wc, int fr, int fq) const {
        const int row0 = u.pm * 256 + wr * 64 + fr, cw = wc * 32 + 8 * fq; const int pn = u.pn;
        if (pn < 16) {
#pragma unroll
            for (int ai = 0; ai < 2; ++ai)
#pragma unroll
                for (int m = 0; m < 4; ++m) { const int row = row0 + ai * 128 + m * 16;
                    *(u32x4*)(zz + (size_t)row * D + pn * 128 + cw) = pack8(acc[ai][0][m][0] * acc[ai][1][m][0], acc[ai][0][m][1] * acc[ai][1][m][1]); }
        } else if (pn < 32) {
            bf16_t* O = (pn < 24) ? bg : q; const int c0 = ((pn - 16) & 7) * 256 + cw;
#pragma unroll
            for (int ai = 0; ai < 2; ++ai)
#pragma unroll
                for (int m = 0; m < 4; ++m) { const int row = row0 + ai * 128 + m * 16;
#pragma unroll
                    for (int bj = 0; bj < 2; ++bj) *(u32x4*)(O + (size_t)row * D + c0 + bj * 128) = pack8(acc[ai][bj][m][0], acc[ai][bj][m][1]); }
        } else if (pn < 40) {
            const int c0 = (pn - 32) * 256; const int b = c0 >> 9, h0 = (c0 & 511) >> 7;
            bf16_t* O = kv + (size_t)b * ((size_t)T * 512);
#pragma unroll
            for (int ai = 0; ai < 2; ++ai)
#pragma unroll
                for (int m = 0; m < 4; ++m) { const int row = row0 + ai * 128 + m * 16;
#pragma unroll
                    for (int bj = 0; bj < 2; ++bj) {
                        const size_t off = (b >= 2) ? (((size_t)(row >> 5) << 12) + ((row >> 2) & 1) * 2048 + (cw >> 5) * 512 + (4 * ((row & 31) >> 3) + (row & 3)) * 32 + (cw & 31))
                                                    : ((size_t)row * 128 + cw);
                        *(u32x4*)(O + (size_t)(h0 + bj) * ((size_t)T * 128) + off) = pack8(acc[ai][bj][m][0], acc[ai][bj][m][1]);
                        if (b == 2) { const f32x4 a = acc[ai][bj][m][0], c2 = acc[ai][bj][m][1]; *(long*)(ks8 + (size_t)(h0 + bj) * ((size_t)T * 128) + off) = pack8_fp8(a[0], a[1], a[2], a[3], c2[0], c2[1], c2[2], c2[3]); } } }
        } else if (pn < 48) {
            const int c0 = (pn - 40) * 256 + cw;
#pragma unroll
            for (int ai = 0; ai < 2; ++ai)
#pragma unroll
                for (int m = 0; m < 4; ++m) { const int row = row0 + ai * 128 + m * 16;
#pragma unroll
                    for (int bj = 0; bj < 2; ++bj) { f32x4 a = acc[ai][bj][m][0], b = acc[ai][bj][m][1];
                        for (int i = 0; i < 4; ++i) { a[i] = fast_sigmoid(a[i]); b[i] = fast_sigmoid(b[i]); }
                        *(u32x4*)(sma + (size_t)row * D + c0 + bj * 128) = pack8(a, b); } }
        } else {
            if (cw < 48) {
#pragma unroll
                for (int ai = 0; ai < 2; ++ai)
#pragma unroll
                    for (int m = 0; m < 4; ++m) { const int row = row0 + ai * 128 + m * 16; f32x4 a = acc[ai][0][m][0], b = acc[ai][0][m][1];
                        for (int i = 0; i < 4; ++i) { a[i] = fast_sigmoid(a[i]); b[i] = fast_sigmoid(b[i]); }
                        *(f32x4*)(gates + (size_t)row * 48 + cw) = a; *(f32x4*)(gates + (size_t)row * 48 + cw + 4) = b; }
            }
        }
    }
};

struct Args {
    const float* in[22]; float* out; unsigned char* ws; int ph_lo, ph_hi, G, pad;
};

struct Ctx { int tid, lane, wave, gw, NGW, gtid, NT; LAS unsigned char* lds; };

__device__ __forceinline__ void tr_item(const float* W, int ldw, int k0, int nsrc0, bf16_t* WT, int ldt, int drow0, LAS float* scr, int lane) {
#pragma unroll 8
    for (int i = 0; i < 32; ++i) { const int kk = 2 * i + (lane >> 5); scr[kk * 33 + (lane & 31)] = W[(size_t)(k0 + kk) * ldw + nsrc0 + (lane & 31)]; }
    asm volatile("s_waitcnt lgkmcnt(0)" ::: "memory");
    const int c = lane & 7;
#pragma unroll
    for (int j = 0; j < 4; ++j) { const int n = (lane >> 3) + 8 * j; const LAS float* s = scr + (8 * c) * 33 + n;
        u32x4 o; o.x = cvt_pk_bf16(s[0 * 33], s[1 * 33]); o.y = cvt_pk_bf16(s[2 * 33], s[3 * 33]); o.z = cvt_pk_bf16(s[4 * 33], s[5 * 33]); o.w = cvt_pk_bf16(s[6 * 33], s[7 * 33]);
        *(u32x4*)(WT + (size_t)(drow0 + n) * ldt + k0 + 8 * c) = o; }
    asm volatile("s_waitcnt lgkmcnt(0)" ::: "memory");
}
__device__ __forceinline__ void tr_job(const Ctx& C, const float* W, int K, int ldw, int ncol0, int ncols, bf16_t* WT, int ldt, int drow0, int grp, int grp_stride) {
    LAS float* scr = (LAS float*)(C.lds + C.wave * 16384);
    const int nblk = ncols / 32, items = (K / 64) * nblk;
    for (int it = C.gw; it < items; it += C.NGW) {
        const int kb = it / nblk, n = (it % nblk) * 32; const int drow = drow0 + (n / grp) * grp_stride + (n % grp);
        tr_item(W, ldw, kb * 64, ncol0 + n, WT, ldt, drow, scr, C.lane);
    }
}
__device__ __forceinline__ void cvt_job(const Ctx& C, const float* X, bf16_t* O, size_t n8) {
    for (size_t i = C.gtid; i < n8; i += C.NT) { const f32x4 a = *(const f32x4*)(X + i * 8), b = *(const f32x4*)(X + i * 8 + 4); *(u32x4*)(O + i * 8) = pack8(a, b); }
}

template <bool OUT_BF16>
__device__ __forceinline__ void ln_rows(const Ctx& C, const float* P, const float* gam, const float* bet, void* outp) {
    for (int r = C.gw; r < T; r += C.NGW) {
        const f32x4* xr = (const f32x4*)(P + (size_t)r * D) + C.lane;
        f32x4 v[8]; float s = 0.f;
#pragma unroll
        for (int j = 0; j < 8; ++j) { v[j] = xr[64 * j]; s += (v[j][0] + v[j][1]) + (v[j][2] + v[j][3]); }
#pragma unroll
        for (int o = 1; o < 64; o <<= 1) s += __shfl_xor(s, o);
        const float mean = s * (1.f / D); float s2 = 0.f;
#pragma unroll
        for (int j = 0; j < 8; ++j) { v[j] = v[j] - mean; s2 += (v[j][0] * v[j][0] + v[j][1] * v[j][1]) + (v[j][2] * v[j][2] + v[j][3] * v[j][3]); }
#pragma unroll
        for (int o = 1; o < 64; o <<= 1) s2 += __shfl_xor(s2, o);
        const float rstd = 1.f / sqrtf(s2 * (1.f / D) + LN_EPS);
#pragma unroll
        for (int j = 0; j < 8; ++j) {
            const f32x4 gg = *((const f32x4*)gam + C.lane + 64 * j), bb = *((const f32x4*)bet + C.lane + 64 * j);
            const f32x4 y = v[j] * rstd * gg + bb;
            if (OUT_BF16) { u32x2 w; w.x = cvt_pk_bf16(y[0], y[1]); w.y = cvt_pk_bf16(y[2], y[3]); *((u32x2*)((bf16_t*)outp + (size_t)r * D) + C.lane + 64 * j) = w; }
            else *((f32x4*)((float*)outp + (size_t)r * D) + C.lane + 64 * j) = y;
        }
    }
}

constexpr float SC_LOG2E = 0.08838834764831845f * 1.4426950408889634f;
__device__ __forceinline__ int rel_bucket(int n) {
    const int e = 31 - __builtin_clz((unsigned)(n | 1));
    const int odd = ((unsigned)n * (unsigned)n >= (1u << (2 * e + 1))) ? 1 : 0;
    const int lg = min(31, 8 + 2 * e + odd);
    return n < 16 ? n : lg;
}
template <int MODE>
__device__ __forceinline__ void att_step(const bf16_t* __restrict__ Kp, const bf16_t* __restrict__ VTp, int ldv, int key0, int tq, bool colok,
                                         const bf16x8 (&qf)[4], float& m, float& lsum, f32x4 (&O)[8], float inv_l,
                                         const LAS float* tab, int hd16, LAS float* impq, int g, int fr) {
    bf16x8 ka[4], kb[4], vf[8];
    {
        const bf16_t* kq = Kp + ((size_t)(key0 >> 5) << 12) + fr * 32 + 8 * g;
#pragma unroll
        for (int dc = 0; dc < 4; ++dc) { ka[dc] = *(const bf16x8*)(kq + dc * 512); kb[dc] = *(const bf16x8*)(kq + 2048 + dc * 512); }
        if (MODE != 0) { const bf16_t* vq = VTp + ((size_t)(key0 >> 5) << 12) + fr * 32 + 8 * g;
#pragma unroll
            for (int dt = 0; dt < 8; ++dt) vf[dt] = *(const bf16x8*)(vq + dt * 512); }
    }
    f32x4 sa = {0.f, 0.f, 0.f, 0.f}, sb = {0.f, 0.f, 0.f, 0.f};
#pragma unroll
    for (int dc = 0; dc < 4; ++dc) { sa = __builtin_amdgcn_mfma_f32_16x16x32_bf16(ka[dc], qf[dc], sa, 0, 0, 0); sb = __builtin_amdgcn_mfma_f32_16x16x32_bf16(kb[dc], qf[dc], sb, 0, 0, 0); }
    float s[8]; bool ok[8];
#pragma unroll
    for (int e = 0; e < 8; ++e) {
        const int idx = key0 + 8 * g + e;
        const int dist = (MODE < 2) ? (tq - 31 - 16 * idx) : (tq - idx);
        ok[e] = (MODE < 2) ? (dist >= 0) : (MODE == 2 ? (dist >= 0 && dist < 512) : (dist >= 0 && colok));
        const int bk = rel_bucket(max(dist, 0));
        const float sv = (e < 4 ? sa[e & 3] : sb[e & 3]) * SC_LOG2E + tab[bk * 16 + hd16];
        s[e] = ok[e] ? sv : -1e30f;
    }
    float p[8];
    if (MODE != 1) {
        float mx = fmaxf(fmaxf(fmaxf(s[0], s[1]), fmaxf(s[2], s[3])), fmaxf(fmaxf(s[4], s[5]), fmaxf(s[6], s[7])));
        mx = fmaxf(mx, __shfl_xor(mx, 16)); mx = fmaxf(mx, __shfl_xor(mx, 32));
        const float mn = fmaxf(m, mx); const float alpha = __builtin_amdgcn_exp2f(m - mn); m = mn;
        float ps = 0.f;
#pragma unroll
        for (int e = 0; e < 8; ++e) { p[e] = ok[e] ? __builtin_amdgcn_exp2f(s[e] - mn) : 0.f; ps += p[e]; }
        lsum = lsum * alpha + ps;
        if (MODE != 0) {
#pragma unroll
            for (int dt = 0; dt < 8; ++dt) O[dt] = O[dt] * alpha;
        }
    } else {
#pragma unroll
        for (int e = 0; e < 8; ++e) p[e] = ok[e] ? __builtin_amdgcn_exp2f(s[e] - m) * inv_l : 0.f;
        const int G2 = (key0 >> 2) + 2 * g;
        atomicAdd((float*)(impq + G2), (p[0] + p[1]) + (p[2] + p[3]));
        atomicAdd((float*)(impq + G2 + 1), (p[3] + p[4]) + (p[5] + p[6]) + p[7]);
        atomicAdd((float*)(impq + G2 + 2), p[7]);
    }
    if (MODE != 0) {
        u32x4 pw; pw.x = cvt_pk_bf16(p[0], p[1]); pw.y = cvt_pk_bf16(p[2], p[3]); pw.z = cvt_pk_bf16(p[4], p[5]); pw.w = cvt_pk_bf16(p[6], p[7]);
        const bf16x8 pf = __builtin_bit_cast(bf16x8, pw);
#pragma unroll
        for (int dt = 0; dt < 8; ++dt) O[dt] = __builtin_amdgcn_mfma_f32_16x16x32_bf16(vf[dt], pf, O[dt], 0, 0, 0);
    }
}

struct Frag8 { long ka[4], kb[4], vf[8]; };
__device__ __forceinline__ void load_frag8(Frag8& F, const unsigned char* __restrict__ K8, const unsigned char* __restrict__ V8T, int key0, int g, int fr) {
    const unsigned char* kq = K8 + ((size_t)(key0 >> 5) << 12) + fr * 32 + 8 * g;
#pragma unroll
    for (int dc = 0; dc < 4; ++dc) { F.ka[dc] = *(const long*)(kq + dc * 512); F.kb[dc] = *(const long*)(kq + 2048 + dc * 512); }
    const unsigned char* vq = V8T + ((size_t)(key0 >> 5) << 12) + fr * 32 + 8 * g;
#pragma unroll
    for (int dt = 0; dt < 8; ++dt) F.vf[dt] = *(const long*)(vq + dt * 512);
}
__device__ __forceinline__ void compute_fp8(const Frag8& F, int key0, int tq, bool colok, const long (&q8)[4], float& m, float& lsum, f32x4 (&O)[8], const LAS float* tab, int hd16, int g) {
    f32x4 sa = {0.f, 0.f, 0.f, 0.f}, sb = {0.f, 0.f, 0.f, 0.f};
#pragma unroll
    for (int dc = 0; dc < 4; ++dc) { sa = __builtin_amdgcn_mfma_f32_16x16x32_fp8_fp8(F.ka[dc], q8[dc], sa, 0, 0, 0); sb = __builtin_amdgcn_mfma_f32_16x16x32_fp8_fp8(F.kb[dc], q8[dc], sb, 0, 0, 0); }
    float s[8]; bool ok[8];
#pragma unroll
    for (int e = 0; e < 8; ++e) {
        const int dist = tq - (key0 + 8 * g + e);
        ok[e] = dist >= 0 && colok;
        const int bk = rel_bucket(max(dist, 0));
        const float sv = (e < 4 ? sa[e & 3] : sb[e & 3]) * SC_LOG2E + tab[bk * 16 + hd16];
        s[e] = ok[e] ? sv : -1e30f;
    }
    float mx = fmaxf(fmaxf(fmaxf(s[0], s[1]), fmaxf(s[2], s[3])), fmaxf(fmaxf(s[4], s[5]), fmaxf(s[6], s[7])));
    mx = fmaxf(mx, __shfl_xor(mx, 16)); mx = fmaxf(mx, __shfl_xor(mx, 32));
    const float mn = fmaxf(m, mx); const float alpha = __builtin_amdgcn_exp2f(m - mn); m = mn;
    float p[8]; float ps = 0.f;
#pragma unroll
    for (int e = 0; e < 8; ++e) { p[e] = ok[e] ? __builtin_amdgcn_exp2f(s[e] - mn) : 0.f; ps += p[e]; }
    lsum = lsum * alpha + ps;
#pragma unroll
    for (int dt = 0; dt < 8; ++dt) O[dt] = O[dt] * alpha;
    const long pf = pack8_fp8(p[0] * 256.f, p[1] * 256.f, p[2] * 256.f, p[3] * 256.f, p[4] * 256.f, p[5] * 256.f, p[6] * 256.f, p[7] * 256.f);
#pragma unroll
    for (int dt = 0; dt < 8; ++dt) O[dt] = __builtin_amdgcn_mfma_f32_16x16x32_fp8_fp8(F.vf[dt], pf, O[dt], 0, 0, 0);
}

constexpr int IMP_STRIDE = 264;
__device__ __forceinline__ void attention_phase(const Ctx& C, bf16_t* qo, const bf16_t* kc, const bf16_t* vcT, const bf16_t* ks, const bf16_t* vsT,
                                                const bf16_t* kw, const bf16_t* vwT, const float* gates, const float* rel_bias, const unsigned char* ks8, const unsigned char* vs8) {
    LAS float* tab = (LAS float*)C.lds;
    LAS float* imp = (LAS float*)(C.lds + 4096 + C.wave * 8192);
    LAS int* lst = (LAS int*)(C.lds + 4096 + C.wave * 8192 + 4 * IMP_STRIDE * 4);
    for (int i = C.tid; i < 512; i += NWAVES * 64) tab[i] = rel_bias[i] * 1.4426950408889634f;
    __syncthreads();
    const int lane = C.lane, fr = lane & 15, g = lane >> 4, qi = fr >> 2, hd = fr & 3;
    const int hk = (int)(blockIdx.x & 3), wl = (int)(blockIdx.x >> 2) * NWAVES + C.wave, nwl = C.NGW >> 2;
    for (int qg = wl; qg < T / 4; qg += nwl) {
        const int t0 = qg * 4, tq = t0 + qi, head = hk * 4 + hd, jt = t0 >> 6;
        bf16x8 qf[4];
        { const bf16_t* qp = qo + (size_t)tq * D + head * HD + 8 * g;
#pragma unroll
          for (int dc = 0; dc < 4; ++dc) qf[dc] = *(const bf16x8*)(qp + dc * 32); }
        const float g0 = gates[(size_t)tq * 48 + head * 3 + 0], g1 = gates[(size_t)tq * 48 + head * 3 + 1], g2 = gates[(size_t)tq * 48 + head * 3 + 2];
        f32x4 OA[8];
#pragma unroll
        for (int dt = 0; dt < 8; ++dt) OA[dt] = (f32x4){0.f, 0.f, 0.f, 0.f};
        f32x4 O[8];
        for (int i = lane; i < 4 * IMP_STRIDE; i += 64) imp[i] = 0.f;
        __builtin_amdgcn_wave_barrier(); asm volatile("s_waitcnt lgkmcnt(0)" ::: "memory");
        const bf16_t* Kc = kc + (size_t)hk * NCMP * HD; const bf16_t* Vc = vcT + (size_t)hk * HD * NCMP;
        const int ncv = (t0 + 3 >= 31) ? ((t0 + 3 - 31) >> 4) + 1 : 0;
        const int nst = (ncv + 31) >> 5;
        {
            float m = -1e30f, lsum = 0.f;
            for (int st = 0; st < nst; ++st) att_step<0>(Kc, Vc, NCMP, st * 32, tq, true, qf, m, lsum, O, 0.f, tab, hd + 0 * 16 + (hk * 4), imp + qi * IMP_STRIDE, g, fr);
            float l = lsum; l += __shfl_xor(l, 16); l += __shfl_xor(l, 32);
            const float inv = l > 0.f ? 1.f / l : 0.f;
#pragma unroll
            for (int dt = 0; dt < 8; ++dt) O[dt] = (f32x4){0.f, 0.f, 0.f, 0.f};
            for (int st = 0; st < nst; ++st) att_step<1>(Kc, Vc, NCMP, st * 32, tq, true, qf, m, lsum, O, inv, tab, hd + hk * 4, imp + qi * IMP_STRIDE, g, fr);
#pragma unroll
            for (int dt = 0; dt < 8; ++dt) OA[dt] = OA[dt] + O[dt] * g0;
        }
        __builtin_amdgcn_wave_barrier(); asm volatile("s_waitcnt lgkmcnt(0)" ::: "memory");
        int nlist = 0;
        const int ncand = jt - 2;
        if (ncand <= 13) {
            if (lane <= jt) lst[lane] = lane | (0xF << 16);
            nlist = jt + 1;
        } else {
            if (lane == 0) { lst[0] = 0 | (0xF << 16); lst[1] = (jt - 1) | (0xF << 16); lst[2] = jt | (0xF << 16); }
            nlist = 3;
            for (int qq = 0; qq < 4; ++qq) {
                float v[4];
#pragma unroll
                for (int k = 0; k < 4; ++k) { const int sblk = 4 * lane + k; const float x = imp[qq * IMP_STRIDE + sblk]; v[k] = (sblk >= 1 && sblk <= jt - 2) ? x : -1.f; }
                for (int r = 0; r < 13; ++r) {
                    float lm = fmaxf(fmaxf(v[0], v[1]), fmaxf(v[2], v[3]));
                    float wm = lm;
#pragma unroll
                    for (int o = 1; o < 64; o <<= 1) wm = fmaxf(wm, __shfl_xor(wm, o));
                    const unsigned long long bal = __ballot(lm == wm);
                    const int src = __ffsll((long long)bal) - 1;
                    if (lane == src) {
                        int k = (v[0] == wm) ? 0 : (v[1] == wm) ? 1 : (v[2] == wm) ? 2 : 3;
                        if (k == 0) v[0] = -2.f; else if (k == 1) v[1] = -2.f; else if (k == 2) v[2] = -2.f; else v[3] = -2.f;
                        lst[nlist + r] = (4 * lane + k) | ((1 << qq) << 16);
                    }
                }
                nlist += 13;
            }
        }
        __builtin_amdgcn_wave_barrier(); asm volatile("s_waitcnt lgkmcnt(0)" ::: "memory");
        {
            const unsigned char* Ks8 = ks8 + (size_t)hk * T * HD; const unsigned char* Vs8 = vs8 + (size_t)hk * T * HD;
            long q8[4];
#pragma unroll
            for (int dc = 0; dc < 4; ++dc) { const u32x4 w = __builtin_bit_cast(u32x4, qf[dc]); q8[dc] = pack8_fp8(bf_lo(w[0]), bf_hi(w[0]), bf_lo(w[1]), bf_hi(w[1]), bf_lo(w[2]), bf_hi(w[2]), bf_lo(w[3]), bf_hi(w[3])); }
            float m = -1e30f, lsum = 0.f;
#pragma unroll
            for (int dt = 0; dt < 8; ++dt) O[dt] = (f32x4){0.f, 0.f, 0.f, 0.f};
            Frag8 FA, FB;
            int ent = __builtin_amdgcn_readfirstlane(lst[0]);
            load_frag8(FA, Ks8, Vs8, (ent & 0xffff) * 64, g, fr);
            for (int i = 0; i < nlist; ++i) {
                const int blk = ent & 0xffff; const bool colok = ((ent >> (16 + qi)) & 1) != 0;
                load_frag8(FB, Ks8, Vs8, blk * 64 + 32, g, fr);
                compute_fp8(FA, blk * 64, tq, colok, q8, m, lsum, O, tab, hd + hk * 4, g);
                const int nent = __builtin_amdgcn_readfirstlane(lst[(i + 1 < nlist) ? i + 1 : i]);
                load_frag8(FA, Ks8, Vs8, (nent & 0xffff) * 64, g, fr);
                compute_fp8(FB, blk * 64 + 32, tq, colok, q8, m, lsum, O, tab, hd + hk * 4, g);
                ent = nent;
            }
            float l = lsum; l += __shfl_xor(l, 16); l += __shfl_xor(l, 32);
            const float sc = (l > 0.f ? 1.f / l : 0.f) * g1 * (1.f / 256.f);
#pragma unroll
            for (int dt = 0; dt < 8; ++dt) OA[dt] = OA[dt] + O[dt] * sc;
        }
        {
            const bf16_t* Kw = kw + (size_t)hk * T * HD; const bf16_t* Vw = vwT + (size_t)hk * HD * T;
            float m = -1e30f, lsum = 0.f;
#pragma unroll
            for (int dt = 0; dt < 8; ++dt) O[dt] = (f32x4){0.f, 0.f, 0.f, 0.f};
            const int kstart = max(0, t0 - 511) & ~31;
            for (int k0 = kstart; k0 <= t0 + 3; k0 += 32) att_step<2>(Kw, Vw, T, k0, tq, true, qf, m, lsum, O, 0.f, tab, hd + hk * 4, imp, g, fr);
            float l = lsum; l += __shfl_xor(l, 16); l += __shfl_xor(l, 32);
            const float sc = (l > 0.f ? 1.f / l : 0.f) * g2;
#pragma unroll
            for (int dt = 0; dt < 8; ++dt) OA[dt] = OA[dt] + O[dt] * sc;
        }
        { bf16_t* op = qo + (size_t)tq * D + head * HD + 4 * g;
#pragma unroll
          for (int dt = 0; dt < 8; ++dt) { u32x2 w; w.x = cvt_pk_bf16(OA[dt][0], OA[dt][1]); w.y = cvt_pk_bf16(OA[dt][2], OA[dt][3]); *(u32x2*)(op + dt * 16) = w; } }
        __builtin_amdgcn_wave_barrier(); asm volatile("s_waitcnt lgkmcnt(0)" ::: "memory");
    }
}

__global__ void __launch_bounds__(NWAVES * 64, 2) fwd_megakernel(Args args) {
    extern __shared__ __attribute__((aligned(16))) unsigned char lds_raw[];
    __builtin_assume(__builtin_amdgcn_workitem_id_y() == 0); __builtin_assume(__builtin_amdgcn_workitem_id_z() == 0);
    cg::grid_group grid = cg::this_grid();
    Ctx C; C.lds = (LAS unsigned char*)lds_raw; C.tid = threadIdx.x; C.lane = C.tid & 63; C.wave = __builtin_amdgcn_readfirstlane(C.tid >> 6);
    const int G = args.G, bx = blockIdx.x;
    C.gw = bx * NWAVES + C.wave; C.NGW = G * NWAVES; C.gtid = bx * (NWAVES * 64) + C.tid; C.NT = G * NWAVES * 64;
    unsigned char* ws = args.ws;
#define x_in (args.in[0])
#define pin (args.in[1])
#define w_in (args.in[2])
#define conv_w (args.in[3])
#define pe_k (args.in[4])
#define w1_k (args.in[5])
#define w2_k (args.in[6])
#define pe_v (args.in[7])
#define w1_v (args.in[8])
#define w2_v (args.in[9])
#define w_conv_out (args.in[10])
#define w_attn_out (args.in[11])
#define w_mix_out (args.in[12])
#define ln1_g (args.in[13])
#define ln1_b (args.in[14])
#define w_up (args.in[15])
#define w_down (args.in[16])
#define w_ple (args.in[17])
#define w_ple_gate (args.in[18])
#define ln2_g (args.in[19])
#define ln2_b (args.in[20])
#define rel_bias (args.in[21])
#define BP(off) ((bf16_t*)(ws + (off)))
#define FP(off) ((float*)(ws + (off)))
#define XB BP(WS_XB)
#define WTIN BP(WS_WTIN)
#define WTVT BP(WS_WTVT)
#define WTMB BP(WS_WTMB)
#define W1K BP(WS_W1K)
#define W1V BP(WS_W1V)
#define BIASK FP(WS_BIASK)
#define BIASV FP(WS_BIASV)
#define HIDK BP(WS_HIDK)
#define HIDV BP(WS_HIDV)
#define KC BP(WS_KC)
#define VCT BP(WS_VCT)
#define GATES FP(WS_GATES)
#define BG BP(WS_BG)
#define ZZ BP(WS_ZZ)
#define Q BP(WS_Q)
#define KCS BP(WS_KCS)
#define VCS BP(WS_VCS)
#define KS BP(WS_KS)
#define KW BP(WS_KW)
#define VST BP(WS_VST)
#define VWT BP(WS_VWT)
#define SMA BP(WS_SMA)
#define SMB BP(WS_SMB)
#define WTCONV BP(WS_WTCONV)
#define WTATTN BP(WS_WTATTN)
#define WTMIX BP(WS_WTMIX)
#define WTGATE BP(WS_WTGATE)
#define WTPLE BP(WS_WTPLE)
#define PB BP(WS_PB)
#define WTUP BP(WS_WTUP)
#define WTDOWN BP(WS_WTDOWN)
#define PRE1 FP(WS_PRE1)
#define PRE2 FP(WS_PRE2)
#define X1B BP(WS_X1B)
#define H1 BP(WS_H1)
    const int lo = args.ph_lo, hi = args.ph_hi;
    unsigned* gbar = (unsigned*)(ws + 16384); int nbar = 0;
    if (lo == 12345) grid.sync();
#ifndef PHMASK
#define PHMASK 0xFFFF
#endif
#define IN(k) (((PHMASK >> (k)) & 1) && lo <= (k) && (k) < hi)
#define SEAM(k) do { if (IN(k) && IN((k) + 1)) { ++nbar; \
        asm volatile("s_waitcnt vmcnt(0) lgkmcnt(0)" ::: "memory"); __syncthreads(); \
        if (C.tid == 0) { __builtin_amdgcn_fence(__ATOMIC_RELEASE, "agent"); asm volatile("s_waitcnt vmcnt(0)" ::: "memory"); \
            __hip_atomic_fetch_add(gbar, 1u, __ATOMIC_RELAXED, __HIP_MEMORY_SCOPE_AGENT); \
            while (__hip_atomic_load(gbar, __ATOMIC_RELAXED, __HIP_MEMORY_SCOPE_AGENT) < (unsigned)(nbar * G)) __builtin_amdgcn_s_sleep(2); \
            __builtin_amdgcn_fence(__ATOMIC_ACQUIRE, "agent"); asm volatile("s_waitcnt vmcnt(0)" ::: "memory"); } \
        __syncthreads(); \
        __builtin_amdgcn_fence(__ATOMIC_ACQUIRE, "agent"); asm volatile("s_waitcnt vmcnt(0)" ::: "memory"); } } while (0)

    if (IN(0)) {
        cvt_job(C, x_in, XB, (size_t)T * D / 8);
        tr_job(C, w_in, D, NIN, 2048, 2048, WTIN, D, 0, 128, 256);
        tr_job(C, w_in, D, NIN, 4096, 2048, WTIN, D, 128, 128, 256);
        tr_job(C, w_in, D, NIN, 0, 2048, WTIN, D, 4096, 2048, 0);
        tr_job(C, w_in, D, NIN, 6144, 2048, WTIN, D, 6144, 2048, 0);
        tr_job(C, w_in, D, NIN, 8192, 512, WTIN, D, 8192, 512, 0);
        tr_job(C, w_in, D, NIN, 8704, 512, WTIN, D, 8704, 512, 0);
        tr_job(C, w_in, D, NIN, 9216, 512, WTIN, D, 9216, 512, 0);
        tr_job(C, w_in, D, NIN, 10240, 512, WTIN, D, 9728, 512, 0);
        tr_job(C, w_in, D, NIN, 11312, 2048, WTIN, D, 10240, 2048, 0);
        tr_job(C, w_in, D, NIN, 9728, 512, WTVT, D, 0, 512, 0);
        tr_job(C, w_in, D, NIN, 10752, 512, WTVT, D, 512, 512, 0);
        tr_job(C, w_in, D, NIN, 13360, 2048, WTMB, D, 0, 2048, 0);
        tr_job(C, w1_k, 4096, 256, 0, 256, W1K, 4096, 0, 256, 0);
        tr_job(C, w1_v, 4096, 256, 0, 256, W1V, 4096, 0, 256, 0);
        for (int i = C.gtid; i < 256 * D; i += C.NT) { const int r = i / D, k = i % D; const float v = (r < 48) ? w_in[(size_t)k * NIN + 11264 + r] : 0.f; WTIN[(size_t)(12288 + r) * D + k] = (bf16_t)(cvt_pk_bf16(v, 0.f) & 0xffff); }
        if (bx == G - 1) {
            const int n = C.tid & 255; const float* pe = (C.tid < 256) ? pe_k : pe_v; const float* w1 = (C.tid < 256) ? w1_k : w1_v; float s = 0.f;
            for (int j = 0; j < 4096; ++j) s += pe[j] * w1[(size_t)j * 256 + n];
            ((C.tid < 256) ? BIASK : BIASV)[n] = s;
        }
        asm volatile("s_waitcnt vmcnt(0) lgkmcnt(0)" ::: "memory"); __syncthreads();
    }
    SEAM(0);
    if (IN(1)) {
        { pg8::Gemm g{XB, WTIN, T, 12544, D, D, D}; pg8::StaticOrder S; S.init(T, 12544, G, bx);
          EpiInProj E{ZZ, BG, Q, KCS, SMA, GATES, ws + 492 * MiB};
          pg8::gemm_phase(C.lds, g, S, E); }
        { pg8::Gemm g{WTVT, XB, 1024, T, D, D, D}; pg8::StaticOrder S; S.init(1024, T, G, (bx + 64) % G);
          pg8::EpiGen<FStoreVT> E{{VST, ws + 500 * MiB}};
          pg8::gemm_phase(C.lds, g, S, E); }
    }
    SEAM(1);
    if (IN(2)) {
        if (bx < 32) {
            { pg8::Gemm g{KCS, W1K, 4096, 256, 4096, 2048, 4096}; pg8::StaticOrder S; S.init(4096, 256, G, bx < 16 ? bx : -1); S.G = 16;
              pg8::EpiGen<FGeluBias> E{{HIDK, 256, BIASK}}; pg8::gemm_phase(C.lds, g, S, E); }
            { pg8::Gemm g{VCS, W1V, 4096, 256, 4096, 2048, 4096}; pg8::StaticOrder S; S.init(4096, 256, G, (bx >= 16 && bx < 32) ? bx - 16 : -1); S.G = 16;
              pg8::EpiGen<FGeluBias> E{{HIDV, 256, BIASV}}; pg8::gemm_phase(C.lds, g, S, E); }
        } else
        for (size_t i = (size_t)(bx - 32) * (NWAVES * 64) + C.tid; i < (size_t)T * D / 8; i += (size_t)(G - 32) * (NWAVES * 64)) {
            const int t = (int)(i / (D / 8)), c8 = (int)(i % (D / 8)) * 8;
            f32x4 z0a, z0b, z1a = {0.f, 0.f, 0.f, 0.f}, z1b = z1a, z2a = z1a, z2b = z1a, ba, bb;
            unpack8(*(const u32x4*)(ZZ + (size_t)t * D + c8), z0a, z0b);
            if (t >= 1) unpack8(*(const u32x4*)(ZZ + (size_t)(t - 1) * D + c8), z1a, z1b);
            if (t >= 2) unpack8(*(const u32x4*)(ZZ + (size_t)(t - 2) * D + c8), z2a, z2b);
            unpack8(*(const u32x4*)(BG + (size_t)t * D + c8), ba, bb);
            const f32x4 w0a = *(const f32x4*)(conv_w + c8), w0b = *(const f32x4*)(conv_w + c8 + 4);
            const f32x4 w1a = *(const f32x4*)(conv_w + D + c8), w1b = *(const f32x4*)(conv_w + D + c8 + 4);
            const f32x4 w2a = *(const f32x4*)(conv_w + 2 * D + c8), w2b = *(const f32x4*)(conv_w + 2 * D + c8 + 4);
            const f32x4 ua = ba * (w0a * z2a + w1a * z1a + w2a * z0a), ub = bb * (w0b * z2b + w1b * z1b + w2b * z0b);
            *(u32x4*)(BG + (size_t)t * D + c8) = pack8(ua, ub);
        }
    }
    SEAM(2);
    if (IN(3)) {
        { pg8::Gemm g{XB, WTMB, T, D, D, D, D}; pg8::StaticOrder S; S.init(T, D, G, bx);
          pg8::EpiGen<FStoreBf16> E{{SMB, D, 1}}; pg8::gemm_phase(C.lds, g, S, E); }
    }
    SEAM(3);
    if (IN(4)) {
        for (int i = C.gtid; i < 4096 * HD; i += C.NT) {
            const int d = i & 127, row = i >> 7; const bf16_t* hp = HIDK + (size_t)row * 256; float s = 0.f;
            for (int j = 0; j < 256; j += 2) { const unsigned w = *(const unsigned*)(hp + j); s += bf_lo(w) * w2_k[(size_t)j * HD + d] + bf_hi(w) * w2_k[(size_t)(j + 1) * HD + d]; }
            { const int h = row >> 10, c = row & 1023; KC[(size_t)h * 131072 + ((size_t)(c >> 5) << 12) + ((c >> 2) & 1) * 2048 + (d >> 5) * 512 + (4 * ((c & 31) >> 3) + (c & 3)) * 32 + (d & 31)] = (bf16_t)(cvt_pk_bf16(s, 0.f) & 0xffff); }
        }
        for (int i = C.gtid; i < 4096 * HD; i += C.NT) {
            const int ii = i & 1023, d = (i >> 10) & 127, h = i >> 17; const bf16_t* hp = HIDV + (size_t)(h * 1024 + ii) * 256; float s = 0.f;
            for (int j = 0; j < 256; j += 2) { const unsigned w = *(const unsigned*)(hp + j); s += bf_lo(w) * w2_v[(size_t)j * HD + d] + bf_hi(w) * w2_v[(size_t)(j + 1) * HD + d]; }
            VCT[(size_t)h * 131072 + ((size_t)(ii >> 5) << 12) + (d >> 4) * 512 + (d & 15) * 32 + (ii & 31)] = (bf16_t)(cvt_pk_bf16(s, 0.f) & 0xffff);
        }
        tr_job(C, w_conv_out, D, D, 0, D, WTCONV, D, 0, D, 0);
        tr_job(C, w_attn_out, D, D, 0, D, WTATTN, D, 0, D, 0);
        tr_job(C, w_mix_out, D, D, 0, D, WTMIX, D, 0, D, 0);
        tr_job(C, w_ple_gate, D, D, 0, D, WTGATE, D, 0, D, 0);
        tr_job(C, w_ple, PLE, D, 0, D, WTPLE, PLE, 0, D, 0);
        tr_job(C, w_up, D, FF, 0, FF, WTUP, D, 0, FF, 0);
        tr_job(C, w_down, FF, D, 0, D, WTDOWN, FF, 0, D, 0);
        cvt_job(C, pin, PB, (size_t)T * PLE / 8);
        asm volatile("s_waitcnt vmcnt(0) lgkmcnt(0)" ::: "memory"); __syncthreads();
    }
    SEAM(4);
    if (IN(5)) {
        attention_phase(C, Q, KC, VCT, KS, VST, KW, VWT, GATES, rel_bias, ws + 492 * MiB, ws + 500 * MiB);
        asm volatile("s_waitcnt vmcnt(0) lgkmcnt(0)" ::: "memory"); __syncthreads();
    }
    SEAM(5);
    if (IN(6)) { pg8::Gemm g{BG, WTCONV, T, D, D, D, D}; pg8::StaticOrder S; S.init(T, D, G, bx); pg8::EpiGen<FMulInplace> E{{SMA, D}}; pg8::gemm_phase(C.lds, g, S, E); }
    SEAM(6);
    if (IN(7)) { pg8::Gemm g{Q, WTATTN, T, D, D, D, D}; pg8::StaticOrder S; S.init(T, D, G, bx); pg8::EpiGen<FMulAddInplace> E{{SMB, SMA, D}}; pg8::gemm_phase(C.lds, g, S, E); }
    SEAM(7);
    if (IN(8)) { pg8::Gemm g{SMB, WTMIX, T, D, D, D, D}; pg8::StaticOrder S; S.init(T, D, G, bx); pg8::EpiGen<FResidF32> E{{PRE1, x_in, D}}; pg8::gemm_phase(C.lds, g, S, E); }
    SEAM(8);
    if (IN(9)) ln_rows<true>(C, PRE1, ln1_g, ln1_b, X1B);
    SEAM(9);
    if (IN(10)) {
        { pg8::Gemm g{X1B, WTGATE, T, D, D, D, D}; pg8::StaticOrder S; S.init(T, D, G, bx); pg8::EpiGen<FSigmoidF32> E{{PRE2, D}}; pg8::gemm_phase(C.lds, g, S, E); }
        { pg8::Gemm g{X1B, WTUP, T / 2, FF, D, D, D}; pg8::StaticOrder S; S.init(T / 2, FF, G, bx); pg8::EpiGen<FStoreBf16> E{{H1, FF, 2}}; pg8::gemm_phase(C.lds, g, S, E); }
    }
    SEAM(10);
    if (IN(11)) { pg8::Gemm g{PB, WTPLE, T, D, PLE, PLE, PLE}; pg8::StaticOrder S; S.init(T, D, G, bx); pg8::EpiGen<FPle> E{{PRE2, X1B, D}}; pg8::gemm_phase(C.lds, g, S, E); }
    SEAM(11);
    if (IN(12)) { pg8::Gemm g{H1, WTDOWN, T / 2, D, FF, FF, FF}; pg8::StaticOrder S; S.init(T / 2, D, G, bx); pg8::EpiGen<FAccF32> E{{PRE2, D}}; pg8::gemm_phase(C.lds, g, S, E); }
    SEAM(12);
    if (IN(13)) { pg8::Gemm g{X1B + (size_t)(T / 2) * D, WTUP, T / 2, FF, D, D, D}; pg8::StaticOrder S; S.init(T / 2, FF, G, bx); pg8::EpiGen<FStoreBf16> E{{H1, FF, 2}}; pg8::gemm_phase(C.lds, g, S, E); }
    SEAM(13);
    if (IN(14)) { pg8::Gemm g{H1, WTDOWN, T / 2, D, FF, FF, FF}; pg8::StaticOrder S; S.init(T / 2, D, G, bx); pg8::EpiGen<FAccF32> E{{PRE2 + (size_t)(T / 2) * D, D}}; pg8::gemm_phase(C.lds, g, S, E); }
    SEAM(14);
    if (IN(15)) ln_rows<false>(C, PRE2, ln2_g, ln2_b, args.out);
#undef IN
#undef SEAM
}

extern "C" void kernel_launch(void* const* d_in, const int* in_sizes, int n_in, void* d_out, int out_size, void* d_ws, size_t ws_size, hipStream_t stream) {
    static int grid = 0;
    if (grid == 0) {
        if (n_in != 22 || ws_size < 508 * MiB) { fprintf(stderr, "kernel_launch: need 22 inputs and >= %zu bytes of workspace (got %d, %zu)\n", (size_t)WS_END, n_in, ws_size); grid = -1; return; }
        int dev = 0, cus = 0, per_cu = 0;
        hipGetDevice(&dev); hipDeviceGetAttribute(&cus, hipDeviceAttributeMultiprocessorCount, dev);
        if (hipFuncSetAttribute((const void*)fwd_megakernel, hipFuncAttributeMaxDynamicSharedMemorySize, LDS_BYTES) != hipSuccess) { fprintf(stderr, "kernel_launch: hipFuncSetAttribute failed\n"); grid = -1; return; }
        if (hipOccupancyMaxActiveBlocksPerMultiprocessor(&per_cu, (const void*)fwd_megakernel, NWAVES * 64, LDS_BYTES) != hipSuccess || per_cu < 1) { fprintf(stderr, "kernel_launch: occupancy query says %d\n", per_cu); per_cu = 1; }
        (void)hipGetLastError();
        grid = cus * 1;
    }
    if (grid < 0) return;
    Args a{};
    for (int i = 0; i < 22; ++i) a.in[i] = (const float*)d_in[i];
    a.out = (float*)d_out; a.ws = (unsigned char*)d_ws; a.G = grid; a.pad = 0;
#if MK_PER_PHASE
    for (int ph = 0; ph < 16; ++ph) { a.ph_lo = ph; a.ph_hi = ph + 1; void* kargs[] = {&a};
        hipError_t e = hipLaunchCooperativeKernel((const void*)fwd_megakernel, dim3(grid), dim3(NWAVES * 64), kargs, LDS_BYTES, stream);
        if (e != hipSuccess) { fprintf(stderr, "kernel_launch: launch failed: %s\n", hipGetErrorString(e)); break; } }
#else
    (void)hipMemsetAsync((char*)d_ws + 16384, 0, 256, stream);
    a.ph_lo = 0; a.ph_hi = 16; void* kargs[] = {&a};
    hipError_t e = hipLaunchCooperativeKernel((const void*)fwd_megakernel, dim3(grid), dim3(NWAVES * 64), kargs, LDS_BYTES, stream);
    if (e != hipSuccess) fprintf(stderr, "kernel_launch: cooperative launch failed: %s (grid %d)\n", hipGetErrorString(e), grid);
#endif
}
```

```cpp
#include <hip/hip_runtime.h>
#include <hip/hip_cooperative_groups.h>
#include <cstdio>
#include <cstdint>
namespace cg = cooperative_groups;

#define LAS __attribute__((address_space(3)))
typedef unsigned short bf16_t;
typedef short bf16x8 __attribute__((ext_vector_type(8)));
typedef float f32x4 __attribute__((ext_vector_type(4)));
typedef float f32x2 __attribute__((ext_vector_type(2)));
typedef unsigned u32x4 __attribute__((ext_vector_type(4)));
typedef unsigned u32x2 __attribute__((ext_vector_type(2)));

#ifndef MK_PER_PHASE
#define MK_PER_PHASE 0
#endif

constexpr int T = 16384, D = 2048, NIN = 15408, FF = 8192, PLE = 256, HK = 4, HD = 128, NCMP = 1024;
constexpr float DN_ALPHA = 1.189207115002721f;
constexpr float LN_EPS = 1e-5f;
constexpr int NWAVES = 8;
constexpr int LDS_BYTES = 147456;

constexpr size_t MiB = 1u << 20;
constexpr size_t WS_BIASK = 0, WS_BIASV = 4096;
constexpr size_t WS_XB = 1 * MiB;
constexpr size_t WS_WTUP = 1 * MiB, WS_WTDOWN = 33 * MiB;
constexpr size_t WS_WTIN = 65 * MiB;
constexpr size_t WS_WTVT = 114 * MiB;
constexpr size_t WS_WTMB = 118 * MiB;
constexpr size_t WS_WTCONV = 65 * MiB, WS_WTATTN = 73 * MiB, WS_WTMIX = 81 * MiB, WS_WTGATE = 89 * MiB, WS_WTPLE = 97 * MiB, WS_PB = 98 * MiB;
constexpr size_t WS_W1K = 126 * MiB, WS_W1V = 128 * MiB;
constexpr size_t WS_HIDK = 130 * MiB, WS_HIDV = 132 * MiB;
constexpr size_t WS_KC = 134 * MiB, WS_VCT = 135 * MiB;
constexpr size_t WS_GATES = 136 * MiB;
constexpr size_t WS_BG = 140 * MiB;
constexpr size_t WS_X1B = 140 * MiB;
constexpr size_t WS_ZZ = 204 * MiB;
constexpr size_t WS_SMB = 204 * MiB, WS_H1 = 204 * MiB;
constexpr size_t WS_Q = 268 * MiB;
constexpr size_t WS_KCS = 332 * MiB, WS_VCS = 348 * MiB, WS_KS = 364 * MiB, WS_KW = 380 * MiB, WS_VST = 396 * MiB, WS_VWT = 412 * MiB;
constexpr size_t WS_SMA = 428 * MiB;
constexpr size_t WS_PRE1 = 300 * MiB, WS_PRE2 = 364 * MiB;
constexpr size_t WS_END = 492 * MiB;

typedef __bf16 bf16x2_t __attribute__((ext_vector_type(2)));
__device__ __forceinline__ unsigned cvt_pk_bf16(float lo, float hi) { f32x2 v = {lo, hi}; bf16x2_t b = __builtin_convertvector(v, bf16x2_t); return __builtin_bit_cast(unsigned, b); }
__device__ __forceinline__ float bf_lo(unsigned w) { return __uint_as_float(w << 16); }
__device__ __forceinline__ float bf_hi(unsigned w) { return __uint_as_float(w & 0xffff0000u); }
__device__ __forceinline__ float fast_sigmoid(float x) { return __builtin_amdgcn_rcpf(1.f + __expf(-x)); }
__device__ __forceinline__ u32x4 pack8(const f32x4& a, const f32x4& b) { u32x4 w; w.x = cvt_pk_bf16(a[0], a[1]); w.y = cvt_pk_bf16(a[2], a[3]); w.z = cvt_pk_bf16(b[0], b[1]); w.w = cvt_pk_bf16(b[2], b[3]); return w; }
__device__ __forceinline__ void unpack8(const u32x4& w, f32x4& a, f32x4& b) { a[0] = bf_lo(w.x); a[1] = bf_hi(w.x); a[2] = bf_lo(w.y); a[3] = bf_hi(w.y); b[0] = bf_lo(w.z); b[1] = bf_hi(w.z); b[2] = bf_lo(w.w); b[3] = bf_hi(w.w); }

__device__ __forceinline__ long pack8_fp8(float a0, float a1, float a2, float a3, float a4, float a5, float a6, float a7) {
    int lo = __builtin_amdgcn_cvt_pk_fp8_f32(a0, a1, 0, false); lo = __builtin_amdgcn_cvt_pk_fp8_f32(a2, a3, lo, true);
    int hi = __builtin_amdgcn_cvt_pk_fp8_f32(a4, a5, 0, false); hi = __builtin_amdgcn_cvt_pk_fp8_f32(a6, a7, hi, true);
    return (long)(((unsigned long long)(unsigned)hi << 32) | (unsigned long long)(unsigned)lo);
}

namespace pg8 {
constexpr int BM = 256, BK = 64, HALF = 128, HTB = HALF * BK * 2, STAGE_BYTES = 8 * HTB, NXCD = 8, WGM = 8;
__host__ __device__ __forceinline__ int lds_byte(int r, int c) { const int st = (r >> 4) * 2 + (c >> 5), rr = r & 15, cc = c & 31, ob = rr * 64 + cc * 2; return st * 1024 + (ob ^ (((ob >> 9) & 1) << 5)); }
__host__ __device__ __forceinline__ void stage_rc(int b, int& R, int& C) { const int st = b / 1024, sb = b % 1024, swz = sb ^ (((sb >> 9) & 1) << 5); R = (st >> 1) * 16 + swz / 64; C = (st & 1) * 32 + (swz % 64) / 2; }
__host__ __device__ __forceinline__ int perm32(int rho) { const int n = rho >> 4, i = rho & 15; return 8 * (i >> 2) + 4 * n + (i & 3); }

struct Unit { int pm, pn; };
struct Gemm { const bf16_t* A; const bf16_t* Bt; int M, N, K, lda, ldb; };

struct StaticOrder {
    int nM, nN, nwg, G, c;
    __device__ void init(int M, int N, int G_, int c_) { nM = M / BM; nN = N / BM; nwg = nM * nN; G = G_; c = c_; }
    __device__ bool next(int i, Unit& u) const {
        const long L = (long)i * G + c; if (c < 0 || L >= nwg) return false;
        int wgid = (int)L; { const int q = nwg / NXCD, r = nwg % NXCD, xcd = wgid % NXCD, off = wgid / NXCD; wgid = (xcd < r ? xcd * (q + 1) : r * (q + 1) + (xcd - r) * q) + off; }
        const int nig = WGM * nN, gid = wgid / nig, fm = gid * WGM, gsz = (nM - fm) < WGM ? (nM - fm) : WGM;
        u.pm = fm + ((wgid % nig) % gsz); u.pn = (wgid % nig) / gsz; return true;
    }
};

template <class F> struct EpiGen {
    F f;
    __device__ __forceinline__ void operator()(const f32x4 (&acc)[2][2][4][2], const Unit& u, int wr, int wc, int fr, int fq) const {
        const int row0 = u.pm * BM + wr * 64 + fr, col0 = u.pn * BM + wc * 32 + 8 * fq;
#pragma unroll
        for (int ai = 0; ai < 2; ++ai)
#pragma unroll
            for (int m = 0; m < 4; ++m) {
                const int row = row0 + ai * HALF + m * 16;
#pragma unroll
                for (int bj = 0; bj < 2; ++bj) f(row, col0 + bj * HALF, acc[ai][bj][m][0], acc[ai][bj][m][1]);
            }
    }
};

template <class Epi, class Sched>
__device__ __forceinline__ void gemm_phase(LAS unsigned char* lds, const Gemm g, const Sched& S, const Epi& E) {
    const int tid = threadIdx.x, wid = __builtin_amdgcn_readfirstlane(tid >> 6), lane = tid & 63, wr = wid >> 2, wc = wid & 3, fr = lane & 15, fq = lane >> 4;
    const int K = g.K, nt = K / BK;
    unsigned voffA[2], voffB[2];
#pragma unroll
    for (int i = 0; i < 2; ++i) { int R, C; stage_rc(tid * 16 + i * 8192, R, C); const int Rb = (R & ~31) + perm32(R & 31);
        voffA[i] = (unsigned)(R * g.lda + C) * 2u; voffB[i] = (unsigned)(Rb * g.ldb + C) * 2u; }
    const size_t kstep = (size_t)(BK * 2);
    const size_t hstepA = (size_t)HALF * g.lda * 2, hstepB = (size_t)HALF * g.ldb * 2;
    const size_t tstepA = 2 * hstepA, tstepB = 2 * hstepB;
    const unsigned ldsw = (unsigned)wid * 1024u;
    const int aoff = lds_byte(wr * 64 + fr, fq * 8), boff = lds_byte(wc * 32 + fr, fq * 8);
#define PG8_SA(b, h) (((b) * 2 + (h)) * HTB)
#define PG8_SB(b, h) ((4 + (b) * 2 + (h)) * HTB)
#define PG8_STAGE(bufoff, gbase, voff) do { _Pragma("unroll") for (int _i = 0; _i < 2; ++_i) \
        __builtin_amdgcn_global_load_lds((const unsigned*)((const char*)(gbase) + (voff)[_i]), (LAS unsigned*)(lds + (bufoff) + ldsw + _i * 8192), 16, 0, 0); } while (0)
#define PG8_LDA(dst, b, h) do { _Pragma("unroll") for (int m = 0; m < 4; ++m) _Pragma("unroll") for (int k = 0; k < 2; ++k) dst[m][k] = *(const LAS bf16x8*)(lds + PG8_SA(b, h) + aoff + m * 2048 + k * 1024); } while (0)
#define PG8_LDB(dst, b, h) do { _Pragma("unroll") for (int n = 0; n < 2; ++n) _Pragma("unroll") for (int k = 0; k < 2; ++k) dst[n][k] = *(const LAS bf16x8*)(lds + PG8_SB(b, h) + boff + n * 2048 + k * 1024); } while (0)
#define PG8_MMA(ai, bj, At, Bt) do { __builtin_amdgcn_s_setprio(1); _Pragma("unroll") for (int m = 0; m < 4; ++m) _Pragma("unroll") for (int n = 0; n < 2; ++n) _Pragma("unroll") for (int k = 0; k < 2; ++k) \
        acc[ai][bj][m][n] = __builtin_amdgcn_mfma_f32_16x16x32_bf16(Bt[n][k], At[m][k], acc[ai][bj][m][n], 0, 0, 0); __builtin_amdgcn_s_setprio(0); } while (0)
#define PG8_WAIT_V(n) asm volatile("s_waitcnt vmcnt(" #n ")" ::: "memory")
#define PG8_WAIT_L(n) asm volatile("s_waitcnt lgkmcnt(" #n ")" ::: "memory")
#define PG8_BAR __builtin_amdgcn_s_barrier()
#define PG8_SCHED __builtin_amdgcn_sched_barrier(0)
    Unit cur, nxt; int ui = 0;
    if (!S.next(0, cur)) return;
    f32x4 acc[2][2][4][2];
#pragma unroll
    for (int a = 0; a < 2; ++a)
#pragma unroll
        for (int b = 0; b < 2; ++b)
#pragma unroll
            for (int m = 0; m < 4; ++m)
#pragma unroll
                for (int n = 0; n < 2; ++n) acc[a][b][m][n] = (f32x4){0.f, 0.f, 0.f, 0.f};
    bf16x8 At[4][2], B0[2][2], B1[2][2];
    const char* cA = (const char*)g.A + (size_t)cur.pm * tstepA; const char* cB = (const char*)g.Bt + (size_t)cur.pn * tstepB;
    PG8_STAGE(PG8_SB(0, 0), cB, voffB); PG8_STAGE(PG8_SB(0, 1), cB + hstepB, voffB); PG8_STAGE(PG8_SA(0, 0), cA, voffA); PG8_STAGE(PG8_SA(0, 1), cA + hstepA, voffA);
    if (wr == 1) PG8_BAR;
    PG8_WAIT_V(2); PG8_BAR;
    PG8_STAGE(PG8_SB(1, 0), cB + kstep, voffB); PG8_STAGE(PG8_SA(1, 0), cA + kstep, voffA); PG8_STAGE(PG8_SB(1, 1), cB + hstepB + kstep, voffB);
    PG8_WAIT_V(6); PG8_BAR;
    for (;;) {
        const bool has_next = S.next(ui + 1, nxt);
        const char* nA = has_next ? (const char*)g.A + (size_t)nxt.pm * tstepA : cA; const char* nB = has_next ? (const char*)g.Bt + (size_t)nxt.pn * tstepB : cB;
        for (int t = 0; t < nt; t += 2) {
            const bool last = (t == nt - 2);
            const char* a1 = cA + (size_t)(t + 1) * kstep;
            const char* a2 = last ? nA : cA + (size_t)(t + 2) * kstep; const char* b2 = last ? nB : cB + (size_t)(t + 2) * kstep;
            const char* a3 = a2 + kstep; const char* b3 = b2 + kstep;
            PG8_LDB(B0, 0, 0); PG8_LDB(B1, 0, 1); PG8_SCHED; PG8_LDA(At, 0, 0); PG8_STAGE(PG8_SA(1, 1), a1 + hstepA, voffA);
            PG8_WAIT_V(8); PG8_WAIT_L(0); PG8_BAR; PG8_MMA(0, 0, At, B0); PG8_MMA(0, 1, At, B1); PG8_BAR; PG8_SCHED;
            PG8_LDA(At, 0, 1); PG8_STAGE(PG8_SB(0, 0), b2, voffB); PG8_STAGE(PG8_SB(0, 1), b2 + hstepB, voffB); PG8_STAGE(PG8_SA(0, 0), a2, voffA);
            PG8_WAIT_V(8); PG8_WAIT_L(0); PG8_BAR; PG8_MMA(1, 0, At, B0); PG8_MMA(1, 1, At, B1); PG8_BAR; PG8_SCHED;
            PG8_LDB(B0, 1, 0); PG8_LDB(B1, 1, 1); PG8_SCHED; PG8_LDA(At, 1, 0); PG8_STAGE(PG8_SA(0, 1), a2 + hstepA, voffA);
            PG8_WAIT_V(8); PG8_WAIT_L(0); PG8_BAR; PG8_MMA(0, 0, At, B0); PG8_MMA(0, 1, At, B1); PG8_BAR; PG8_SCHED;
            PG8_LDA(At, 1, 1); PG8_STAGE(PG8_SB(1, 0), b3, voffB); PG8_STAGE(PG8_SB(1, 1), b3 + hstepB, voffB); PG8_STAGE(PG8_SA(1, 0), a3, voffA);
            PG8_WAIT_V(8); PG8_WAIT_L(0); PG8_BAR; PG8_MMA(1, 0, At, B0); PG8_MMA(1, 1, At, B1); PG8_BAR; PG8_SCHED;
        }
        if (wr == 0) PG8_BAR;
        E(acc, cur, wr, wc, fr, fq);
        if (!has_next) break;
#pragma unroll
        for (int a = 0; a < 2; ++a)
#pragma unroll
            for (int b = 0; b < 2; ++b)
#pragma unroll
                for (int m = 0; m < 4; ++m)
#pragma unroll
                    for (int n = 0; n < 2; ++n) acc[a][b][m][n] = (f32x4){0.f, 0.f, 0.f, 0.f};
        cur = nxt; cA = nA; cB = nB; ++ui;
        if (wr == 1) PG8_BAR;
    }
    PG8_WAIT_V(0);
    PG8_BAR;
#undef PG8_SA
#undef PG8_SB
#undef PG8_STAGE
#undef PG8_LDA
#undef PG8_LDB
#undef PG8_MMA
#undef PG8_WAIT_V
#undef PG8_WAIT_L
#undef PG8_BAR
#undef PG8_SCHED
}
}

struct FStoreBf16 {
    bf16_t* O; int ldc; int act;
    __device__ __forceinline__ void operator()(int row, int col, f32x4 a, f32x4 b) const {
        if (act == 1) { for (int i = 0; i < 4; ++i) { a[i] = fast_sigmoid(a[i]); b[i] = fast_sigmoid(b[i]); } }
        else if (act == 2) { for (int i = 0; i < 4; ++i) { float x = fmaxf(a[i], 0.f), y = fmaxf(b[i], 0.f); a[i] = x * x; b[i] = y * y; } }
        *(u32x4*)(O + (size_t)row * ldc + col) = pack8(a, b);
    }
};
struct FStoreVT {
    bf16_t* O; unsigned char* O8;
    __device__ __forceinline__ void operator()(int row, int col, f32x4 a, f32x4 b) const {
        if (row < 512) { const int hk = row >> 7, d = row & 127; *(long*)(O8 + (size_t)hk * ((size_t)T * 128) + ((size_t)(col >> 5) << 12) + (d >> 4) * 512 + (d & 15) * 32 + (col & 31)) = pack8_fp8(a[0], a[1], a[2], a[3], b[0], b[1], b[2], b[3]); *(u32x4*)(O + (size_t)hk * ((size_t)T * 128) + ((size_t)(col >> 5) << 12) + (d >> 4) * 512 + (d & 15) * 32 + (col & 31)) = pack8(a, b); }
        else { const int hk = (row - 512) >> 7, d = row & 127; *(u32x4*)(O + (size_t)512 * T + (size_t)hk * ((size_t)T * 128) + ((size_t)(col >> 5) << 12) + (d >> 4) * 512 + (d & 15) * 32 + (col & 31)) = pack8(a, b); }
    }
};
struct FGeluBias {
    bf16_t* O; int ldc; const float* bias;
    __device__ __forceinline__ void operator()(int row, int col, f32x4 a, f32x4 b) const {
        const f32x4 b0 = *(const f32x4*)(bias + col), b1 = *(const f32x4*)(bias + col + 4);
        a = a + b0; b = b + b1;
        for (int i = 0; i < 4; ++i) {
            float x = a[i]; a[i] = x * __builtin_amdgcn_rcpf(1.f + __expf(-1.5957691216057308f * (x + 0.044715f * x * x * x)));
            float y = b[i]; b[i] = y * __builtin_amdgcn_rcpf(1.f + __expf(-1.5957691216057308f * (y + 0.044715f * y * y * y)));
        }
        *(u32x4*)(O + (size_t)row * ldc + col) = pack8(a, b);
    }
};
struct FMulInplace {
    bf16_t* O; int ldc;
    __device__ __forceinline__ void operator()(int row, int col, f32x4 a, f32x4 b) const {
        bf16_t* p = O + (size_t)row * ldc + col; f32x4 g0, g1; unpack8(*(const u32x4*)p, g0, g1);
        *(u32x4*)p = pack8(a * g0, b * g1);
    }
};
struct FMulAddInplace {
    bf16_t* O; const bf16_t* Y; int ldc;
    __device__ __forceinline__ void operator()(int row, int col, f32x4 a, f32x4 b) const {
        bf16_t* p = O + (size_t)row * ldc + col; f32x4 g0, g1, y0, y1; unpack8(*(const u32x4*)p, g0, g1); unpack8(*(const u32x4*)(Y + (size_t)row * ldc + col), y0, y1);
        *(u32x4*)p = pack8(a * g0 + y0, b * g1 + y1);
    }
};
struct FResidF32 {
    float* P; const float* X; int ldc;
    __device__ __forceinline__ void operator()(int row, int col, f32x4 a, f32x4 b) const {
        const size_t o = (size_t)row * ldc + col;
        const f32x4 x0 = *(const f32x4*)(X + o), x1 = *(const f32x4*)(X + o + 4);
        *(f32x4*)(P + o) = x0 * DN_ALPHA + a; *(f32x4*)(P + o + 4) = x1 * DN_ALPHA + b;
    }
};
struct FSigmoidF32 {
    float* P; int ldc;
    __device__ __forceinline__ void operator()(int row, int col, f32x4 a, f32x4 b) const {
        for (int i = 0; i < 4; ++i) { a[i] = fast_sigmoid(a[i]); b[i] = fast_sigmoid(b[i]); }
        const size_t o = (size_t)row * ldc + col; *(f32x4*)(P + o) = a; *(f32x4*)(P + o + 4) = b;
    }
};
struct FPle {
    float* P; const bf16_t* X; int ldc;
    __device__ __forceinline__ void operator()(int row, int col, f32x4 a, f32x4 b) const {
        const size_t o = (size_t)row * ldc + col; f32x4 x0, x1; unpack8(*(const u32x4*)(X + o), x0, x1);
        const f32x4 p0 = *(const f32x4*)(P + o), p1 = *(const f32x4*)(P + o + 4);
        *(f32x4*)(P + o) = a * p0 + x0 * DN_ALPHA; *(f32x4*)(P + o + 4) = b * p1 + x1 * DN_ALPHA;
    }
};
struct FAccF32 {
    float* P; int ldc;
    __device__ __forceinline__ void operator()(int row, int col, f32x4 a, f32x4 b) const {
        const size_t o = (size_t)row * ldc + col;
        *(f32x4*)(P + o) = *(const f32x4*)(P + o) + a; *(f32x4*)(P + o + 4) = *(const f32x4*)(P + o + 4) + b;
    }
};
struct EpiInProj {
    bf16_t *zz, *bg, *q, *kv, *sma; float* gates; unsigned char* ks8;
    __device__ __forceinline__ void operator()(const f32x4 (&acc)[2][2][4][2], const pg8::Unit& u, int wr, int wc, int fr, int fq) const {
        const int row0 = u.pm * 256 + wr * 64 + fr, cw = wc * 32 + 8 * fq; const int pn = u.pn;
        if (pn < 16) {
#pragma unroll
            for (int ai = 0; ai < 2; ++ai)
#pragma unroll
                for (int m = 0; m < 4; ++m) { const int row = row0 + ai * 128 + m * 16;
                    *(u32x4*)(zz + (size_t)row * D + pn * 128 + cw) = pack8(acc[ai][0][m][0] * acc[ai][1][m][0], acc[ai][0][m][1] * acc[ai][1][m][1]); }
        } else if (pn < 32) {
            bf16_t* O = (pn < 24) ? bg : q; const int c0 = ((pn - 16) & 7) * 256 + cw;
#pragma unroll
            for (int ai = 0; ai < 2; ++ai)
#pragma unroll
                for (int m = 0; m < 4; ++m) { const int row = row0 + ai * 128 + m * 16;
#pragma unroll
                    for (int bj = 0; bj < 2; ++bj) *(u32x4*)(O + (size_t)row * D + c0 + bj * 128) = pack8(acc[ai][bj][m][0], acc[ai][bj][m][1]); }
        } else if (pn < 40) {
            const int c0 = (pn - 32) * 256; const int b = c0 >> 9, h0 = (c0 & 511) >> 7;
            bf16_t* O = kv + (size_t)b * ((size_t)T * 512);
#pragma unroll
            for (int ai = 0; ai < 2; ++ai)
#pragma unroll
                for (int m = 0; m < 4; ++m) { const int row = row0 + ai * 128 + m * 16;
#pragma unroll
                    for (int bj = 0; bj < 2; ++bj) {
                        const size_t off = (b >= 2) ? (((size_t)(row >> 5) << 12) + ((row >> 2) & 1) * 2048 + (cw >> 5) * 512 + (4 * ((row & 31) >> 3) + (row & 3)) * 32 + (cw & 31))
                                                    : ((size_t)row * 128 + cw);
                        *(u32x4*)(O + (size_t)(h0 + bj) * ((size_t)T * 128) + off) = pack8(acc[ai][bj][m][0], acc[ai][bj][m][1]);
                        if (b == 2) { const f32x4 a = acc[ai][bj][m][0], c2 = acc[ai][bj][m][1]; *(long*)(ks8 + (size_t)(h0 + bj) * ((size_t)T * 128) + off) = pack8_fp8(a[0], a[1], a[2], a[3], c2[0], c2[1], c2[2], c2[3]); } } }
        } else if (pn < 48) {
            const int c0 = (pn - 40) * 256 + cw;
#pragma unroll
            for (int ai = 0; ai < 2; ++ai)
#pragma unroll
                for (int m = 0; m < 4; ++m) { const int row = row0 + ai * 128 + m * 16;
#pragma unroll
                    for (int bj = 0; bj < 2; ++bj) { f32x4 a = acc[ai][bj][m][0], b = acc[ai][bj][m][1];
                        for (int i = 0; i < 4; ++i) { a[i] = fast_sigmoid(a[i]); b[i] = fast_sigmoid(b[i]); }
                        *(u32x4*)(sma + (size_t)row * D + c0 + bj * 128) = pack8(a, b); } }
        } else {
            if (cw < 48) {
#pragma unroll
                for (int ai = 0; ai < 2; ++ai)
#pragma unroll
                    for (int m = 0; m < 4; ++m) { const int row = row0 + ai * 128 + m * 16; f32x4 a = acc[ai][0][m][0], b = acc[ai][0][m][1];
                        for (int i = 0; i < 4; ++i) { a[i] = fast_sigmoid(a[i]); b[i] = fast_sigmoid(b[i]); }
                        *(f32x4*)(gates + (size_t)row * 48 + cw) = a; *(f32x4*)(gates + (size_t)row * 48 + cw + 4) = b; }
            }
        }
    }
};

struct Args {
    const float* in[22]; float* out; unsigned char* ws; int ph_lo, ph_hi, G, pad;
};

struct Ctx { int tid, lane, wave, gw, NGW, gtid, NT; LAS unsigned char* lds; };

__device__ __forceinline__ void tr_item(const float* W, int ldw, int k0, int nsrc0, bf16_t* WT, int ldt, int drow0, LAS float* scr, int lane) {
#pragma unroll 8
    for (int i = 0; i < 32; ++i) { const int kk = 2 * i + (lane >> 5); scr[kk * 33 + (lane & 31)] = W[(size_t)(k0 + kk) * ldw + nsrc0 + (lane & 31)]; }
    asm volatile("s_waitcnt lgkmcnt(0)" ::: "memory");
    const int c = lane & 7;
#pragma unroll
    for (int j = 0; j < 4; ++j) { const int n = (lane >> 3) + 8 * j; const LAS float* s = scr + (8 * c) * 33 + n;
        u32x4 o; o.x = cvt_pk_bf16(s[0 * 33], s[1 * 33]); o.y = cvt_pk_bf16(s[2 * 33], s[3 * 33]); o.z = cvt_pk_bf16(s[4 * 33], s[5 * 33]); o.w = cvt_pk_bf16(s[6 * 33], s[7 * 33]);
        *(u32x4*)(WT + (size_t)(drow0 + n) * ldt + k0 + 8 * c) = o; }
    asm volatile("s_waitcnt lgkmcnt(0)" ::: "memory");
}
__device__ __forceinline__ void tr_job(const Ctx& C, const float* W, int K, int ldw, int ncol0, int ncols, bf16_t* WT, int ldt, int drow0, int grp, int grp_stride) {
    LAS float* scr = (LAS float*)(C.lds + C.wave * 16384);
    const int nblk = ncols / 32, items = (K / 64) * nblk;
    for (int it = C.gw; it < items; it += C.NGW) {
        const int kb = it / nblk, n = (it % nblk) * 32; const int drow = drow0 + (n / grp) * grp_stride + (n % grp);
        tr_item(W, ldw, kb * 64, ncol0 + n, WT, ldt, drow, scr, C.lane);
    }
}
__device__ __forceinline__ void cvt_job(const Ctx& C, const float* X, bf16_t* O, size_t n8) {
    for (size_t i = C.gtid; i < n8; i += C.NT) { const f32x4 a = *(const f32x4*)(X + i * 8), b = *(const f32x4*)(X + i * 8 + 4); *(u32x4*)(O + i * 8) = pack8(a, b); }
}

template <bool OUT_BF16>
__device__ __forceinline__ void ln_rows(const Ctx& C, const float* P, const float* gam, const float* bet, void* outp) {
    for (int r = C.gw; r < T; r += C.NGW) {
        const f32x4* xr = (const f32x4*)(P + (size_t)r * D) + C.lane;
        f32x4 v[8]; float s = 0.f;
#pragma unroll
        for (int j = 0; j < 8; ++j) { v[j] = xr[64 * j]; s += (v[j][0] + v[j][1]) + (v[j][2] + v[j][3]); }
#pragma unroll
        for (int o = 1; o < 64; o <<= 1) s += __shfl_xor(s, o);
        const float mean = s * (1.f / D); float s2 = 0.f;
#pragma unroll
        for (int j = 0; j < 8; ++j) { v[j] = v[j] - mean; s2 += (v[j][0] * v[j][0] + v[j][1] * v[j][1]) + (v[j][2] * v[j][2] + v[j][3] * v[j][3]); }
#pragma unroll
        for (int o = 1; o < 64; o <<= 1) s2 += __shfl_xor(s2, o);
        const float rstd = 1.f / sqrtf(s2 * (1.f / D) + LN_EPS);
#pragma unroll
        for (int j = 0; j < 8; ++j) {
            const f32x4 gg = *((const f32x4*)gam + C.lane + 64 * j), bb = *((const f32x4*)bet + C.lane + 64 * j);
            const f32x4 y = v[j] * rstd * gg + bb;
            if (OUT_BF16) { u32x2 w; w.x = cvt_pk_bf16(y[0], y[1]); w.y = cvt_pk_bf16(y[2], y[3]); *((u32x2*)((bf16_t*)outp + (size_t)r * D) + C.lane + 64 * j) = w; }
            else *((f32x4*)((float*)outp + (size_t)r * D) + C.lane + 64 * j) = y;
        }
    }
}

constexpr float SC_LOG2E = 0.08838834764831845f * 1.4426950408889634f;
__device__ __forceinline__ int rel_bucket(int n) {
    const int e = 31 - __builtin_clz((unsigned)(n | 1));
    const int odd = ((unsigned)n * (unsigned)n >= (1u << (2 * e + 1))) ? 1 : 0;
    const int lg = min(31, 8 + 2 * e + odd);
    return n < 16 ? n : lg;
}
template <int MODE>
__device__ __forceinline__ void att_step(const bf16_t* __restrict__ Kp, const bf16_t* __restrict__ VTp, int ldv, int key0, int tq, bool colok,
                                         const bf16x8 (&qf)[4], float& m, float& lsum, f32x4 (&O)[8], float inv_l,
                                         const LAS float* tab, int hd16, LAS float* impq, int g, int fr) {
    bf16x8 ka[4], kb[4], vf[8];
    {
        const bf16_t* kq = Kp + ((size_t)(key0 >> 5) << 12) + fr * 32 + 8 * g;
#pragma unroll
        for (int dc = 0; dc < 4; ++dc) { ka[dc] = *(const bf16x8*)(kq + dc * 512); kb[dc] = *(const bf16x8*)(kq + 2048 + dc * 512); }
        if (MODE != 0) { const bf16_t* vq = VTp + ((size_t)(key0 >> 5) << 12) + fr * 32 + 8 * g;
#pragma unroll
            for (int dt = 0; dt < 8; ++dt) vf[dt] = *(const bf16x8*)(vq + dt * 512); }
    }
    f32x4 sa = {0.f, 0.f, 0.f, 0.f}, sb = {0.f, 0.f, 0.f, 0.f};
#pragma unroll
    for (int dc = 0; dc < 4; ++dc) { sa = __builtin_amdgcn_mfma_f32_16x16x32_bf16(ka[dc], qf[dc], sa, 0, 0, 0); sb = __builtin_amdgcn_mfma_f32_16x16x32_bf16(kb[dc], qf[dc], sb, 0, 0, 0); }
    float s[8]; bool ok[8];
#pragma unroll
    for (int e = 0; e < 8; ++e) {
        const int idx = key0 + 8 * g + e;
        const int dist = (MODE < 2) ? (tq - 31 - 16 * idx) : (tq - idx);
        ok[e] = (MODE < 2) ? (dist >= 0) : (MODE == 2 ? (dist >= 0 && dist < 512) : (dist >= 0 && colok));
        const int bk = rel_bucket(max(dist, 0));
        const float sv = (e < 4 ? sa[e & 3] : sb[e & 3]) * SC_LOG2E + tab[bk * 16 + hd16];
        s[e] = ok[e] ? sv : -1e30f;
    }
    float p[8];
    if (MODE != 1) {
        float mx = fmaxf(fmaxf(fmaxf(s[0], s[1]), fmaxf(s[2], s[3])), fmaxf(fmaxf(s[4], s[5]), fmaxf(s[6], s[7])));
        mx = fmaxf(mx, __shfl_xor(mx, 16)); mx = fmaxf(mx, __shfl_xor(mx, 32));
        const float mn = fmaxf(m, mx); const float alpha = __builtin_amdgcn_exp2f(m - mn); m = mn;
        float ps = 0.f;
#pragma unroll
        for (int e = 0; e < 8; ++e) { p[e] = ok[e] ? __builtin_amdgcn_exp2f(s[e] - mn) : 0.f; ps += p[e]; }
        lsum = lsum * alpha + ps;
        if (MODE != 0) {
#pragma unroll
            for (int dt = 0; dt < 8; ++dt) O[dt] = O[dt] * alpha;
        }
    } else {
#pragma unroll
        for (int e = 0; e < 8; ++e) p[e] = ok[e] ? __builtin_amdgcn_exp2f(s[e] - m) * inv_l : 0.f;
        const int G2 = (key0 >> 2) + 2 * g;
        atomicAdd((float*)(impq + G2), (p[0] + p[1]) + (p[2] + p[3]));
        atomicAdd((float*)(impq + G2 + 1), (p[3] + p[4]) + (p[5] + p[6]) + p[7]);
        atomicAdd((float*)(impq + G2 + 2), p[7]);
    }
    if (MODE != 0) {
        u32x4 pw; pw.x = cvt_pk_bf16(p[0], p[1]); pw.y = cvt_pk_bf16(p[2], p[3]); pw.z = cvt_pk_bf16(p[4], p[5]); pw.w = cvt_pk_bf16(p[6], p[7]);
        const bf16x8 pf = __builtin_bit_cast(bf16x8, pw);
#pragma unroll
        for (int dt = 0; dt < 8; ++dt) O[dt] = __builtin_amdgcn_mfma_f32_16x16x32_bf16(vf[dt], pf, O[dt], 0, 0, 0);
    }
}

struct Frag8 { long ka[4], kb[4], vf[8]; };
__device__ __forceinline__ void load_frag8(Frag8& F, const unsigned char* __restrict__ K8, const unsigned char* __restrict__ V8T, int key0, int g, int fr) {
    const unsigned char* kq = K8 + ((size_t)(key0 >> 5) << 12) + fr * 32 + 8 * g;
#pragma unroll
    for (int dc = 0; dc < 4; ++dc) { F.ka[dc] = *(const long*)(kq + dc * 512); F.kb[dc] = *(const long*)(kq + 2048 + dc * 512); }
    const unsigned char* vq = V8T + ((size_t)(key0 >> 5) << 12) + fr * 32 + 8 * g;
#pragma unroll
    for (int dt = 0; dt < 8; ++dt) F.vf[dt] = *(const long*)(vq + dt * 512);
}
__device__ __forceinline__ void compute_fp8(const Frag8& F, int key0, int tq, bool colok, const long (&q8)[4], float& m, float& lsum, f32x4 (&O)[8], const LAS float* tab, int hd16, int g) {
    f32x4 sa = {0.f, 0.f, 0.f, 0.f}, sb = {0.f, 0.f, 0.f, 0.f};
#pragma unroll
    for (int dc = 0; dc < 4; ++dc) { sa = __builtin_amdgcn_mfma_f32_16x16x32_fp8_fp8(F.ka[dc], q8[dc], sa, 0, 0, 0); sb = __builtin_amdgcn_mfma_f32_16x16x32_fp8_fp8(F.kb[dc], q8[dc], sb, 0, 0, 0); }
    float s[8]; bool ok[8];
#pragma unroll
    for (int e = 0; e < 8; ++e) {
        const int dist = tq - (key0 + 8 * g + e);
        ok[e] = dist >= 0 && colok;
        const int bk = rel_bucket(max(dist, 0));
        const float sv = (e < 4 ? sa[e & 3] : sb[e & 3]) * SC_LOG2E + tab[bk * 16 + hd16];
        s[e] = ok[e] ? sv : -1e30f;
    }
    float mx = fmaxf(fmaxf(fmaxf(s[0], s[1]), fmaxf(s[2], s[3])), fmaxf(fmaxf(s[4], s[5]), fmaxf(s[6], s[7])));
    mx = fmaxf(mx, __shfl_xor(mx, 16)); mx = fmaxf(mx, __shfl_xor(mx, 32));
    const float mn = fmaxf(m, mx); const float alpha = __builtin_amdgcn_exp2f(m - mn);
    const bool grew = __builtin_amdgcn_ballot_w64(mn > m) != 0ull; m = mn;
    float p[8]; float ps = 0.f;
#pragma unroll
    for (int e = 0; e < 8; ++e) { p[e] = ok[e] ? __builtin_amdgcn_exp2f(s[e] - mn) : 0.f; ps += p[e]; }
    lsum = lsum * alpha + ps;
    if (grew) {
#pragma unroll
        for (int dt = 0; dt < 8; ++dt) O[dt] = O[dt] * alpha;
    }
    const long pf = pack8_fp8(p[0] * 256.f, p[1] * 256.f, p[2] * 256.f, p[3] * 256.f, p[4] * 256.f, p[5] * 256.f, p[6] * 256.f, p[7] * 256.f);
#pragma unroll
    for (int dt = 0; dt < 8; ++dt) O[dt] = __builtin_amdgcn_mfma_f32_16x16x32_fp8_fp8(F.vf[dt], pf, O[dt], 0, 0, 0);
}

constexpr int IMP_STRIDE = 264;
__device__ __forceinline__ void attention_phase(const Ctx& C, bf16_t* qo, const bf16_t* kc, const bf16_t* vcT, const bf16_t* ks, const bf16_t* vsT,
                                                const bf16_t* kw, const bf16_t* vwT, const float* gates, const float* rel_bias, const unsigned char* ks8, const unsigned char* vs8) {
    LAS float* tab = (LAS float*)C.lds;
    LAS float* imp = (LAS float*)(C.lds + 4096 + C.wave * 8192);
    LAS int* lst = (LAS int*)(C.lds + 4096 + C.wave * 8192 + 4 * IMP_STRIDE * 4);
    for (int i = C.tid; i < 512; i += NWAVES * 64) tab[i] = rel_bias[i] * 1.4426950408889634f;
    __syncthreads();
    const int lane = C.lane, fr = lane & 15, g = lane >> 4, qi = fr >> 2, hd = fr & 3;
    const int hk = (int)(blockIdx.x & 3), wl = (int)(blockIdx.x >> 2) * NWAVES + C.wave, nwl = C.NGW >> 2;
    for (int qg = wl; qg < T / 4; qg += nwl) {
        const int t0 = qg * 4, tq = t0 + qi, head = hk * 4 + hd, jt = t0 >> 6;
        bf16x8 qf[4];
        { const bf16_t* qp = qo + (size_t)tq * D + head * HD + 8 * g;
#pragma unroll
          for (int dc = 0; dc < 4; ++dc) qf[dc] = *(const bf16x8*)(qp + dc * 32); }
        const float g0 = gates[(size_t)tq * 48 + head * 3 + 0], g1 = gates[(size_t)tq * 48 + head * 3 + 1], g2 = gates[(size_t)tq * 48 + head * 3 + 2];
        f32x4 OA[8];
#pragma unroll
        for (int dt = 0; dt < 8; ++dt) OA[dt] = (f32x4){0.f, 0.f, 0.f, 0.f};
        f32x4 O[8];
        for (int i = lane; i < 4 * IMP_STRIDE; i += 64) imp[i] = 0.f;
        __builtin_amdgcn_wave_barrier(); asm volatile("s_waitcnt lgkmcnt(0)" ::: "memory");
        const bf16_t* Kc = kc + (size_t)hk * NCMP * HD; const bf16_t* Vc = vcT + (size_t)hk * HD * NCMP;
        const int ncv = (t0 + 3 >= 31) ? ((t0 + 3 - 31) >> 4) + 1 : 0;
        const int nst = (ncv + 31) >> 5;
        {
            float m = -1e30f, lsum = 0.f;
            for (int st = 0; st < nst; ++st) att_step<0>(Kc, Vc, NCMP, st * 32, tq, true, qf, m, lsum, O, 0.f, tab, hd + 0 * 16 + (hk * 4), imp + qi * IMP_STRIDE, g, fr);
            float l = lsum; l += __shfl_xor(l, 16); l += __shfl_xor(l, 32);
            const float inv = l > 0.f ? 1.f / l : 0.f;
#pragma unroll
            for (int dt = 0; dt < 8; ++dt) O[dt] = (f32x4){0.f, 0.f, 0.f, 0.f};
            for (int st = 0; st < nst; ++st) att_step<1>(Kc, Vc, NCMP, st * 32, tq, true, qf, m, lsum, O, inv, tab, hd + hk * 4, imp + qi * IMP_STRIDE, g, fr);
#pragma unroll
            for (int dt = 0; dt < 8; ++dt) OA[dt] = OA[dt] + O[dt] * g0;
        }
        __builtin_amdgcn_wave_barrier(); asm volatile("s_waitcnt lgkmcnt(0)" ::: "memory");
        int nlist = 0;
        const int ncand = jt - 2;
        if (ncand <= 13) {
            if (lane <= jt) lst[lane] = lane | (0xF << 16);
            nlist = jt + 1;
        } else {
            if (lane == 0) { lst[0] = 0 | (0xF << 16); lst[1] = (jt - 1) | (0xF << 16); lst[2] = jt | (0xF << 16); }
            nlist = 3;
            for (int qq = 0; qq < 4; ++qq) {
                float v[4];
#pragma unroll
                for (int k = 0; k < 4; ++k) { const int sblk = 4 * lane + k; const float x = imp[qq * IMP_STRIDE + sblk]; v[k] = (sblk >= 1 && sblk <= jt - 2) ? x : -1.f; }
                for (int r = 0; r < 13; ++r) {
                    float lm = fmaxf(fmaxf(v[0], v[1]), fmaxf(v[2], v[3]));
                    float wm = lm;
#pragma unroll
                    for (int o = 1; o < 64; o <<= 1) wm = fmaxf(wm, __shfl_xor(wm, o));
                    const unsigned long long bal = __ballot(lm == wm);
                    const int src = __ffsll((long long)bal) - 1;
                    if (lane == src) {
                        int k = (v[0] == wm) ? 0 : (v[1] == wm) ? 1 : (v[2] == wm) ? 2 : 3;
                        if (k == 0) v[0] = -2.f; else if (k == 1) v[1] = -2.f; else if (k == 2) v[2] = -2.f; else v[3] = -2.f;
                        lst[nlist + r] = (4 * lane + k) | ((1 << qq) << 16);
                    }
                }
                nlist += 13;
            }
        }
        __builtin_amdgcn_wave_barrier(); asm volatile("s_waitcnt lgkmcnt(0)" ::: "memory");
        {
            const unsigned char* Ks8 = ks8 + (size_t)hk * T * HD; const unsigned char* Vs8 = vs8 + (size_t)hk * T * HD;
            long q8[4];
#pragma unroll
            for (int dc = 0; dc < 4; ++dc) { const u32x4 w = __builtin_bit_cast(u32x4, qf[dc]); q8[dc] = pack8_fp8(bf_lo(w[0]), bf_hi(w[0]), bf_lo(w[1]), bf_hi(w[1]), bf_lo(w[2]), bf_hi(w[2]), bf_lo(w[3]), bf_hi(w[3])); }
            float m = -1e30f, lsum = 0.f;
#pragma unroll
            for (int dt = 0; dt < 8; ++dt) O[dt] = (f32x4){0.f, 0.f, 0.f, 0.f};
            Frag8 FA, FB;
            int ent = __builtin_amdgcn_readfirstlane(lst[0]);
            load_frag8(FA, Ks8, Vs8, (ent & 0xffff) * 64, g, fr);
            for (int i = 0; i < nlist; ++i) {
                const int blk = ent & 0xffff; const bool colok = ((ent >> (16 + qi)) & 1) != 0;
                load_frag8(FB, Ks8, Vs8, blk * 64 + 32, g, fr);
                compute_fp8(FA, blk * 64, tq, colok, q8, m, lsum, O, tab, hd + hk * 4, g);
                const int nent = __builtin_amdgcn_readfirstlane(lst[(i + 1 < nlist) ? i + 1 : i]);
                load_frag8(FA, Ks8, Vs8, (nent & 0xffff) * 64, g, fr);
                compute_fp8(FB, blk * 64 + 32, tq, colok, q8, m, lsum, O, tab, hd + hk * 4, g);
                ent = nent;
            }
            float l = lsum; l += __shfl_xor(l, 16); l += __shfl_xor(l, 32);
            const float sc = (l > 0.f ? 1.f / l : 0.f) * g1 * (1.f / 256.f);
#pragma unroll
            for (int dt = 0; dt < 8; ++dt) OA[dt] = OA[dt] + O[dt] * sc;
        }
        {
            const bf16_t* Kw = kw + (size_t)hk * T * HD; const bf16_t* Vw = vwT + (size_t)hk * HD * T;
            float m = -1e30f, lsum = 0.f;
#pragma unroll
            for (int dt = 0; dt < 8; ++dt) O[dt] = (f32x4){0.f, 0.f, 0.f, 0.f};
            const int kstart = max(0, t0 - 511) & ~31;
            for (int k0 = kstart; k0 <= t0 + 3; k0 += 32) att_step<2>(Kw, Vw, T, k0, tq, true, qf, m, lsum, O, 0.f, tab, hd + hk * 4, imp, g, fr);
            float l = lsum; l += __shfl_xor(l, 16); l += __shfl_xor(l, 32);
            const float sc = (l > 0.f ? 1.f / l : 0.f) * g2;
#pragma unroll
            for (int dt = 0; dt < 8; ++dt) OA[dt] = OA[dt] + O[dt] * sc;
        }
        { bf16_t* op = qo + (size_t)tq * D + head * HD + 4 * g;
#pragma unroll
          for (int dt = 0; dt < 8; ++dt) { u32x2 w; w.x = cvt_pk_bf16(OA[dt][0], OA[dt][1]); w.y = cvt_pk_bf16(OA[dt][2], OA[dt][3]); *(u32x2*)(op + dt * 16) = w; } }
        __builtin_amdgcn_wave_barrier(); asm volatile("s_waitcnt lgkmcnt(0)" ::: "memory");
    }
}

__global__ void __launch_bounds__(NWAVES * 64, 2) fwd_megakernel(Args args) {
    extern __shared__ __attribute__((aligned(16))) unsigned char lds_raw[];
    __builtin_assume(__builtin_amdgcn_workitem_id_y() == 0); __builtin_assume(__builtin_amdgcn_workitem_id_z() == 0);
    cg::grid_group grid = cg::this_grid();
    Ctx C; C.lds = (LAS unsigned char*)lds_raw; C.tid = threadIdx.x; C.lane = C.tid & 63; C.wave = __builtin_amdgcn_readfirstlane(C.tid >> 6);
    const int G = args.G, bx = blockIdx.x;
    C.gw = bx * NWAVES + C.wave; C.NGW = G * NWAVES; C.gtid = bx * (NWAVES * 64) + C.tid; C.NT = G * NWAVES * 64;
    unsigned char* ws = args.ws;
#define x_in (args.in[0])
#define pin (args.in[1])
#define w_in (args.in[2])
#define conv_w (args.in[3])
#define pe_k (args.in[4])
#define w1_k (args.in[5])
#define w2_k (args.in[6])
#define pe_v (args.in[7])
#define w1_v (args.in[8])
#define w2_v (args.in[9])
#define w_conv_out (args.in[10])
#define w_attn_out (args.in[11])
#define w_mix_out (args.in[12])
#define ln1_g (args.in[13])
#define ln1_b (args.in[14])
#define w_up (args.in[15])
#define w_down (args.in[16])
#define w_ple (args.in[17])
#define w_ple_gate (args.in[18])
#define ln2_g (args.in[19])
#define ln2_b (args.in[20])
#define rel_bias (args.in[21])
#define BP(off) ((bf16_t*)(ws + (off)))
#define FP(off) ((float*)(ws + (off)))
#define XB BP(WS_XB)
#define WTIN BP(WS_WTIN)
#define WTVT BP(WS_WTVT)
#define WTMB BP(WS_WTMB)
#define W1K BP(WS_W1K)
#define W1V BP(WS_W1V)
#define BIASK FP(WS_BIASK)
#define BIASV FP(WS_BIASV)
#define HIDK BP(WS_HIDK)
#define HIDV BP(WS_HIDV)
#define KC BP(WS_KC)
#define VCT BP(WS_VCT)
#define GATES FP(WS_GATES)
#define BG BP(WS_BG)
#define ZZ BP(WS_ZZ)
#define Q BP(WS_Q)
#define KCS BP(WS_KCS)
#define VCS BP(WS_VCS)
#define KS BP(WS_KS)
#define KW BP(WS_KW)
#define VST BP(WS_VST)
#define VWT BP(WS_VWT)
#define SMA BP(WS_SMA)
#define SMB BP(WS_SMB)
#define WTCONV BP(WS_WTCONV)
#define WTATTN BP(WS_WTATTN)
#define WTMIX BP(WS_WTMIX)
#define WTGATE BP(WS_WTGATE)
#define WTPLE BP(WS_WTPLE)
#define PB BP(WS_PB)
#define WTUP BP(WS_WTUP)
#define WTDOWN BP(WS_WTDOWN)
#define PRE1 FP(WS_PRE1)
#define PRE2 FP(WS_PRE2)
#define X1B BP(WS_X1B)
#define H1 BP(WS_H1)
    const int lo = args.ph_lo, hi = args.ph_hi;
    unsigned* gbar = (unsigned*)(ws + 16384); int nbar = 0;
    if (lo == 12345) grid.sync();
#ifndef PHMASK
#define PHMASK 0xFFFF
#endif
#define IN(k) (((PHMASK >> (k)) & 1) && lo <= (k) && (k) < hi)
#define SEAM(k) do { if (IN(k) && IN((k) + 1)) { ++nbar; \
        asm volatile("s_waitcnt vmcnt(0) lgkmcnt(0)" ::: "memory"); __syncthreads(); \
        if (C.tid == 0) { __builtin_amdgcn_fence(__ATOMIC_RELEASE, "agent"); asm volatile("s_waitcnt vmcnt(0)" ::: "memory"); \
            __hip_atomic_fetch_add(gbar, 1u, __ATOMIC_RELAXED, __HIP_MEMORY_SCOPE_AGENT); \
            while (__hip_atomic_load(gbar, __ATOMIC_RELAXED, __HIP_MEMORY_SCOPE_AGENT) < (unsigned)(nbar * G)) __builtin_amdgcn_s_sleep(2); \
            __builtin_amdgcn_fence(__ATOMIC_ACQUIRE, "agent"); asm volatile("s_waitcnt vmcnt(0)" ::: "memory"); } \
        __syncthreads(); \
        __builtin_amdgcn_fence(__ATOMIC_ACQUIRE, "agent"); asm volatile("s_waitcnt vmcnt(0)" ::: "memory"); } } while (0)

    if (IN(0)) {
        cvt_job(C, x_in, XB, (size_t)T * D / 8);
        tr_job(C, w_in, D, NIN, 2048, 2048, WTIN, D, 0, 128, 256);
        tr_job(C, w_in, D, NIN, 4096, 2048, WTIN, D, 128, 128, 256);
        tr_job(C, w_in, D, NIN, 0, 2048, WTIN, D, 4096, 2048, 0);
        tr_job(C, w_in, D, NIN, 6144, 2048, WTIN, D, 6144, 2048, 0);
        tr_job(C, w_in, D, NIN, 8192, 512, WTIN, D, 8192, 512, 0);
        tr_job(C, w_in, D, NIN, 8704, 512, WTIN, D, 8704, 512, 0);
        tr_job(C, w_in, D, NIN, 9216, 512, WTIN, D, 9216, 512, 0);
        tr_job(C, w_in, D, NIN, 10240, 512, WTIN, D, 9728, 512, 0);
        tr_job(C, w_in, D, NIN, 11312, 2048, WTIN, D, 10240, 2048, 0);
        tr_job(C, w_in, D, NIN, 9728, 512, WTVT, D, 0, 512, 0);
        tr_job(C, w_in, D, NIN, 10752, 512, WTVT, D, 512, 512, 0);
        tr_job(C, w_in, D, NIN, 13360, 2048, WTMB, D, 0, 2048, 0);
        tr_job(C, w1_k, 4096, 256, 0, 256, W1K, 4096, 0, 256, 0);
        tr_job(C, w1_v, 4096, 256, 0, 256, W1V, 4096, 0, 256, 0);
        for (int i = C.gtid; i < 256 * D; i += C.NT) { const int r = i / D, k = i % D; const float v = (r < 48) ? w_in[(size_t)k * NIN + 11264 + r] : 0.f; WTIN[(size_t)(12288 + r) * D + k] = (bf16_t)(cvt_pk_bf16(v, 0.f) & 0xffff); }
        if (bx == G - 1) {
            const int n = C.tid & 255; const float* pe = (C.tid < 256) ? pe_k : pe_v; const float* w1 = (C.tid < 256) ? w1_k : w1_v; float s = 0.f;
            for (int j = 0; j < 4096; ++j) s += pe[j] * w1[(size_t)j * 256 + n];
            ((C.tid < 256) ? BIASK : BIASV)[n] = s;
        }
        asm volatile("s_waitcnt vmcnt(0) lgkmcnt(0)" ::: "memory"); __syncthreads();
    }
    SEAM(0);
    if (IN(1)) {
        { pg8::Gemm g{XB, WTIN, T, 12544, D, D, D}; pg8::StaticOrder S; S.init(T, 12544, G, bx);
          EpiInProj E{ZZ, BG, Q, KCS, SMA, GATES, ws + 492 * MiB};
          pg8::gemm_phase(C.lds, g, S, E); }
        { pg8::Gemm g{WTVT, XB, 1024, T, D, D, D}; pg8::StaticOrder S; S.init(1024, T, G, (bx + 64) % G);
          pg8::EpiGen<FStoreVT> E{{VST, ws + 500 * MiB}};
          pg8::gemm_phase(C.lds, g, S, E); }
    }
    SEAM(1);
    if (IN(2)) {
        if (bx < 32) {
            { pg8::Gemm g{KCS, W1K, 4096, 256, 4096, 2048, 4096}; pg8::StaticOrder S; S.init(4096, 256, G, bx < 16 ? bx : -1); S.G = 16;
              pg8::EpiGen<FGeluBias> E{{HIDK, 256, BIASK}}; pg8::gemm_phase(C.lds, g, S, E); }
            { pg8::Gemm g{VCS, W1V, 4096, 256, 4096, 2048, 4096}; pg8::StaticOrder S; S.init(4096, 256, G, (bx >= 16 && bx < 32) ? bx - 16 : -1); S.G = 16;
              pg8::EpiGen<FGeluBias> E{{HIDV, 256, BIASV}}; pg8::gemm_phase(C.lds, g, S, E); }
        } else
        for (size_t i = (size_t)(bx - 32) * (NWAVES * 64) + C.tid; i < (size_t)T * D / 8; i += (size_t)(G - 32) * (NWAVES * 64)) {
            const int t = (int)(i / (D / 8)), c8 = (int)(i % (D / 8)) * 8;
            f32x4 z0a, z0b, z1a = {0.f, 0.f, 0.f, 0.f}, z1b = z1a, z2a = z1a, z2b = z1a, ba, bb;
            unpack8(*(const u32x4*)(ZZ + (size_t)t * D + c8), z0a, z0b);
            if (t >= 1) unpack8(*(const u32x4*)(ZZ + (size_t)(t - 1) * D + c8), z1a, z1b);
            if (t >= 2) unpack8(*(const u32x4*)(ZZ + (size_t)(t - 2) * D + c8), z2a, z2b);
            unpack8(*(const u32x4*)(BG + (size_t)t * D + c8), ba, bb);
            const f32x4 w0a = *(const f32x4*)(conv_w + c8), w0b = *(const f32x4*)(conv_w + c8 + 4);
            const f32x4 w1a = *(const f32x4*)(conv_w + D + c8), w1b = *(const f32x4*)(conv_w + D + c8 + 4);
            const f32x4 w2a = *(const f32x4*)(conv_w + 2 * D + c8), w2b = *(const f32x4*)(conv_w + 2 * D + c8 + 4);
            const f32x4 ua = ba * (w0a * z2a + w1a * z1a + w2a * z0a), ub = bb * (w0b * z2b + w1b * z1b + w2b * z0b);
            *(u32x4*)(BG + (size_t)t * D + c8) = pack8(ua, ub);
        }
    }
    SEAM(2);
    if (IN(3)) {
        { pg8::Gemm g{XB, WTMB, T, D, D, D, D}; pg8::StaticOrder S; S.init(T, D, G, bx);
          pg8::EpiGen<FStoreBf16> E{{SMB, D, 1}}; pg8::gemm_phase(C.lds, g, S, E); }
    }
    SEAM(3);
    if (IN(4)) {
        for (int i = C.gtid; i < 4096 * HD; i += C.NT) {
            const int d = i & 127, row = i >> 7; const bf16_t* hp = HIDK + (size_t)row * 256; float s = 0.f;
            for (int j = 0; j < 256; j += 2) { const unsigned w = *(const unsigned*)(hp + j); s += bf_lo(w) * w2_k[(size_t)j * HD + d] + bf_hi(w) * w2_k[(size_t)(j + 1) * HD + d]; }
            { const int h = row >> 10, c = row & 1023; KC[(size_t)h * 131072 + ((size_t)(c >> 5) << 12) + ((c >> 2) & 1) * 2048 + (d >> 5) * 512 + (4 * ((c & 31) >> 3) + (c & 3)) * 32 + (d & 31)] = (bf16_t)(cvt_pk_bf16(s, 0.f) & 0xffff); }
        }
        for (int i = C.gtid; i < 4096 * HD; i += C.NT) {
            const int ii = i & 1023, d = (i >> 10) & 127, h = i >> 17; const bf16_t* hp = HIDV + (size_t)(h * 1024 + ii) * 256; float s = 0.f;
            for (int j = 0; j < 256; j += 2) { const unsigned w = *(const unsigned*)(hp + j); s += bf_lo(w) * w2_v[(size_t)j * HD + d] + bf_hi(w) * w2_v[(size_t)(j + 1) * HD + d]; }
            VCT[(size_t)h * 131072 + ((size_t)(ii >> 5) << 12) + (d >> 4) * 512 + (d & 15) * 32 + (ii & 31)] = (bf16_t)(cvt_pk_bf16(s, 0.f) & 0xffff);
        }
        tr_job(C, w_conv_out, D, D, 0, D, WTCONV, D, 0, D, 0);
        tr_job(C, w_attn_out, D, D, 0, D, WTATTN, D, 0, D, 0);
        tr_job(C, w_mix_out, D, D, 0, D, WTMIX, D, 0, D, 0);
        tr_job(C, w_ple_gate, D, D, 0, D, WTGATE, D, 0, D, 0);
        tr_job(C, w_ple, PLE, D, 0, D, WTPLE, PLE, 0, D, 0);
        tr_job(C, w_up, D, FF, 0, FF, WTUP, D, 0, FF, 0);
        tr_job(C, w_down, FF, D, 0, D, WTDOWN, FF, 0, D, 0);
        cvt_job(C, pin, PB, (size_t)T * PLE / 8);
        asm volatile("s_waitcnt vmcnt(0) lgkmcnt(0)" ::: "memory"); __syncthreads();
    }
    SEAM(4);
    if (IN(5)) {
        attention_phase(C, Q, KC, VCT, KS, VST, KW, VWT, GATES, rel_bias, ws + 492 * MiB, ws + 500 * MiB);
        asm volatile("s_waitcnt vmcnt(0) lgkmcnt(0)" ::: "memory"); __syncthreads();
    }
    SEAM(5);
    if (IN(6)) { pg8::Gemm g{BG, WTCONV, T, D, D, D, D}; pg8::StaticOrder S; S.init(T, D, G, bx); pg8::EpiGen<FMulInplace> E{{SMA, D}}; pg8::gemm_phase(C.lds, g, S, E); }
    SEAM(6);
    if (IN(7)) { pg8::Gemm g{Q, WTATTN, T, D, D, D, D}; pg8::StaticOrder S; S.init(T, D, G, bx); pg8::EpiGen<FMulAddInplace> E{{SMB, SMA, D}}; pg8::gemm_phase(C.lds, g, S, E); }
    SEAM(7);
    if (IN(8)) { pg8::Gemm g{SMB, WTMIX, T, D, D, D, D}; pg8::StaticOrder S; S.init(T, D, G, bx); pg8::EpiGen<FResidF32> E{{PRE1, x_in, D}}; pg8::gemm_phase(C.lds, g, S, E); }
    SEAM(8);
    if (IN(9)) ln_rows<true>(C, PRE1, ln1_g, ln1_b, X1B);
    SEAM(9);
    if (IN(10)) {
        { pg8::Gemm g{X1B, WTGATE, T, D, D, D, D}; pg8::StaticOrder S; S.init(T, D, G, bx); pg8::EpiGen<FSigmoidF32> E{{PRE2, D}}; pg8::gemm_phase(C.lds, g, S, E); }
        { pg8::Gemm g{X1B, WTUP, T / 2, FF, D, D, D}; pg8::StaticOrder S; S.init(T / 2, FF, G, bx); pg8::EpiGen<FStoreBf16> E{{H1, FF, 2}}; pg8::gemm_phase(C.lds, g, S, E); }
    }
    SEAM(10);
    if (IN(11)) { pg8::Gemm g{PB, WTPLE, T, D, PLE, PLE, PLE}; pg8::StaticOrder S; S.init(T, D, G, bx); pg8::EpiGen<FPle> E{{PRE2, X1B, D}}; pg8::gemm_phase(C.lds, g, S, E); }
    SEAM(11);
    if (IN(12)) { pg8::Gemm g{H1, WTDOWN, T / 2, D, FF, FF, FF}; pg8::StaticOrder S; S.init(T / 2, D, G, bx); pg8::EpiGen<FAccF32> E{{PRE2, D}}; pg8::gemm_phase(C.lds, g, S, E); }
    SEAM(12);
    if (IN(13)) { pg8::Gemm g{X1B + (size_t)(T / 2) * D, WTUP, T / 2, FF, D, D, D}; pg8::StaticOrder S; S.init(T / 2, FF, G, bx); pg8::EpiGen<FStoreBf16> E{{H1, FF, 2}}; pg8::gemm_phase(C.lds, g, S, E); }
    SEAM(13);
    if (IN(14)) { pg8::Gemm g{H1, WTDOWN, T / 2, D, FF, FF, FF}; pg8::StaticOrder S; S.init(T / 2, D, G, bx); pg8::EpiGen<FAccF32> E{{PRE2 + (size_t)(T / 2) * D, D}}; pg8::gemm_phase(C.lds, g, S, E); }
    SEAM(14);
    if (IN(15)) ln_rows<false>(C, PRE2, ln2_g, ln2_b, args.out);
#undef IN
#undef SEAM
}

extern "C" void kernel_launch(void* const* d_in, const int* in_sizes, int n_in, void* d_out, int out_size, void* d_ws, size_t ws_size, hipStream_t stream) {
    static int grid = 0;
    if (grid == 0) {
        if (n_in != 22 || ws_size < 508 * MiB) { fprintf(stderr, "kernel_launch: need 22 inputs and >= %zu bytes of workspace (got %d, %zu)\n", (size_t)WS_END, n_in, ws_size); grid = -1; return; }
        int dev = 0, cus = 0, per_cu = 0;
        hipGetDevice(&dev); hipDeviceGetAttribute(&cus, hipDeviceAttributeMultiprocessorCount, dev);
        if (hipFuncSetAttribute((const void*)fwd_megakernel, hipFuncAttributeMaxDynamicSharedMemorySize, LDS_BYTES) != hipSuccess) { fprintf(stderr, "kernel_launch: hipFuncSetAttribute failed\n"); grid = -1; return; }
        if (hipOccupancyMaxActiveBlocksPerMultiprocessor(&per_cu, (const void*)fwd_megakernel, NWAVES * 64, LDS_BYTES) != hipSuccess || per_cu < 1) { fprintf(stderr, "kernel_launch: occupancy query says %d\n", per_cu); per_cu = 1; }
        (void)hipGetLastError();
        grid = cus * 1;
    }
    if (grid < 0) return;
    Args a{};
    for (int i = 0; i < 22; ++i) a.in[i] = (const float*)d_in[i];
    a.out = (float*)d_out; a.ws = (unsigned char*)d_ws; a.G = grid; a.pad = 0;
#if MK_PER_PHASE
    for (int ph = 0; ph < 16; ++ph) { a.ph_lo = ph; a.ph_hi = ph + 1; void* kargs[] = {&a};
        hipError_t e = hipLaunchCooperativeKernel((const void*)fwd_megakernel, dim3(grid), dim3(NWAVES * 64), kargs, LDS_BYTES, stream);
        if (e != hipSuccess) { fprintf(stderr, "kernel_launch: launch failed: %s\n", hipGetErrorString(e)); break; } }
#else
    (void)hipMemsetAsync((char*)d_ws + 16384, 0, 256, stream);
    a.ph_lo = 0; a.ph_hi = 16; void* kargs[] = {&a};
    hipError_t e = hipLaunchCooperativeKernel((const void*)fwd_megakernel, dim3(grid), dim3(NWAVES * 64), kargs, LDS_BYTES, stream);
    if (e != hipSuccess) fprintf(stderr, "kernel_launch: cooperative launch failed: %s (grid %d)\n", hipGetErrorString(e), grid);
#endif
}
```

```cpp
#include <hip/hip_runtime.h>
#include <hip/hip_cooperative_groups.h>
#include <cstdio>
#include <cstdint>
namespace cg = cooperative_groups;

#define LAS __attribute__((address_space(3)))
typedef unsigned short bf16_t;
typedef short bf16x8 __attribute__((ext_vector_type(8)));
typedef float f32x4 __attribute__((ext_vector_type(4)));
typedef float f32x2 __attribute__((ext_vector_type(2)));
typedef unsigned u32x4 __attribute__((ext_vector_type(4)));
typedef unsigned u32x2 __attribute__((ext_vector_type(2)));

#ifndef MK_PER_PHASE
#define MK_PER_PHASE 0
#endif

constexpr int T = 16384, D = 2048, NIN = 15408, FF = 8192, PLE = 256, HK = 4, HD = 128, NCMP = 1024;
constexpr float DN_ALPHA = 1.189207115002721f;
constexpr float LN_EPS = 1e-5f;
constexpr int NWAVES = 8;
constexpr int LDS_BYTES = 147456;

constexpr size_t MiB = 1u << 20;
constexpr size_t WS_BIASK = 0, WS_BIASV = 4096;
constexpr size_t WS_XB = 1 * MiB;
constexpr size_t WS_WTUP = 1 * MiB, WS_WTDOWN = 33 * MiB;
constexpr size_t WS_WTIN = 65 * MiB;
constexpr size_t WS_WTVT = 114 * MiB;
constexpr size_t WS_WTMB = 118 * MiB;
constexpr size_t WS_WTCONV = 65 * MiB, WS_WTATTN = 73 * MiB, WS_WTMIX = 81 * MiB, WS_WTGATE = 89 * MiB, WS_WTPLE = 97 * MiB, WS_PB = 98 * MiB;
constexpr size_t WS_W1K = 126 * MiB, WS_W1V = 128 * MiB;
constexpr size_t WS_HIDK = 130 * MiB, WS_HIDV = 132 * MiB;
constexpr size_t WS_KC = 134 * MiB, WS_VCT = 135 * MiB;
constexpr size_t WS_GATES = 136 * MiB;
constexpr size_t WS_BG = 140 * MiB;
constexpr size_t WS_X1B = 140 * MiB;
constexpr size_t WS_ZZ = 204 * MiB;
constexpr size_t WS_SMB = 204 * MiB, WS_H1 = 204 * MiB;
constexpr size_t WS_Q = 268 * MiB;
constexpr size_t WS_KCS = 332 * MiB, WS_VCS = 348 * MiB, WS_KS = 364 * MiB, WS_KW = 380 * MiB, WS_VST = 396 * MiB, WS_VWT = 412 * MiB;
constexpr size_t WS_SMA = 428 * MiB;
constexpr size_t WS_PRE1 = 300 * MiB, WS_PRE2 = 364 * MiB;
constexpr size_t WS_END = 492 * MiB;

typedef __bf16 bf16x2_t __attribute__((ext_vector_type(2)));
__device__ __forceinline__ unsigned cvt_pk_bf16(float lo, float hi) { f32x2 v = {lo, hi}; bf16x2_t b = __builtin_convertvector(v, bf16x2_t); return __builtin_bit_cast(unsigned, b); }
__device__ __forceinline__ float bf_lo(unsigned w) { return __uint_as_float(w << 16); }
__device__ __forceinline__ float bf_hi(unsigned w) { return __uint_as_float(w & 0xffff0000u); }
__device__ __forceinline__ float fast_sigmoid(float x) { return __builtin_amdgcn_rcpf(1.f + __expf(-x)); }
__device__ __forceinline__ u32x4 pack8(const f32x4& a, const f32x4& b) { u32x4 w; w.x = cvt_pk_bf16(a[0], a[1]); w.y = cvt_pk_bf16(a[2], a[3]); w.z = cvt_pk_bf16(b[0], b[1]); w.w = cvt_pk_bf16(b[2], b[3]); return w; }
__device__ __forceinline__ void unpack8(const u32x4& w, f32x4& a, f32x4& b) { a[0] = bf_lo(w.x); a[1] = bf_hi(w.x); a[2] = bf_lo(w.y); a[3] = bf_hi(w.y); b[0] = bf_lo(w.z); b[1] = bf_hi(w.z); b[2] = bf_lo(w.w); b[3] = bf_hi(w.w); }

__device__ __forceinline__ long pack8_fp8(float a0, float a1, float a2, float a3, float a4, float a5, float a6, float a7) {
    int lo = __builtin_amdgcn_cvt_pk_fp8_f32(a0, a1, 0, false); lo = __builtin_amdgcn_cvt_pk_fp8_f32(a2, a3, lo, true);
    int hi = __builtin_amdgcn_cvt_pk_fp8_f32(a4, a5, 0, false); hi = __builtin_amdgcn_cvt_pk_fp8_f32(a6, a7, hi, true);
    return (long)(((unsigned long long)(unsigned)hi << 32) | (unsigned long long)(unsigned)lo);
}

namespace pg8 {
constexpr int BM = 256, BK = 64, HALF = 128, HTB = HALF * BK * 2, STAGE_BYTES = 8 * HTB, NXCD = 8, WGM = 8;
__host__ __device__ __forceinline__ int lds_byte(int r, int c) { const int st = (r >> 4) * 2 + (c >> 5), rr = r & 15, cc = c & 31, ob = rr * 64 + cc * 2; return st * 1024 + (ob ^ (((ob >> 9) & 1) << 5)); }
__host__ __device__ __forceinline__ void stage_rc(int b, int& R, int& C) { const int st = b / 1024, sb = b % 1024, swz = sb ^ (((sb >> 9) & 1) << 5); R = (st >> 1) * 16 + swz / 64; C = (st & 1) * 32 + (swz % 64) / 2; }
__host__ __device__ __forceinline__ int perm32(int rho) { const int n = rho >> 4, i = rho & 15; return 8 * (i >> 2) + 4 * n + (i & 3); }

struct Unit { int pm, pn; };
struct Gemm { const bf16_t* A; const bf16_t* Bt; int M, N, K, lda, ldb; };

struct StaticOrder {
    int nM, nN, nwg, G, c;
    __device__ void init(int M, int N, int G_, int c_) { nM = M / BM; nN = N / BM; nwg = nM * nN; G = G_; c = c_; }
    __device__ bool next(int i, Unit& u) const {
        const long L = (long)i * G + c; if (c < 0 || L >= nwg) return false;
        int wgid = (int)L; { const int q = nwg / NXCD, r = nwg % NXCD, xcd = wgid % NXCD, off = wgid / NXCD; wgid = (xcd < r ? xcd * (q + 1) : r * (q + 1) + (xcd - r) * q) + off; }
        const int nig = WGM * nN, gid = wgid / nig, fm = gid * WGM, gsz = (nM - fm) < WGM ? (nM - fm) : WGM;
        u.pm = fm + ((wgid % nig) % gsz); u.pn = (wgid % nig) / gsz; return true;
    }
};

template <class F> struct EpiGen {
    F f;
    __device__ __forceinline__ void operator()(const f32x4 (&acc)[2][2][4][2], const Unit& u, int wr, int wc, int fr, int fq) const {
        const int row0 = u.pm * BM + wr * 64 + fr, col0 = u.pn * BM + wc * 32 + 8 * fq;
#pragma unroll
        for (int ai = 0; ai < 2; ++ai)
#pragma unroll
            for (int m = 0; m < 4; ++m) {
                const int row = row0 + ai * HALF + m * 16;
#pragma unroll
                for (int bj = 0; bj < 2; ++bj) f(row, col0 + bj * HALF, acc[ai][bj][m][0], acc[ai][bj][m][1]);
            }
    }
};

template <class Epi, class Sched>
__device__ __forceinline__ void gemm_phase(LAS unsigned char* lds, const Gemm g, const Sched& S, const Epi& E) {
    const int tid = threadIdx.x, wid = __builtin_amdgcn_readfirstlane(tid >> 6), lane = tid & 63, wr = wid >> 2, wc = wid & 3, fr = lane & 15, fq = lane >> 4;
    const int K = g.K, nt = K / BK;
    unsigned voffA[2], voffB[2];
#pragma unroll
    for (int i = 0; i < 2; ++i) { int R, C; stage_rc(tid * 16 + i * 8192, R, C); const int Rb = (R & ~31) + perm32(R & 31);
        voffA[i] = (unsigned)(R * g.lda + C) * 2u; voffB[i] = (unsigned)(Rb * g.ldb + C) * 2u; }
    const size_t kstep = (size_t)(BK * 2);
    const size_t hstepA = (size_t)HALF * g.lda * 2, hstepB = (size_t)HALF * g.ldb * 2;
    const size_t tstepA = 2 * hstepA, tstepB = 2 * hstepB;
    const unsigned ldsw = (unsigned)wid * 1024u;
    const int aoff = lds_byte(wr * 64 + fr, fq * 8), boff = lds_byte(wc * 32 + fr, fq * 8);
#define PG8_SA(b, h) (((b) * 2 + (h)) * HTB)
#define PG8_SB(b, h) ((4 + (b) * 2 + (h)) * HTB)
#define PG8_STAGE(bufoff, gbase, voff) do { _Pragma("unroll") for (int _i = 0; _i < 2; ++_i) \
        __builtin_amdgcn_global_load_lds((const unsigned*)((const char*)(gbase) + (voff)[_i]), (LAS unsigned*)(lds + (bufoff) + ldsw + _i * 8192), 16, 0, 0); } while (0)
#define PG8_LDA(dst, b, h) do { _Pragma("unroll") for (int m = 0; m < 4; ++m) _Pragma("unroll") for (int k = 0; k < 2; ++k) dst[m][k] = *(const LAS bf16x8*)(lds + PG8_SA(b, h) + aoff + m * 2048 + k * 1024); } while (0)
#define PG8_LDB(dst, b, h) do { _Pragma("unroll") for (int n = 0; n < 2; ++n) _Pragma("unroll") for (int k = 0; k < 2; ++k) dst[n][k] = *(const LAS bf16x8*)(lds + PG8_SB(b, h) + boff + n * 2048 + k * 1024); } while (0)
#define PG8_MMA(ai, bj, At, Bt) do { __builtin_amdgcn_s_setprio(1); _Pragma("unroll") for (int m = 0; m < 4; ++m) _Pragma("unroll") for (int n = 0; n < 2; ++n) _Pragma("unroll") for (int k = 0; k < 2; ++k) \
        acc[ai][bj][m][n] = __builtin_amdgcn_mfma_f32_16x16x32_bf16(Bt[n][k], At[m][k], acc[ai][bj][m][n], 0, 0, 0); __builtin_amdgcn_s_setprio(0); } while (0)
#define PG8_WAIT_V(n) asm volatile("s_waitcnt vmcnt(" #n ")" ::: "memory")
#define PG8_WAIT_L(n) asm volatile("s_waitcnt lgkmcnt(" #n ")" ::: "memory")
#define PG8_BAR __builtin_amdgcn_s_barrier()
#define PG8_SCHED __builtin_amdgcn_sched_barrier(0)
    Unit cur, nxt; int ui = 0;
    if (!S.next(0, cur)) return;
    f32x4 acc[2][2][4][2];
#pragma unroll
    for (int a = 0; a < 2; ++a)
#pragma unroll
        for (int b = 0; b < 2; ++b)
#pragma unroll
            for (int m = 0; m < 4; ++m)
#pragma unroll
                for (int n = 0; n < 2; ++n) acc[a][b][m][n] = (f32x4){0.f, 0.f, 0.f, 0.f};
    bf16x8 At[4][2], B0[2][2], B1[2][2];
    const char* cA = (const char*)g.A + (size_t)cur.pm * tstepA; const char* cB = (const char*)g.Bt + (size_t)cur.pn * tstepB;
    PG8_STAGE(PG8_SB(0, 0), cB, voffB); PG8_STAGE(PG8_SB(0, 1), cB + hstepB, voffB); PG8_STAGE(PG8_SA(0, 0), cA, voffA); PG8_STAGE(PG8_SA(0, 1), cA + hstepA, voffA);
    if (wr == 1) PG8_BAR;
    PG8_WAIT_V(2); PG8_BAR;
    PG8_STAGE(PG8_SB(1, 0), cB + kstep, voffB); PG8_STAGE(PG8_SA(1, 0), cA + kstep, voffA); PG8_STAGE(PG8_SB(1, 1), cB + hstepB + kstep, voffB);
    PG8_WAIT_V(6); PG8_BAR;
    for (;;) {
        const bool has_next = S.next(ui + 1, nxt);
        const char* nA = has_next ? (const char*)g.A + (size_t)nxt.pm * tstepA : cA; const char* nB = has_next ? (const char*)g.Bt + (size_t)nxt.pn * tstepB : cB;
        for (int t = 0; t < nt; t += 2) {
            const bool last = (t == nt - 2);
            const char* a1 = cA + (size_t)(t + 1) * kstep;
            const char* a2 = last ? nA : cA + (size_t)(t + 2) * kstep; const char* b2 = last ? nB : cB + (size_t)(t + 2) * kstep;
            const char* a3 = a2 + kstep; const char* b3 = b2 + kstep;
            PG8_LDB(B0, 0, 0); PG8_LDB(B1, 0, 1); PG8_SCHED; PG8_LDA(At, 0, 0); PG8_STAGE(PG8_SA(1, 1), a1 + hstepA, voffA);
            PG8_WAIT_V(8); PG8_WAIT_L(0); PG8_BAR; PG8_MMA(0, 0, At, B0); PG8_MMA(0, 1, At, B1); PG8_BAR; PG8_SCHED;
            PG8_LDA(At, 0, 1); PG8_STAGE(PG8_SB(0, 0), b2, voffB); PG8_STAGE(PG8_SB(0, 1), b2 + hstepB, voffB); PG8_STAGE(PG8_SA(0, 0), a2, voffA);
            PG8_WAIT_V(8); PG8_WAIT_L(0); PG8_BAR; PG8_MMA(1, 0, At, B0); PG8_MMA(1, 1, At, B1); PG8_BAR; PG8_SCHED;
            PG8_LDB(B0, 1, 0); PG8_LDB(B1, 1, 1); PG8_SCHED; PG8_LDA(At, 1, 0); PG8_STAGE(PG8_SA(0, 1), a2 + hstepA, voffA);
            PG8_WAIT_V(8); PG8_WAIT_L(0); PG8_BAR; PG8_MMA(0, 0, At, B0); PG8_MMA(0, 1, At, B1); PG8_BAR; PG8_SCHED;
            PG8_LDA(At, 1, 1); PG8_STAGE(PG8_SB(1, 0), b3, voffB); PG8_STAGE(PG8_SB(1, 1), b3 + hstepB, voffB); PG8_STAGE(PG8_SA(1, 0), a3, voffA);
            PG8_WAIT_V(8); PG8_WAIT_L(0); PG8_BAR; PG8_MMA(1, 0, At, B0); PG8_MMA(1, 1, At, B1); PG8_BAR; PG8_SCHED;
        }
        if (wr == 0) PG8_BAR;
        E(acc, cur, wr, wc, fr, fq);
        if (!has_next) break;
#pragma unroll
        for (int a = 0; a < 2; ++a)
#pragma unroll
            for (int b = 0; b < 2; ++b)
#pragma unroll
                for (int m = 0; m < 4; ++m)
#pragma unroll
                    for (int n = 0; n < 2; ++n) acc[a][b][m][n] = (f32x4){0.f, 0.f, 0.f, 0.f};
        cur = nxt; cA = nA; cB = nB; ++ui;
        if (wr == 1) PG8_BAR;
    }
    PG8_WAIT_V(0);
    PG8_BAR;
#undef PG8_SA
#undef PG8_SB
#undef PG8_STAGE
#undef PG8_LDA
#undef PG8_LDB
#undef PG8_MMA
#undef PG8_WAIT_V
#undef PG8_WAIT_L
#undef PG8_BAR
#undef PG8_SCHED
}
}

struct FStoreBf16 {
    bf16_t* O; int ldc; int act;
    __device__ __forceinline__ void operator()(int row, int col, f32x4 a, f32x4 b) const {
        if (act == 1) { for (int i = 0; i < 4; ++i) { a[i] = fast_sigmoid(a[i]); b[i] = fast_sigmoid(b[i]); } }
        else if (act == 2) { for (int i = 0; i < 4; ++i) { float x = fmaxf(a[i], 0.f), y = fmaxf(b[i], 0.f); a[i] = x * x; b[i] = y * y; } }
        *(u32x4*)(O + (size_t)row * ldc + col) = pack8(a, b);
    }
};
struct FStoreVT {
    bf16_t* O; unsigned char* O8;
    __device__ __forceinline__ void operator()(int row, int col, f32x4 a, f32x4 b) const {
        if (row < 512) { const int hk = row >> 7, d = row & 127; *(long*)(O8 + (size_t)hk * ((size_t)T * 128) + ((size_t)(col >> 5) << 12) + (d >> 4) * 512 + (d & 15) * 32 + (col & 31)) = pack8_fp8(a[0], a[1], a[2], a[3], b[0], b[1], b[2], b[3]); *(u32x4*)(O + (size_t)hk * ((size_t)T * 128) + ((size_t)(col >> 5) << 12) + (d >> 4) * 512 + (d & 15) * 32 + (col & 31)) = pack8(a, b); }
        else { const int hk = (row - 512) >> 7, d = row & 127; *(u32x4*)(O + (size_t)512 * T + (size_t)hk * ((size_t)T * 128) + ((size_t)(col >> 5) << 12) + (d >> 4) * 512 + (d & 15) * 32 + (col & 31)) = pack8(a, b); }
    }
};
struct FGeluBias {
    bf16_t* O; int ldc; const float* bias;
    __device__ __forceinline__ void operator()(int row, int col, f32x4 a, f32x4 b) const {
        const f32x4 b0 = *(const f32x4*)(bias + col), b1 = *(const f32x4*)(bias + col + 4);
        a = a + b0; b = b + b1;
        for (int i = 0; i < 4; ++i) {
            float x = a[i]; a[i] = x * __builtin_amdgcn_rcpf(1.f + __expf(-1.5957691216057308f * (x + 0.044715f * x * x * x)));
            float y = b[i]; b[i] = y * __builtin_amdgcn_rcpf(1.f + __expf(-1.5957691216057308f * (y + 0.044715f * y * y * y)));
        }
        *(u32x4*)(O + (size_t)row * ldc + col) = pack8(a, b);
    }
};
struct FMulInplace {
    bf16_t* O; int ldc;
    __device__ __forceinline__ void operator()(int row, int col, f32x4 a, f32x4 b) const {
        bf16_t* p = O + (size_t)row * ldc + col; f32x4 g0, g1; unpack8(*(const u32x4*)p, g0, g1);
        *(u32x4*)p = pack8(a * g0, b * g1);
    }
};
struct FMulAddInplace {
    bf16_t* O; const bf16_t* Y; int ldc;
    __device__ __forceinline__ void operator()(int row, int col, f32x4 a, f32x4 b) const {
        bf16_t* p = O + (size_t)row * ldc + col; f32x4 g0, g1, y0, y1; unpack8(*(const u32x4*)p, g0, g1); unpack8(*(const u32x4*)(Y + (size_t)row * ldc + col), y0, y1);
        *(u32x4*)p = pack8(a * g0 + y0, b * g1 + y1);
    }
};
struct FResidF32 {
    float* P; const float* X; int ldc;
    __device__ __forceinline__ void operator()(int row, int col, f32x4 a, f32x4 b) const {
        const size_t o = (size_t)row * ldc + col;
        const f32x4 x0 = *(const f32x4*)(X + o), x1 = *(const f32x4*)(X + o + 4);
        *(f32x4*)(P + o) = x0 * DN_ALPHA + a; *(f32x4*)(P + o + 4) = x1 * DN_ALPHA + b;
    }
};
struct FSigmoidF32 {
    float* P; int ldc;
    __device__ __forceinline__ void operator()(int row, int col, f32x4 a, f32x4 b) const {
        for (int i = 0; i < 4; ++i) { a[i] = fast_sigmoid(a[i]); b[i] = fast_sigmoid(b[i]); }
        const size_t o = (size_t)row * ldc + col; *(f32x4*)(P + o) = a; *(f32x4*)(P + o + 4) = b;
    }
};
struct FPle {
    float* P; const bf16_t* X; int ldc;
    __device__ __forceinline__ void operator()(int row, int col, f32x4 a, f32x4 b) const {
        const size_t o = (size_t)row * ldc + col; f32x4 x0, x1; unpack8(*(const u32x4*)(X + o), x0, x1);
        const f32x4 p0 = *(const f32x4*)(P + o), p1 = *(const f32x4*)(P + o + 4);
        *(f32x4*)(P + o) = a * p0 + x0 * DN_ALPHA; *(f32x4*)(P + o + 4) = b * p1 + x1 * DN_ALPHA;
    }
};
struct FAccF32 {
    float* P; int ldc;
    __device__ __forceinline__ void operator()(int row, int col, f32x4 a, f32x4 b) const {
        const size_t o = (size_t)row * ldc + col;
        *(f32x4*)(P + o) = *(const f32x4*)(P + o) + a; *(f32x4*)(P + o + 4) = *(const f32x4*)(P + o + 4) + b;
    }
};
struct EpiInProj {
    bf16_t *zz, *bg, *q, *kv, *sma; float* gates; unsigned char* ks8;
    __device__ __forceinline__ void operator()(const f32x4 (&acc)[2][2][4][2], const pg8::Unit& u, int wr, int wc, int fr, int fq) const {
        const int row0 = u.pm * 256 + wr * 64 + fr, cw = wc * 32 + 8 * fq; const int pn = u.pn;
        if (pn < 16) {
#pragma unroll
            for (int ai = 0; ai < 2; ++ai)
#pragma unroll
                for (int m = 0; m < 4; ++m) { const int row = row0 + ai * 128 + m * 16;
                    *(u32x4*)(zz + (size_t)row * D + pn * 128 + cw) = pack8(acc[ai][0][m][0] * acc[ai][1][m][0], acc[ai][0][m][1] * acc[ai][1][m][1]); }
        } else if (pn < 32) {
            bf16_t* O = (pn < 24) ? bg : q; const int c0 = ((pn - 16) & 7) * 256 + cw;
#pragma unroll
            for (int ai = 0; ai < 2; ++ai)
#pragma unroll
                for (int m = 0; m < 4; ++m) { const int row = row0 + ai * 128 + m * 16;
#pragma unroll
                    for (int bj = 0; bj < 2; ++bj) *(u32x4*)(O + (size_t)row * D + c0 + bj * 128) = pack8(acc[ai][bj][m][0], acc[ai][bj][m][1]); }
        } else if (pn < 40) {
            const int c0 = (pn - 32) * 256; const int b = c0 >> 9, h0 = (c0 & 511) >> 7;
            bf16_t* O = kv + (size_t)b * ((size_t)T * 512);
#pragma unroll
            for (int ai = 0; ai < 2; ++ai)
#pragma unroll
                for (int m = 0; m < 4; ++m) { const int row = row0 + ai * 128 + m * 16;
#pragma unroll
                    for (int bj = 0; bj < 2; ++bj) {
                        const size_t off = (b >= 2) ? (((size_t)(row >> 5) << 12) + ((row >> 2) & 1) * 2048 + (cw >> 5) * 512 + (4 * ((row & 31) >> 3) + (row & 3)) * 32 + (cw & 31))
                                                    : ((size_t)row * 128 + cw);
                        *(u32x4*)(O + (size_t)(h0 + bj) * ((size_t)T * 128) + off) = pack8(acc[ai][bj][m][0], acc[ai][bj][m][1]);
                        if (b == 2) { const f32x4 a = acc[ai][bj][m][0], c2 = acc[ai][bj][m][1]; *(long*)(ks8 + (size_t)(h0 + bj) * ((size_t)T * 128) + off) = pack8_fp8(a[0], a[1], a[2], a[3], c2[0], c2[1], c2[2], c2[3]); } } }
        } else if (pn < 48) {
            const int c0 = (pn - 40) * 256 + cw;
#pragma unroll
            for (int ai = 0; ai < 2; ++ai)
#pragma unroll
                for (int m = 0; m < 4; ++m) { const int row = row0 + ai * 128 + m * 16;
#pragma unroll
                    for (int bj = 0; bj < 2; ++bj) { f32x4 a = acc[ai][bj][m][0], b = acc[ai][bj][m][1];
                        for (int i = 0; i < 4; ++i) { a[i] = fast_sigmoid(a[i]); b[i] = fast_sigmoid(b[i]); }
                        *(u32x4*)(sma + (size_t)row * D + c0 + bj * 128) = pack8(a, b); } }
        } else {
            if (cw < 48) {
#pragma unroll
                for (int ai = 0; ai < 2; ++ai)
#pragma unroll
                    for (int m = 0; m < 4; ++m) { const int row = row0 + ai * 128 + m * 16; f32x4 a = acc[ai][0][m][0], b = acc[ai][0][m][1];
                        for (int i = 0; i < 4; ++i) { a[i] = fast_sigmoid(a[i]); b[i] = fast_sigmoid(b[i]); }
                        *(f32x4*)(gates + (size_t)row * 48 + cw) = a; *(f32x4*)(gates + (size_t)row * 48 + cw + 4) = b; }
            }
        }
    }
};

struct Args {
    const float* in[22]; float* out; unsigned char* ws; int ph_lo, ph_hi, G, pad;
};

struct Ctx { int tid, lane, wave, gw, NGW, gtid, NT; LAS unsigned char* lds; };

__device__ __forceinline__ void tr_item(const float* W, int ldw, int k0, int nsrc0, bf16_t* WT, int ldt, int drow0, LAS float* scr, int lane) {
#pragma unroll 8
    for (int i = 0; i < 32; ++i) { const int kk = 2 * i + (lane >> 5); scr[kk * 33 + (lane & 31)] = W[(size_t)(k0 + kk) * ldw + nsrc0 + (lane & 31)]; }
    asm volatile("s_waitcnt lgkmcnt(0)" ::: "memory");
    const int c = lane & 7;
#pragma unroll
    for (int j = 0; j < 4; ++j) { const int n = (lane >> 3) + 8 * j; const LAS float* s = scr + (8 * c) * 33 + n;
        u32x4 o; o.x = cvt_pk_bf16(s[0 * 33], s[1 * 33]); o.y = cvt_pk_bf16(s[2 * 33], s[3 * 33]); o.z = cvt_pk_bf16(s[4 * 33], s[5 * 33]); o.w = cvt_pk_bf16(s[6 * 33], s[7 * 33]);
        *(u32x4*)(WT + (size_t)(drow0 + n) * ldt + k0 + 8 * c) = o; }
    asm volatile("s_waitcnt lgkmcnt(0)" ::: "memory");
}
__device__ __forceinline__ void tr_job(const Ctx& C, const float* W, int K, int ldw, int ncol0, int ncols, bf16_t* WT, int ldt, int drow0, int grp, int grp_stride) {
    LAS float* scr = (LAS float*)(C.lds + C.wave * 16384);
    const int nblk = ncols / 32, items = (K / 64) * nblk;
    for (int it = C.gw; it < items; it += C.NGW) {
        const int kb = it / nblk, n = (it % nblk) * 32; const int drow = drow0 + (n / grp) * grp_stride + (n % grp);
        tr_item(W, ldw, kb * 64, ncol0 + n, WT, ldt, drow, scr, C.lane);
    }
}
__device__ __forceinline__ void cvt_job(const Ctx& C, const float* X, bf16_t* O, size_t n8) {
    for (size_t i = C.gtid; i < n8; i += C.NT) { const f32x4 a = *(const f32x4*)(X + i * 8), b = *(const f32x4*)(X + i * 8 + 4); *(u32x4*)(O + i * 8) = pack8(a, b); }
}

template <bool OUT_BF16>
__device__ __forceinline__ void ln_rows(const Ctx& C, const float* P, const float* gam, const float* bet, void* outp) {
    for (int r = C.gw; r < T; r += C.NGW) {
        const f32x4* xr = (const f32x4*)(P + (size_t)r * D) + C.lane;
        f32x4 v[8]; float s = 0.f;
#pragma unroll
        for (int j = 0; j < 8; ++j) { v[j] = xr[64 * j]; s += (v[j][0] + v[j][1]) + (v[j][2] + v[j][3]); }
#pragma unroll
        for (int o = 1; o < 64; o <<= 1) s += __shfl_xor(s, o);
        const float mean = s * (1.f / D); float s2 = 0.f;
#pragma unroll
        for (int j = 0; j < 8; ++j) { v[j] = v[j] - mean; s2 += (v[j][0] * v[j][0] + v[j][1] * v[j][1]) + (v[j][2] * v[j][2] + v[j][3] * v[j][3]); }
#pragma unroll
        for (int o = 1; o < 64; o <<= 1) s2 += __shfl_xor(s2, o);
        const float rstd = 1.f / sqrtf(s2 * (1.f / D) + LN_EPS);
#pragma unroll
        for (int j = 0; j < 8; ++j) {
            const f32x4 gg = *((const f32x4*)gam + C.lane + 64 * j), bb = *((const f32x4*)bet + C.lane + 64 * j);
            const f32x4 y = v[j] * rstd * gg + bb;
            if (OUT_BF16) { u32x2 w; w.x = cvt_pk_bf16(y[0], y[1]); w.y = cvt_pk_bf16(y[2], y[3]); *((u32x2*)((bf16_t*)outp + (size_t)r * D) + C.lane + 64 * j) = w; }
            else *((f32x4*)((float*)outp + (size_t)r * D) + C.lane + 64 * j) = y;
        }
    }
}

constexpr float SC_LOG2E = 0.08838834764831845f * 1.4426950408889634f;
__device__ __forceinline__ int rel_bucket(int n) {
    const int e = 31 - __builtin_clz((unsigned)(n | 1));
    const int odd = ((unsigned)n * (unsigned)n >= (1u << (2 * e + 1))) ? 1 : 0;
    const int lg = min(31, 8 + 2 * e + odd);
    return n < 16 ? n : lg;
}
template <int MODE>
__device__ __forceinline__ void att_step(const bf16_t* __restrict__ Kp, const bf16_t* __restrict__ VTp, int ldv, int key0, int tq, bool colok,
                                         const bf16x8 (&qf)[4], float& m, float& lsum, f32x4 (&O)[8], float inv_l,
                                         const LAS float* tab, int hd16, LAS float* impq, int g, int fr) {
    bf16x8 ka[4], kb[4], vf[8];
    {
        const bf16_t* kq = Kp + ((size_t)(key0 >> 5) << 12) + fr * 32 + 8 * g;
#pragma unroll
        for (int dc = 0; dc < 4; ++dc) { ka[dc] = *(const bf16x8*)(kq + dc * 512); kb[dc] = *(const bf16x8*)(kq + 2048 + dc * 512); }
        if (MODE != 0) { const bf16_t* vq = VTp + ((size_t)(key0 >> 5) << 12) + fr * 32 + 8 * g;
#pragma unroll
            for (int dt = 0; dt < 8; ++dt) vf[dt] = *(const bf16x8*)(vq + dt * 512); }
    }
    f32x4 sa = {0.f, 0.f, 0.f, 0.f}, sb = {0.f, 0.f, 0.f, 0.f};
#pragma unroll
    for (int dc = 0; dc < 4; ++dc) { sa = __builtin_amdgcn_mfma_f32_16x16x32_bf16(ka[dc], qf[dc], sa, 0, 0, 0); sb = __builtin_amdgcn_mfma_f32_16x16x32_bf16(kb[dc], qf[dc], sb, 0, 0, 0); }
    float s[8]; bool ok[8];
#pragma unroll
    for (int e = 0; e < 8; ++e) {
        const int idx = key0 + 8 * g + e;
        const int dist = (MODE < 2) ? (tq - 31 - 16 * idx) : (tq - idx);
        ok[e] = (MODE < 2) ? (dist >= 0) : (MODE == 2 ? (dist >= 0 && dist < 512) : (dist >= 0 && colok));
        const int bk = rel_bucket(max(dist, 0));
        const float sv = (e < 4 ? sa[e & 3] : sb[e & 3]) * SC_LOG2E + tab[bk * 16 + hd16];
        s[e] = ok[e] ? sv : -1e30f;
    }
    float p[8];
    if (MODE != 1) {
        float mx = fmaxf(fmaxf(fmaxf(s[0], s[1]), fmaxf(s[2], s[3])), fmaxf(fmaxf(s[4], s[5]), fmaxf(s[6], s[7])));
        mx = fmaxf(mx, __shfl_xor(mx, 16)); mx = fmaxf(mx, __shfl_xor(mx, 32));
        const float mn = fmaxf(m, mx); const float alpha = __builtin_amdgcn_exp2f(m - mn); m = mn;
        float ps = 0.f;
#pragma unroll
        for (int e = 0; e < 8; ++e) { p[e] = ok[e] ? __builtin_amdgcn_exp2f(s[e] - mn) : 0.f; ps += p[e]; }
        lsum = lsum * alpha + ps;
        if (MODE != 0) {
#pragma unroll
            for (int dt = 0; dt < 8; ++dt) O[dt] = O[dt] * alpha;
        }
    } else {
#pragma unroll
        for (int e = 0; e < 8; ++e) p[e] = ok[e] ? __builtin_amdgcn_exp2f(s[e] - m) * inv_l : 0.f;
        const int G2 = (key0 >> 2) + 2 * g;
        atomicAdd((float*)(impq + G2), (p[0] + p[1]) + (p[2] + p[3]));
        atomicAdd((float*)(impq + G2 + 1), (p[3] + p[4]) + (p[5] + p[6]) + p[7]);
        atomicAdd((float*)(impq + G2 + 2), p[7]);
    }
    if (MODE != 0) {
        u32x4 pw; pw.x = cvt_pk_bf16(p[0], p[1]); pw.y = cvt_pk_bf16(p[2], p[3]); pw.z = cvt_pk_bf16(p[4], p[5]); pw.w = cvt_pk_bf16(p[6], p[7]);
        const bf16x8 pf = __builtin_bit_cast(bf16x8, pw);
#pragma unroll
        for (int dt = 0; dt < 8; ++dt) O[dt] = __builtin_amdgcn_mfma_f32_16x16x32_bf16(vf[dt], pf, O[dt], 0, 0, 0);
    }
}

struct Frag8 { long ka[4], kb[4], vf[8]; };
__device__ __forceinline__ void load_frag8(Frag8& F, const unsigned char* __restrict__ K8, const unsigned char* __restrict__ V8T, int key0, int g, int fr) {
    const unsigned char* kq = K8 + ((size_t)(key0 >> 5) << 12) + fr * 32 + 8 * g;
#pragma unroll
    for (int dc = 0; dc < 4; ++dc) { F.ka[dc] = *(const long*)(kq + dc * 512); F.kb[dc] = *(const long*)(kq + 2048 + dc * 512); }
    const unsigned char* vq = V8T + ((size_t)(key0 >> 5) << 12) + fr * 32 + 8 * g;
#pragma unroll
    for (int dt = 0; dt < 8; ++dt) F.vf[dt] = *(const long*)(vq + dt * 512);
}
__device__ __forceinline__ void compute_fp8(const Frag8& F, int key0, int tq, bool colok, const long (&q8)[4], float& m, float& lsum, f32x4 (&O)[8], const LAS float* tab, int hd16, int g) {
    f32x4 sa = {0.f, 0.f, 0.f, 0.f}, sb = {0.f, 0.f, 0.f, 0.f};
#pragma unroll
    for (int dc = 0; dc < 4; ++dc) { sa = __builtin_amdgcn_mfma_f32_16x16x32_fp8_fp8(F.ka[dc], q8[dc], sa, 0, 0, 0); sb = __builtin_amdgcn_mfma_f32_16x16x32_fp8_fp8(F.kb[dc], q8[dc], sb, 0, 0, 0); }
    float s[8]; bool ok[8];
#pragma unroll
    for (int e = 0; e < 8; ++e) {
        const int dist = tq - (key0 + 8 * g + e);
        ok[e] = dist >= 0 && colok;
        const int bk = rel_bucket(max(dist, 0));
        const float sv = (e < 4 ? sa[e & 3] : sb[e & 3]) * SC_LOG2E + tab[bk * 16 + hd16];
        s[e] = ok[e] ? sv : -1e30f;
    }
    float mx = fmaxf(fmaxf(fmaxf(s[0], s[1]), fmaxf(s[2], s[3])), fmaxf(fmaxf(s[4], s[5]), fmaxf(s[6], s[7])));
    mx = fmaxf(mx, __shfl_xor(mx, 16)); mx = fmaxf(mx, __shfl_xor(mx, 32));
    const float mn = fmaxf(m, mx); const float alpha = __builtin_amdgcn_exp2f(m - mn);
    const bool grew = __builtin_amdgcn_ballot_w64(mn > m) != 0ull; m = mn;
    float p[8]; float ps = 0.f;
#pragma unroll
    for (int e = 0; e < 8; ++e) { p[e] = ok[e] ? __builtin_amdgcn_exp2f(s[e] - mn) : 0.f; ps += p[e]; }
    lsum = lsum * alpha + ps;
    if (grew) {
#pragma unroll
        for (int dt = 0; dt < 8; ++dt) O[dt] = O[dt] * alpha;
    }
    const long pf = pack8_fp8(p[0] * 256.f, p[1] * 256.f, p[2] * 256.f, p[3] * 256.f, p[4] * 256.f, p[5] * 256.f, p[6] * 256.f, p[7] * 256.f);
#pragma unroll
    for (int dt = 0; dt < 8; ++dt) O[dt] = __builtin_amdgcn_mfma_f32_16x16x32_fp8_fp8(F.vf[dt], pf, O[dt], 0, 0, 0);
}

constexpr int IMP_STRIDE = 264;
__device__ __forceinline__ void attention_phase(const Ctx& C, bf16_t* qo, const bf16_t* kc, const bf16_t* vcT, const bf16_t* ks, const bf16_t* vsT,
                                                const bf16_t* kw, const bf16_t* vwT, const float* gates, const float* rel_bias, const unsigned char* ks8, const unsigned char* vs8) {
    LAS float* tab = (LAS float*)C.lds;
    LAS float* imp = (LAS float*)(C.lds + 4096 + C.wave * 8192);
    LAS int* lst = (LAS int*)(C.lds + 4096 + C.wave * 8192 + 4 * IMP_STRIDE * 4);
    for (int i = C.tid; i < 512; i += NWAVES * 64) tab[i] = rel_bias[i] * 1.4426950408889634f;
    __syncthreads();
    const int lane = C.lane, fr = lane & 15, g = lane >> 4, qi = fr >> 2, hd = fr & 3;
    const int hk = (int)(blockIdx.x & 3), wl = (int)(blockIdx.x >> 2) * NWAVES + C.wave, nwl = C.NGW >> 2;
    for (int qg = wl; qg < T / 4; qg += nwl) {
        const int t0 = qg * 4, tq = t0 + qi, head = hk * 4 + hd, jt = t0 >> 6;
        bf16x8 qf[4];
        { const bf16_t* qp = qo + (size_t)tq * D + head * HD + 8 * g;
#pragma unroll
          for (int dc = 0; dc < 4; ++dc) qf[dc] = *(const bf16x8*)(qp + dc * 32); }
        const float g0 = gates[(size_t)tq * 48 + head * 3 + 0], g1 = gates[(size_t)tq * 48 + head * 3 + 1], g2 = gates[(size_t)tq * 48 + head * 3 + 2];
        f32x4 OA[8];
#pragma unroll
        for (int dt = 0; dt < 8; ++dt) OA[dt] = (f32x4){0.f, 0.f, 0.f, 0.f};
        f32x4 O[8];
        for (int i = lane; i < 4 * IMP_STRIDE; i += 64) imp[i] = 0.f;
        __builtin_amdgcn_wave_barrier(); asm volatile("s_waitcnt lgkmcnt(0)" ::: "memory");
        const bf16_t* Kc = kc + (size_t)hk * NCMP * HD; const bf16_t* Vc = vcT + (size_t)hk * HD * NCMP;
        const int ncv = (t0 + 3 >= 31) ? ((t0 + 3 - 31) >> 4) + 1 : 0;
        const int nst = (ncv + 31) >> 5;
        {
            float m = -1e30f, lsum = 0.f;
            for (int st = 0; st < nst; ++st) att_step<0>(Kc, Vc, NCMP, st * 32, tq, true, qf, m, lsum, O, 0.f, tab, hd + 0 * 16 + (hk * 4), imp + qi * IMP_STRIDE, g, fr);
            float l = lsum; l += __shfl_xor(l, 16); l += __shfl_xor(l, 32);
            const float inv = l > 0.f ? 1.f / l : 0.f;
#pragma unroll
            for (int dt = 0; dt < 8; ++dt) O[dt] = (f32x4){0.f, 0.f, 0.f, 0.f};
            for (int st = 0; st < nst; ++st) att_step<1>(Kc, Vc, NCMP, st * 32, tq, true, qf, m, lsum, O, inv, tab, hd + hk * 4, imp + qi * IMP_STRIDE, g, fr);
#pragma unroll
            for (int dt = 0; dt < 8; ++dt) OA[dt] = OA[dt] + O[dt] * g0;
        }
        __builtin_amdgcn_wave_barrier(); asm volatile("s_waitcnt lgkmcnt(0)" ::: "memory");
        int nlist = 0;
        const int ncand = jt - 2;
        if (ncand <= 13) {
            if (lane <= jt) lst[lane] = lane | (0xF << 16);
            nlist = jt + 1;
        } else {
            if (lane == 0) { lst[0] = 0 | (0xF << 16); lst[1] = (jt - 1) | (0xF << 16); lst[2] = jt | (0xF << 16); }
            nlist = 3;
            for (int qq = 0; qq < 4; ++qq) {
                float v[4];
#pragma unroll
                for (int k = 0; k < 4; ++k) { const int sblk = 4 * lane + k; const float x = imp[qq * IMP_STRIDE + sblk]; v[k] = (sblk >= 1 && sblk <= jt - 2) ? x : -1.f; }
                for (int r = 0; r < 13; ++r) {
                    float lm = fmaxf(fmaxf(v[0], v[1]), fmaxf(v[2], v[3]));
                    float wm = lm;
#pragma unroll
                    for (int o = 1; o < 64; o <<= 1) wm = fmaxf(wm, __shfl_xor(wm, o));
                    const unsigned long long bal = __ballot(lm == wm);
                    const int src = __ffsll((long long)bal) - 1;
                    if (lane == src) {
                        int k = (v[0] == wm) ? 0 : (v[1] == wm) ? 1 : (v[2] == wm) ? 2 : 3;
                        if (k == 0) v[0] = -2.f; else if (k == 1) v[1] = -2.f; else if (k == 2) v[2] = -2.f; else v[3] = -2.f;
                        lst[nlist + r] = (4 * lane + k) | ((1 << qq) << 16);
                    }
                }
                nlist += 13;
            }
        }
        __builtin_amdgcn_wave_barrier(); asm volatile("s_waitcnt lgkmcnt(0)" ::: "memory");
        {
            const unsigned char* Ks8 = ks8 + (size_t)hk * T * HD; const unsigned char* Vs8 = vs8 + (size_t)hk * T * HD;
            long q8[4];
#pragma unroll
            for (int dc = 0; dc < 4; ++dc) { const u32x4 w = __builtin_bit_cast(u32x4, qf[dc]); q8[dc] = pack8_fp8(bf_lo(w[0]), bf_hi(w[0]), bf_lo(w[1]), bf_hi(w[1]), bf_lo(w[2]), bf_hi(w[2]), bf_lo(w[3]), bf_hi(w[3])); }
            float m = -1e30f, lsum = 0.f;
#pragma unroll
            for (int dt = 0; dt < 8; ++dt) O[dt] = (f32x4){0.f, 0.f, 0.f, 0.f};
            Frag8 FA, FB;
            int ent = __builtin_amdgcn_readfirstlane(lst[0]);
            load_frag8(FA, Ks8, Vs8, (ent & 0xffff) * 64, g, fr);
            for (int i = 0; i < nlist; ++i) {
                const int blk = ent & 0xffff; const bool colok = ((ent >> (16 + qi)) & 1) != 0;
                load_frag8(FB, Ks8, Vs8, blk * 64 + 32, g, fr);
                compute_fp8(FA, blk * 64, tq, colok, q8, m, lsum, O, tab, hd + hk * 4, g);
                const int nent = __builtin_amdgcn_readfirstlane(lst[(i + 1 < nlist) ? i + 1 : i]);
                load_frag8(FA, Ks8, Vs8, (nent & 0xffff) * 64, g, fr);
                compute_fp8(FB, blk * 64 + 32, tq, colok, q8, m, lsum, O, tab, hd + hk * 4, g);
                ent = nent;
            }
            float l = lsum; l += __shfl_xor(l, 16); l += __shfl_xor(l, 32);
            const float sc = (l > 0.f ? 1.f / l : 0.f) * g1 * (1.f / 256.f);
#pragma unroll
            for (int dt = 0; dt < 8; ++dt) OA[dt] = OA[dt] + O[dt] * sc;
        }
        {
            const bf16_t* Kw = kw + (size_t)hk * T * HD; const bf16_t* Vw = vwT + (size_t)hk * HD * T;
            float m = -1e30f, lsum = 0.f;
#pragma unroll
            for (int dt = 0; dt < 8; ++dt) O[dt] = (f32x4){0.f, 0.f, 0.f, 0.f};
            const int kstart = max(0, t0 - 511) & ~31;
            for (int k0 = kstart; k0 <= t0 + 3; k0 += 32) att_step<2>(Kw, Vw, T, k0, tq, true, qf, m, lsum, O, 0.f, tab, hd + hk * 4, imp, g, fr);
            float l = lsum; l += __shfl_xor(l, 16); l += __shfl_xor(l, 32);
            const float sc = (l > 0.f ? 1.f / l : 0.f) * g2;
#pragma unroll
            for (int dt = 0; dt < 8; ++dt) OA[dt] = OA[dt] + O[dt] * sc;
        }
        { bf16_t* op = qo + (size_t)tq * D + head * HD + 4 * g;
#pragma unroll
          for (int dt = 0; dt < 8; ++dt) { u32x2 w; w.x = cvt_pk_bf16(OA[dt][0], OA[dt][1]); w.y = cvt_pk_bf16(OA[dt][2], OA[dt][3]); *(u32x2*)(op + dt * 16) = w; } }
        __builtin_amdgcn_wave_barrier(); asm volatile("s_waitcnt lgkmcnt(0)" ::: "memory");
    }
}

__global__ void __launch_bounds__(NWAVES * 64, 2) fwd_megakernel(Args args) {
    extern __shared__ __attribute__((aligned(16))) unsigned char lds_raw[];
    __builtin_assume(__builtin_amdgcn_workitem_id_y() == 0); __builtin_assume(__builtin_amdgcn_workitem_id_z() == 0);
    cg::grid_group grid = cg::this_grid();
    Ctx C; C.lds = (LAS unsigned char*)lds_raw; C.tid = threadIdx.x; C.lane = C.tid & 63; C.wave = __builtin_amdgcn_readfirstlane(C.tid >> 6);
    const int G = args.G, bx = blockIdx.x;
    C.gw = bx * NWAVES + C.wave; C.NGW = G * NWAVES; C.gtid = bx * (NWAVES * 64) + C.tid; C.NT = G * NWAVES * 64;
    unsigned char* ws = args.ws;
#define x_in (args.in[0])
#define pin (args.in[1])
#define w_in (args.in[2])
#define conv_w (args.in[3])
#define pe_k (args.in[4])
#define w1_k (args.in[5])
#define w2_k (args.in[6])
#define pe_v (args.in[7])
#define w1_v (args.in[8])
#define w2_v (args.in[9])
#define w_conv_out (args.in[10])
#define w_attn_out (args.in[11])
#define w_mix_out (args.in[12])
#define ln1_g (args.in[13])
#define ln1_b (args.in[14])
#define w_up (args.in[15])
#define w_down (args.in[16])
#define w_ple (args.in[17])
#define w_ple_gate (args.in[18])
#define ln2_g (args.in[19])
#define ln2_b (args.in[20])
#define rel_bias (args.in[21])
#define BP(off) ((bf16_t*)(ws + (off)))
#define FP(off) ((float*)(ws + (off)))
#define XB BP(WS_XB)
#define WTIN BP(WS_WTIN)
#define WTVT BP(WS_WTVT)
#define WTMB BP(WS_WTMB)
#define W1K BP(WS_W1K)
#define W1V BP(WS_W1V)
#define BIASK FP(WS_BIASK)
#define BIASV FP(WS_BIASV)
#define HIDK BP(WS_HIDK)
#define HIDV BP(WS_HIDV)
#define KC BP(WS_KC)
#define VCT BP(WS_VCT)
#define GATES FP(WS_GATES)
#define BG BP(WS_BG)
#define ZZ BP(WS_ZZ)
#define Q BP(WS_Q)
#define KCS BP(WS_KCS)
#define VCS BP(WS_VCS)
#define KS BP(WS_KS)
#define KW BP(WS_KW)
#define VST BP(WS_VST)
#define VWT BP(WS_VWT)
#define SMA BP(WS_SMA)
#define SMB BP(WS_SMB)
#define WTCONV BP(WS_WTCONV)
#define WTATTN BP(WS_WTATTN)
#define WTMIX BP(WS_WTMIX)
#define WTGATE BP(WS_WTGATE)
#define WTPLE BP(WS_WTPLE)
#define PB BP(WS_PB)
#define WTUP BP(WS_WTUP)
#define WTDOWN BP(WS_WTDOWN)
#define PRE1 FP(WS_PRE1)
#define PRE2 FP(WS_PRE2)
#define X1B BP(WS_X1B)
#define H1 BP(WS_H1)
    const int lo = args.ph_lo, hi = args.ph_hi;
    unsigned* gbar = (unsigned*)(ws + 16384); int nbar = 0;
    if (lo == 12345) grid.sync();
#ifndef PHMASK
#define PHMASK 0xFFFF
#endif
#define IN(k) (((PHMASK >> (k)) & 1) && lo <= (k) && (k) < hi)
#define SEAM(k) do { if (IN(k) && IN((k) + 1)) { ++nbar; \
        asm volatile("s_waitcnt vmcnt(0) lgkmcnt(0)" ::: "memory"); __syncthreads(); \
        if (C.tid == 0) { __builtin_amdgcn_fence(__ATOMIC_RELEASE, "agent"); asm volatile("s_waitcnt vmcnt(0)" ::: "memory"); \
            __hip_atomic_fetch_add(gbar, 1u, __ATOMIC_RELAXED, __HIP_MEMORY_SCOPE_AGENT); \
            while (__hip_atomic_load(gbar, __ATOMIC_RELAXED, __HIP_MEMORY_SCOPE_AGENT) < (unsigned)(nbar * G)) __builtin_amdgcn_s_sleep(2); \
            __builtin_amdgcn_fence(__ATOMIC_ACQUIRE, "agent"); asm volatile("s_waitcnt vmcnt(0)" ::: "memory"); } \
        __syncthreads(); \
        __builtin_amdgcn_fence(__ATOMIC_ACQUIRE, "agent"); asm volatile("s_waitcnt vmcnt(0)" ::: "memory"); } } while (0)

    if (IN(0)) {
        cvt_job(C, x_in, XB, (size_t)T * D / 8);
        tr_job(C, w_in, D, NIN, 2048, 2048, WTIN, D, 0, 128, 256);
        tr_job(C, w_in, D, NIN, 4096, 2048, WTIN, D, 128, 128, 256);
        tr_job(C, w_in, D, NIN, 0, 2048, WTIN, D, 4096, 2048, 0);
        tr_job(C, w_in, D, NIN, 6144, 2048, WTIN, D, 6144, 2048, 0);
        tr_job(C, w_in, D, NIN, 8192, 512, WTIN, D, 8192, 512, 0);
        tr_job(C, w_in, D, NIN, 8704, 512, WTIN, D, 8704, 512, 0);
        tr_job(C, w_in, D, NIN, 9216, 512, WTIN, D, 9216, 512, 0);
        tr_job(C, w_in, D, NIN, 10240, 512, WTIN, D, 9728, 512, 0);
        tr_job(C, w_in, D, NIN, 11312, 2048, WTIN, D, 10240, 2048, 0);
        tr_job(C, w_in, D, NIN, 9728, 512, WTVT, D, 0, 512, 0);
        tr_job(C, w_in, D, NIN, 10752, 512, WTVT, D, 512, 512, 0);
        tr_job(C, w_in, D, NIN, 13360, 2048, WTMB, D, 0, 2048, 0);
        tr_job(C, w1_k, 4096, 256, 0, 256, W1K, 4096, 0, 256, 0);
        tr_job(C, w1_v, 4096, 256, 0, 256, W1V, 4096, 0, 256, 0);
        for (int i = C.gtid; i < 256 * D; i += C.NT) { const int r = i / D, k = i % D; const float v = (r < 48) ? w_in[(size_t)k * NIN + 11264 + r] : 0.f; WTIN[(size_t)(12288 + r) * D + k] = (bf16_t)(cvt_pk_bf16(v, 0.f) & 0xffff); }
        if (bx == G - 1) {
            const int n = C.tid & 255; const float* pe = (C.tid < 256) ? pe_k : pe_v; const float* w1 = (C.tid < 256) ? w1_k : w1_v; float s = 0.f;
            for (int j = 0; j < 4096; ++j) s += pe[j] * w1[(size_t)j * 256 + n];
            ((C.tid < 256) ? BIASK : BIASV)[n] = s;
        }
        asm volatile("s_waitcnt vmcnt(0) lgkmcnt(0)" ::: "memory"); __syncthreads();
    }
    SEAM(0);
    if (IN(1)) {
        { pg8::Gemm g{XB, WTIN, T, 12544, D, D, D}; pg8::StaticOrder S; S.init(T, 12544, G, bx);
          EpiInProj E{ZZ, BG, Q, KCS, SMA, GATES, ws + 492 * MiB};
          pg8::gemm_phase(C.lds, g, S, E); }
        { pg8::Gemm g{WTVT, XB, 1024, T, D, D, D}; pg8::StaticOrder S; S.init(1024, T, G, (bx + 64) % G);
          pg8::EpiGen<FStoreVT> E{{VST, ws + 500 * MiB}};
          pg8::gemm_phase(C.lds, g, S, E); }
    }
    SEAM(1);
    if (IN(2)) {
        if (bx < 32) {
            { pg8::Gemm g{KCS, W1K, 4096, 256, 4096, 2048, 4096}; pg8::StaticOrder S; S.init(4096, 256, G, bx < 16 ? bx : -1); S.G = 16;
              pg8::EpiGen<FGeluBias> E{{HIDK, 256, BIASK}}; pg8::gemm_phase(C.lds, g, S, E); }
            { pg8::Gemm g{VCS, W1V, 4096, 256, 4096, 2048, 4096}; pg8::StaticOrder S; S.init(4096, 256, G, (bx >= 16 && bx < 32) ? bx - 16 : -1); S.G = 16;
              pg8::EpiGen<FGeluBias> E{{HIDV, 256, BIASV}}; pg8::gemm_phase(C.lds, g, S, E); }
        } else
        for (size_t i = (size_t)(bx - 32) * (NWAVES * 64) + C.tid; i < (size_t)T * D / 8; i += (size_t)(G - 32) * (NWAVES * 64)) {
            const int t = (int)(i / (D / 8)), c8 = (int)(i % (D / 8)) * 8;
            f32x4 z0a, z0b, z1a = {0.f, 0.f, 0.f, 0.f}, z1b = z1a, z2a = z1a, z2b = z1a, ba, bb;
            unpack8(*(const u32x4*)(ZZ + (size_t)t * D + c8), z0a, z0b);
            if (t >= 1) unpack8(*(const u32x4*)(ZZ + (size_t)(t - 1) * D + c8), z1a, z1b);
            if (t >= 2) unpack8(*(const u32x4*)(ZZ + (size_t)(t - 2) * D + c8), z2a, z2b);
            unpack8(*(const u32x4*)(BG + (size_t)t * D + c8), ba, bb);
            const f32x4 w0a = *(const f32x4*)(conv_w + c8), w0b = *(const f32x4*)(conv_w + c8 + 4);
            const f32x4 w1a = *(const f32x4*)(conv_w + D + c8), w1b = *(const f32x4*)(conv_w + D + c8 + 4);
            const f32x4 w2a = *(const f32x4*)(conv_w + 2 * D + c8), w2b = *(const f32x4*)(conv_w + 2 * D + c8 + 4);
            const f32x4 ua = ba * (w0a * z2a + w1a * z1a + w2a * z0a), ub = bb * (w0b * z2b + w1b * z1b + w2b * z0b);
            *(u32x4*)(BG + (size_t)t * D + c8) = pack8(ua, ub);
        }
    }
    SEAM(2);
    if (IN(3)) {
        { pg8::Gemm g{XB, WTMB, T, D, D, D, D}; pg8::StaticOrder S; S.init(T, D, G, bx);
          pg8::EpiGen<FStoreBf16> E{{SMB, D, 1}}; pg8::gemm_phase(C.lds, g, S, E); }
    }
    SEAM(3);
    if (IN(4)) {
        for (int i = C.gtid; i < 4096 * HD; i += C.NT) {
            const int d = i & 127, row = i >> 7; const bf16_t* hp = HIDK + (size_t)row * 256; float s = 0.f;
            for (int j = 0; j < 256; j += 2) { const unsigned w = *(const unsigned*)(hp + j); s += bf_lo(w) * w2_k[(size_t)j * HD + d] + bf_hi(w) * w2_k[(size_t)(j + 1) * HD + d]; }
            { const int h = row >> 10, c = row & 1023; KC[(size_t)h * 131072 + ((size_t)(c >> 5) << 12) + ((c >> 2) & 1) * 2048 + (d >> 5) * 512 + (4 * ((c & 31) >> 3) + (c & 3)) * 32 + (d & 31)] = (bf16_t)(cvt_pk_bf16(s, 0.f) & 0xffff); }
        }
        for (int i = C.gtid; i < 4096 * HD; i += C.NT) {
            const int ii = i & 1023, d = (i >> 10) & 127, h = i >> 17; const bf16_t* hp = HIDV + (size_t)(h * 1024 + ii) * 256; float s = 0.f;
            for (int j = 0; j < 256; j += 2) { const unsigned w = *(const unsigned*)(hp + j); s += bf_lo(w) * w2_v[(size_t)j * HD + d] + bf_hi(w) * w2_v[(size_t)(j + 1) * HD + d]; }
            VCT[(size_t)h * 131072 + ((size_t)(ii >> 5) << 12) + (d >> 4) * 512 + (d & 15) * 32 + (ii & 31)] = (bf16_t)(cvt_pk_bf16(s, 0.f) & 0xffff);
        }
        tr_job(C, w_conv_out, D, D, 0, D, WTCONV, D, 0, D, 0);
        tr_job(C, w_attn_out, D, D, 0, D, WTATTN, D, 0, D, 0);
        tr_job(C, w_mix_out, D, D, 0, D, WTMIX, D, 0, D, 0);
        tr_job(C, w_ple_gate, D, D, 0, D, WTGATE, D, 0, D, 0);
        tr_job(C, w_ple, PLE, D, 0, D, WTPLE, PLE, 0, D, 0);
        tr_job(C, w_up, D, FF, 0, FF, WTUP, D, 0, FF, 0);
        tr_job(C, w_down, FF, D, 0, D, WTDOWN, FF, 0, D, 0);
        cvt_job(C, pin, PB, (size_t)T * PLE / 8);
        asm volatile("s_waitcnt vmcnt(0) lgkmcnt(0)" ::: "memory"); __syncthreads();
    }
    SEAM(4);
    if (IN(5)) {
        attention_phase(C, Q, KC, VCT, KS, VST, KW, VWT, GATES, rel_bias, ws + 492 * MiB, ws + 500 * MiB);
        asm volatile("s_waitcnt vmcnt(0) lgkmcnt(0)" ::: "memory"); __syncthreads();
    }
    SEAM(5);
    if (IN(6)) {
        { pg8::Gemm g{BG, WTCONV, T, D, D, D, D}; pg8::StaticOrder S; S.init(T, D, G, bx); pg8::EpiGen<FMulInplace> E{{SMA, D}}; pg8::gemm_phase(C.lds, g, S, E); }
        { pg8::Gemm g{Q, WTATTN, T, D, D, D, D}; pg8::StaticOrder S; S.init(T, D, G, bx); pg8::EpiGen<FMulAddInplace> E{{SMB, SMA, D}}; pg8::gemm_phase(C.lds, g, S, E); }
    }
    SEAM(7);
    if (IN(8)) { pg8::Gemm g{SMB, WTMIX, T, D, D, D, D}; pg8::StaticOrder S; S.init(T, D, G, bx); pg8::EpiGen<FResidF32> E{{PRE1, x_in, D}}; pg8::gemm_phase(C.lds, g, S, E); }
    SEAM(8);
    if (IN(9)) ln_rows<true>(C, PRE1, ln1_g, ln1_b, X1B);
    SEAM(9);
    if (IN(10)) {
        { pg8::Gemm g{X1B, WTGATE, T, D, D, D, D}; pg8::StaticOrder S; S.init(T, D, G, bx); pg8::EpiGen<FSigmoidF32> E{{PRE2, D}}; pg8::gemm_phase(C.lds, g, S, E); }
        { pg8::Gemm g{X1B, WTUP, T / 2, FF, D, D, D}; pg8::StaticOrder S; S.init(T / 2, FF, G, bx); pg8::EpiGen<FStoreBf16> E{{H1, FF, 2}}; pg8::gemm_phase(C.lds, g, S, E); }
    }
    SEAM(10);
    if (IN(11)) { pg8::Gemm g{PB, WTPLE, T, D, PLE, PLE, PLE}; pg8::StaticOrder S; S.init(T, D, G, bx); pg8::EpiGen<FPle> E{{PRE2, X1B, D}}; pg8::gemm_phase(C.lds, g, S, E); }
    SEAM(11);
    if (IN(12)) { pg8::Gemm g{H1, WTDOWN, T / 2, D, FF, FF, FF}; pg8::StaticOrder S; S.init(T / 2, D, G, bx); pg8::EpiGen<FAccF32> E{{PRE2, D}}; pg8::gemm_phase(C.lds, g, S, E); }
    SEAM(12);
    if (IN(13)) { pg8::Gemm g{X1B + (size_t)(T / 2) * D, WTUP, T / 2, FF, D, D, D}; pg8::StaticOrder S; S.init(T / 2, FF, G, bx); pg8::EpiGen<FStoreBf16> E{{H1, FF, 2}}; pg8::gemm_phase(C.lds, g, S, E); }
    SEAM(13);
    if (IN(14)) { pg8::Gemm g{H1, WTDOWN, T / 2, D, FF, FF, FF}; pg8::StaticOrder S; S.init(T / 2, D, G, bx); pg8::EpiGen<FAccF32> E{{PRE2 + (size_t)(T / 2) * D, D}}; pg8::gemm_phase(C.lds, g, S, E); }
    SEAM(14);
    if (IN(15)) ln_rows<false>(C, PRE2, ln2_g, ln2_b, args.out);
#undef IN
#undef SEAM
}

extern "C" void kernel_launch(void* const* d_in, const int* in_sizes, int n_in, void* d_out, int out_size, void* d_ws, size_t ws_size, hipStream_t stream) {
    static int grid = 0;
    if (grid == 0) {
        if (n_in != 22 || ws_size < 508 * MiB) { fprintf(stderr, "kernel_launch: need 22 inputs and >= %zu bytes of workspace (got %d, %zu)\n", (size_t)WS_END, n_in, ws_size); grid = -1; return; }
        int dev = 0, cus = 0, per_cu = 0;
        hipGetDevice(&dev); hipDeviceGetAttribute(&cus, hipDeviceAttributeMultiprocessorCount, dev);
        if (hipFuncSetAttribute((const void*)fwd_megakernel, hipFuncAttributeMaxDynamicSharedMemorySize, LDS_BYTES) != hipSuccess) { fprintf(stderr, "kernel_launch: hipFuncSetAttribute failed\n"); grid = -1; return; }
        if (hipOccupancyMaxActiveBlocksPerMultiprocessor(&per_cu, (const void*)fwd_megakernel, NWAVES * 64, LDS_BYTES) != hipSuccess || per_cu < 1) { fprintf(stderr, "kernel_launch: occupancy query says %d\n", per_cu); per_cu = 1; }
        (void)hipGetLastError();
        grid = cus * 1;
    }
    if (grid < 0) return;
    Args a{};
    for (int i = 0; i < 22; ++i) a.in[i] = (const float*)d_in[i];
    a.out = (float*)d_out; a.ws = (unsigned char*)d_ws; a.G = grid; a.pad = 0;
#if MK_PER_PHASE
    for (int ph = 0; ph < 16; ++ph) { a.ph_lo = ph; a.ph_hi = ph + 1; void* kargs[] = {&a};
        hipError_t e = hipLaunchCooperativeKernel((const void*)fwd_megakernel, dim3(grid), dim3(NWAVES * 64), kargs, LDS_BYTES, stream);
        if (e != hipSuccess) { fprintf(stderr, "kernel_launch: launch failed: %s\n", hipGetErrorString(e)); break; } }
#else
    (void)hipMemsetAsync((char*)d_ws + 16384, 0, 256, stream);
    a.ph_lo = 0; a.ph_hi = 16; void* kargs[] = {&a};
    hipError_t e = hipLaunchCooperativeKernel((const void*)fwd_megakernel, dim3(grid), dim3(NWAVES * 64), kargs, LDS_BYTES, stream);
    if (e != hipSuccess) fprintf(stderr, "kernel_launch: cooperative launch failed: %s (grid %d)\n", hipGetErrorString(e), grid);
#endif
}
```

```cpp
#include <hip/hip_runtime.h>
#include <hip/hip_cooperative_groups.h>
#include <cstdio>
#include <cstdint>
namespace cg = cooperative_groups;

#define LAS __attribute__((address_space(3)))
typedef unsigned short bf16_t;
typedef short bf16x8 __attribute__((ext_vector_type(8)));
typedef float f32x4 __attribute__((ext_vector_type(4)));
typedef float f32x2 __attribute__((ext_vector_type(2)));
typedef unsigned u32x4 __attribute__((ext_vector_type(4)));
typedef unsigned u32x2 __attribute__((ext_vector_type(2)));

#ifndef MK_PER_PHASE
#define MK_PER_PHASE 0
#endif

constexpr int T = 16384, D = 2048, NIN = 15408, FF = 8192, PLE = 256, HK = 4, HD = 128, NCMP = 1024;
constexpr float DN_ALPHA = 1.189207115002721f;
constexpr float LN_EPS = 1e-5f;
constexpr int NWAVES = 8;
constexpr int LDS_BYTES = 147456;

constexpr size_t MiB = 1u << 20;
constexpr size_t WS_BIASK = 0, WS_BIASV = 4096;
constexpr size_t WS_XB = 1 * MiB;
constexpr size_t WS_WTUP = 1 * MiB, WS_WTDOWN = 33 * MiB;
constexpr size_t WS_WTIN = 65 * MiB;
constexpr size_t WS_WTVT = 114 * MiB;
constexpr size_t WS_WTMB = 118 * MiB;
constexpr size_t WS_WTCONV = 65 * MiB, WS_WTATTN = 73 * MiB, WS_WTMIX = 81 * MiB, WS_WTGATE = 89 * MiB, WS_WTPLE = 97 * MiB, WS_PB = 98 * MiB;
constexpr size_t WS_W1K = 126 * MiB, WS_W1V = 128 * MiB;
constexpr size_t WS_HIDK = 130 * MiB, WS_HIDV = 132 * MiB;
constexpr size_t WS_KC = 134 * MiB, WS_VCT = 135 * MiB;
constexpr size_t WS_GATES = 136 * MiB;
constexpr size_t WS_BG = 140 * MiB;
constexpr size_t WS_X1B = 140 * MiB;
constexpr size_t WS_ZZ = 204 * MiB;
constexpr size_t WS_SMB = 204 * MiB, WS_H1 = 204 * MiB;
constexpr size_t WS_Q = 268 * MiB;
constexpr size_t WS_KCS = 332 * MiB, WS_VCS = 348 * MiB, WS_KS = 364 * MiB, WS_KW = 380 * MiB, WS_VST = 396 * MiB, WS_VWT = 412 * MiB;
constexpr size_t WS_SMA = 428 * MiB;
constexpr size_t WS_PRE1 = 300 * MiB, WS_PRE2 = 364 * MiB;
constexpr size_t WS_END = 492 * MiB;

typedef __bf16 bf16x2_t __attribute__((ext_vector_type(2)));
__device__ __forceinline__ unsigned cvt_pk_bf16(float lo, float hi) { f32x2 v = {lo, hi}; bf16x2_t b = __builtin_convertvector(v, bf16x2_t); return __builtin_bit_cast(unsigned, b); }
__device__ __forceinline__ float bf_lo(unsigned w) { return __uint_as_float(w << 16); }
__device__ __forceinline__ float bf_hi(unsigned w) { return __uint_as_float(w & 0xffff0000u); }
__device__ __forceinline__ float fast_sigmoid(float x) { return __builtin_amdgcn_rcpf(1.f + __expf(-x)); }
__device__ __forceinline__ u32x4 pack8(const f32x4& a, const f32x4& b) { u32x4 w; w.x = cvt_pk_bf16(a[0], a[1]); w.y = cvt_pk_bf16(a[2], a[3]); w.z = cvt_pk_bf16(b[0], b[1]); w.w = cvt_pk_bf16(b[2], b[3]); return w; }
__device__ __forceinline__ void unpack8(const u32x4& w, f32x4& a, f32x4& b) { a[0] = bf_lo(w.x); a[1] = bf_hi(w.x); a[2] = bf_lo(w.y); a[3] = bf_hi(w.y); b[0] = bf_lo(w.z); b[1] = bf_hi(w.z); b[2] = bf_lo(w.w); b[3] = bf_hi(w.w); }

__device__ __forceinline__ long pack8_fp8(float a0, float a1, float a2, float a3, float a4, float a5, float a6, float a7) {
    int lo = __builtin_amdgcn_cvt_pk_fp8_f32(a0, a1, 0, false); lo = __builtin_amdgcn_cvt_pk_fp8_f32(a2, a3, lo, true);
    int hi = __builtin_amdgcn_cvt_pk_fp8_f32(a4, a5, 0, false); hi = __builtin_amdgcn_cvt_pk_fp8_f32(a6, a7, hi, true);
    return (long)(((unsigned long long)(unsigned)hi << 32) | (unsigned long long)(unsigned)lo);
}

namespace pg8 {
constexpr int BM = 256, BK = 64, HALF = 128, HTB = HALF * BK * 2, STAGE_BYTES = 8 * HTB, NXCD = 8, WGM = 8;
__host__ __device__ __forceinline__ int lds_byte(int r, int c) { const int st = (r >> 4) * 2 + (c >> 5), rr = r & 15, cc = c & 31, ob = rr * 64 + cc * 2; return st * 1024 + (ob ^ (((ob >> 9) & 1) << 5)); }
__host__ __device__ __forceinline__ void stage_rc(int b, int& R, int& C) { const int st = b / 1024, sb = b % 1024, swz = sb ^ (((sb >> 9) & 1) << 5); R = (st >> 1) * 16 + swz / 64; C = (st & 1) * 32 + (swz % 64) / 2; }
__host__ __device__ __forceinline__ int perm32(int rho) { const int n = rho >> 4, i = rho & 15; return 8 * (i >> 2) + 4 * n + (i & 3); }

struct Unit { int pm, pn; };
struct Gemm { const bf16_t* A; const bf16_t* Bt; int M, N, K, lda, ldb; };

struct StaticOrder {
    int nM, nN, nwg, G, c;
    __device__ void init(int M, int N, int G_, int c_) { nM = M / BM; nN = N / BM; nwg = nM * nN; G = G_; c = c_; }
    __device__ bool next(int i, Unit& u) const {
        const long L = (long)i * G + c; if (c < 0 || L >= nwg) return false;
        int wgid = (int)L; { const int q = nwg / NXCD, r = nwg % NXCD, xcd = wgid % NXCD, off = wgid / NXCD; wgid = (xcd < r ? xcd * (q + 1) : r * (q + 1) + (xcd - r) * q) + off; }
        const int nig = WGM * nN, gid = wgid / nig, fm = gid * WGM, gsz = (nM - fm) < WGM ? (nM - fm) : WGM;
        u.pm = fm + ((wgid % nig) % gsz); u.pn = (wgid % nig) / gsz; return true;
    }
};

template <class F> struct EpiGen {
    F f;
    __device__ __forceinline__ void operator()(const f32x4 (&acc)[2][2][4][2], const Unit& u, int wr, int wc, int fr, int fq) const {
        const int row0 = u.pm * BM + wr * 64 + fr, col0 = u.pn * BM + wc * 32 + 8 * fq;
#pragma unroll
        for (int ai = 0; ai < 2; ++ai)
#pragma unroll
            for (int m = 0; m < 4; ++m) {
                const int row = row0 + ai * HALF + m * 16;
#pragma unroll
                for (int bj = 0; bj < 2; ++bj) f(row, col0 + bj * HALF, acc[ai][bj][m][0], acc[ai][bj][m][1]);
            }
    }
};

template <class Epi, class Sched>
__device__ __forceinline__ void gemm_phase(LAS unsigned char* lds, const Gemm g, const Sched& S, const Epi& E) {
    const int tid = threadIdx.x, wid = __builtin_amdgcn_readfirstlane(tid >> 6), lane = tid & 63, wr = wid >> 2, wc = wid & 3, fr = lane & 15, fq = lane >> 4;
    const int K = g.K, nt = K / BK;
    unsigned voffA[2], voffB[2];
#pragma unroll
    for (int i = 0; i < 2; ++i) { int R, C; stage_rc(tid * 16 + i * 8192, R, C); const int Rb = (R & ~31) + perm32(R & 31);
        voffA[i] = (unsigned)(R * g.lda + C) * 2u; voffB[i] = (unsigned)(Rb * g.ldb + C) * 2u; }
    const size_t kstep = (size_t)(BK * 2);
    const size_t hstepA = (size_t)HALF * g.lda * 2, hstepB = (size_t)HALF * g.ldb * 2;
    const size_t tstepA = 2 * hstepA, tstepB = 2 * hstepB;
    const unsigned ldsw = (unsigned)wid * 1024u;
    const int aoff = lds_byte(wr * 64 + fr, fq * 8), boff = lds_byte(wc * 32 + fr, fq * 8);
#define PG8_SA(b, h) (((b) * 2 + (h)) * HTB)
#define PG8_SB(b, h) ((4 + (b) * 2 + (h)) * HTB)
#define PG8_STAGE(bufoff, gbase, voff) do { _Pragma("unroll") for (int _i = 0; _i < 2; ++_i) \
        __builtin_amdgcn_global_load_lds((const unsigned*)((const char*)(gbase) + (voff)[_i]), (LAS unsigned*)(lds + (bufoff) + ldsw + _i * 8192), 16, 0, 0); } while (0)
#define PG8_LDA(dst, b, h) do { _Pragma("unroll") for (int m = 0; m < 4; ++m) _Pragma("unroll") for (int k = 0; k < 2; ++k) dst[m][k] = *(const LAS bf16x8*)(lds + PG8_SA(b, h) + aoff + m * 2048 + k * 1024); } while (0)
#define PG8_LDB(dst, b, h) do { _Pragma("unroll") for (int n = 0; n < 2; ++n) _Pragma("unroll") for (int k = 0; k < 2; ++k) dst[n][k] = *(const LAS bf16x8*)(lds + PG8_SB(b, h) + boff + n * 2048 + k * 1024); } while (0)
#define PG8_MMA(ai, bj, At, Bt) do { __builtin_amdgcn_s_setprio(1); _Pragma("unroll") for (int m = 0; m < 4; ++m) _Pragma("unroll") for (int n = 0; n < 2; ++n) _Pragma("unroll") for (int k = 0; k < 2; ++k) \
        acc[ai][bj][m][n] = __builtin_amdgcn_mfma_f32_16x16x32_bf16(Bt[n][k], At[m][k], acc[ai][bj][m][n], 0, 0, 0); __builtin_amdgcn_s_setprio(0); } while (0)
#define PG8_WAIT_V(n) asm volatile("s_waitcnt vmcnt(" #n ")" ::: "memory")
#define PG8_WAIT_L(n) asm volatile("s_waitcnt lgkmcnt(" #n ")" ::: "memory")
#define PG8_BAR __builtin_amdgcn_s_barrier()
#define PG8_SCHED __builtin_amdgcn_sched_barrier(0)
    Unit cur, nxt; int ui = 0;
    if (!S.next(0, cur)) return;
    f32x4 acc[2][2][4][2];
#pragma unroll
    for (int a = 0; a < 2; ++a)
#pragma unroll
        for (int b = 0; b < 2; ++b)
#pragma unroll
            for (int m = 0; m < 4; ++m)
#pragma unroll
                for (int n = 0; n < 2; ++n) acc[a][b][m][n] = (f32x4){0.f, 0.f, 0.f, 0.f};
    bf16x8 At[4][2], B0[2][2], B1[2][2];
    const char* cA = (const char*)g.A + (size_t)cur.pm * tstepA; const char* cB = (const char*)g.Bt + (size_t)cur.pn * tstepB;
    PG8_STAGE(PG8_SB(0, 0), cB, voffB); PG8_STAGE(PG8_SB(0, 1), cB + hstepB, voffB); PG8_STAGE(PG8_SA(0, 0), cA, voffA); PG8_STAGE(PG8_SA(0, 1), cA + hstepA, voffA);
    if (wr == 1) PG8_BAR;
    PG8_WAIT_V(2); PG8_BAR;
    PG8_STAGE(PG8_SB(1, 0), cB + kstep, voffB); PG8_STAGE(PG8_SA(1, 0), cA + kstep, voffA); PG8_STAGE(PG8_SB(1, 1), cB + hstepB + kstep, voffB);
    PG8_WAIT_V(6); PG8_BAR;
    for (;;) {
        const bool has_next = S.next(ui + 1, nxt);
        const char* nA = has_next ? (const char*)g.A + (size_t)nxt.pm * tstepA : cA; const char* nB = has_next ? (const char*)g.Bt + (size_t)nxt.pn * tstepB : cB;
        for (int t = 0; t < nt; t += 2) {
            const bool last = (t == nt - 2);
            const char* a1 = cA + (size_t)(t + 1) * kstep;
            const char* a2 = last ? nA : cA + (size_t)(t + 2) * kstep; const char* b2 = last ? nB : cB + (size_t)(t + 2) * kstep;
            const char* a3 = a2 + kstep; const char* b3 = b2 + kstep;
            PG8_LDB(B0, 0, 0); PG8_LDB(B1, 0, 1); PG8_SCHED; PG8_LDA(At, 0, 0); PG8_STAGE(PG8_SA(1, 1), a1 + hstepA, voffA);
            PG8_WAIT_V(8); PG8_WAIT_L(0); PG8_BAR; PG8_MMA(0, 0, At, B0); PG8_MMA(0, 1, At, B1); PG8_BAR; PG8_SCHED;
            PG8_LDA(At, 0, 1); PG8_STAGE(PG8_SB(0, 0), b2, voffB); PG8_STAGE(PG8_SB(0, 1), b2 + hstepB, voffB); PG8_STAGE(PG8_SA(0, 0), a2, voffA);
            PG8_WAIT_V(8); PG8_WAIT_L(0); PG8_BAR; PG8_MMA(1, 0, At, B0); PG8_MMA(1, 1, At, B1); PG8_BAR; PG8_SCHED;
            PG8_LDB(B0, 1, 0); PG8_LDB(B1, 1, 1); PG8_SCHED; PG8_LDA(At, 1, 0); PG8_STAGE(PG8_SA(0, 1), a2 + hstepA, voffA);
            PG8_WAIT_V(8); PG8_WAIT_L(0); PG8_BAR; PG8_MMA(0, 0, At, B0); PG8_MMA(0, 1, At, B1); PG8_BAR; PG8_SCHED;
            PG8_LDA(At, 1, 1); PG8_STAGE(PG8_SB(1, 0), b3, voffB); PG8_STAGE(PG8_SB(1, 1), b3 + hstepB, voffB); PG8_STAGE(PG8_SA(1, 0), a3, voffA);
            PG8_WAIT_V(8); PG8_WAIT_L(0); PG8_BAR; PG8_MMA(1, 0, At, B0); PG8_MMA(1, 1, At, B1); PG8_BAR; PG8_SCHED;
        }
        if (wr == 0) PG8_BAR;
        E(acc, cur, wr, wc, fr, fq);
        if (!has_next) break;
#pragma unroll
        for (int a = 0; a < 2; ++a)
#pragma unroll
            for (int b = 0; b < 2; ++b)
#pragma unroll
                for (int m = 0; m < 4; ++m)
#pragma unroll
                    for (int n = 0; n < 2; ++n) acc[a][b][m][n] = (f32x4){0.f, 0.f, 0.f, 0.f};
        cur = nxt; cA = nA; cB = nB; ++ui;
        if (wr == 1) PG8_BAR;
    }
    PG8_WAIT_V(0);
    PG8_BAR;
#undef PG8_SA
#undef PG8_SB
#undef PG8_STAGE
#undef PG8_LDA
#undef PG8_LDB
#undef PG8_MMA
#undef PG8_WAIT_V
#undef PG8_WAIT_L
#undef PG8_BAR
#undef PG8_SCHED
}
}

struct FStoreBf16 {
    bf16_t* O; int ldc; int act;
    __device__ __forceinline__ void operator()(int row, int col, f32x4 a, f32x4 b) const {
        if (act == 1) { for (int i = 0; i < 4; ++i) { a[i] = fast_sigmoid(a[i]); b[i] = fast_sigmoid(b[i]); } }
        else if (act == 2) { for (int i = 0; i < 4; ++i) { float x = fmaxf(a[i], 0.f), y = fmaxf(b[i], 0.f); a[i] = x * x; b[i] = y * y; } }
        *(u32x4*)(O + (size_t)row * ldc + col) = pack8(a, b);
    }
};
struct FStoreVT {
    bf16_t* O; unsigned char* O8;
    __device__ __forceinline__ void operator()(int row, int col, f32x4 a, f32x4 b) const {
        if (row < 512) { const int hk = row >> 7, d = row & 127; *(long*)(O8 + (size_t)hk * ((size_t)T * 128) + ((size_t)(col >> 5) << 12) + (d >> 4) * 512 + (d & 15) * 32 + (col & 31)) = pack8_fp8(a[0], a[1], a[2], a[3], b[0], b[1], b[2], b[3]); *(u32x4*)(O + (size_t)hk * ((size_t)T * 128) + ((size_t)(col >> 5) << 12) + (d >> 4) * 512 + (d & 15) * 32 + (col & 31)) = pack8(a, b); }
        else { const int hk = (row - 512) >> 7, d = row & 127; *(u32x4*)(O + (size_t)512 * T + (size_t)hk * ((size_t)T * 128) + ((size_t)(col >> 5) << 12) + (d >> 4) * 512 + (d & 15) * 32 + (col & 31)) = pack8(a, b); }
    }
};
struct FGeluBias {
    bf16_t* O; int ldc; const float* bias;
    __device__ __forceinline__ void operator()(int row, int col, f32x4 a, f32x4 b) const {
        const f32x4 b0 = *(const f32x4*)(bias + col), b1 = *(const f32x4*)(bias + col + 4);
        a = a + b0; b = b + b1;
        for (int i = 0; i < 4; ++i) {
            float x = a[i]; a[i] = x * __builtin_amdgcn_rcpf(1.f + __expf(-1.5957691216057308f * (x + 0.044715f * x * x * x)));
            float y = b[i]; b[i] = y * __builtin_amdgcn_rcpf(1.f + __expf(-1.5957691216057308f * (y + 0.044715f * y * y * y)));
        }
        *(u32x4*)(O + (size_t)row * ldc + col) = pack8(a, b);
    }
};
struct FMulInplace {
    bf16_t* O; int ldc;
    __device__ __forceinline__ void operator()(int row, int col, f32x4 a, f32x4 b) const {
        bf16_t* p = O + (size_t)row * ldc + col; f32x4 g0, g1; unpack8(*(const u32x4*)p, g0, g1);
        *(u32x4*)p = pack8(a * g0, b * g1);
    }
};
struct FMulAddInplace {
    bf16_t* O; const bf16_t* Y; int ldc;
    __device__ __forceinline__ void operator()(int row, int col, f32x4 a, f32x4 b) const {
        bf16_t* p = O + (size_t)row * ldc + col; f32x4 g0, g1, y0, y1; unpack8(*(const u32x4*)p, g0, g1); unpack8(*(const u32x4*)(Y + (size_t)row * ldc + col), y0, y1);
        *(u32x4*)p = pack8(a * g0 + y0, b * g1 + y1);
    }
};
struct FResidF32 {
    float* P; const float* X; int ldc;
    __device__ __forceinline__ void operator()(int row, int col, f32x4 a, f32x4 b) const {
        const size_t o = (size_t)row * ldc + col;
        const f32x4 x0 = *(const f32x4*)(X + o), x1 = *(const f32x4*)(X + o + 4);
        *(f32x4*)(P + o) = x0 * DN_ALPHA + a; *(f32x4*)(P + o + 4) = x1 * DN_ALPHA + b;
    }
};
struct FSigmoidF32 {
    float* P; int ldc;
    __device__ __forceinline__ void operator()(int row, int col, f32x4 a, f32x4 b) const {
        for (int i = 0; i < 4; ++i) { a[i] = fast_sigmoid(a[i]); b[i] = fast_sigmoid(b[i]); }
        const size_t o = (size_t)row * ldc + col; *(f32x4*)(P + o) = a; *(f32x4*)(P + o + 4) = b;
    }
};
struct FPle {
    float* P; const bf16_t* X; int ldc;
    __device__ __forceinline__ void operator()(int row, int col, f32x4 a, f32x4 b) const {
        const size_t o = (size_t)row * ldc + col; f32x4 x0, x1; unpack8(*(const u32x4*)(X + o), x0, x1);
        const f32x4 p0 = *(const f32x4*)(P + o), p1 = *(const f32x4*)(P + o + 4);
        *(f32x4*)(P + o) = a * p0 + x0 * DN_ALPHA; *(f32x4*)(P + o + 4) = b * p1 + x1 * DN_ALPHA;
    }
};
struct FAccF32 {
    float* P; int ldc;
    __device__ __forceinline__ void operator()(int row, int col, f32x4 a, f32x4 b) const {
        const size_t o = (size_t)row * ldc + col;
        *(f32x4*)(P + o) = *(const f32x4*)(P + o) + a; *(f32x4*)(P + o + 4) = *(const f32x4*)(P + o + 4) + b;
    }
};
struct EpiInProj {
    bf16_t *zz, *bg, *q, *kv, *sma; float* gates; unsigned char* ks8;
    __device__ __forceinline__ void operator()(const f32x4 (&acc)[2][2][4][2], const pg8::Unit& u, int wr, int wc, int fr, int fq) const {
        const int row0 = u.pm * 256 + wr * 64 + fr, cw = wc * 32 + 8 * fq; const int pn = u.pn;
        if (pn < 16) {
#pragma unroll
            for (int ai = 0; ai < 2; ++ai)
#pragma unroll
                for (int m = 0; m < 4; ++m) { const int row = row0 + ai * 128 + m * 16;
                    *(u32x4*)(zz + (size_t)row * D + pn * 128 + cw) = pack8(acc[ai][0][m][0] * acc[ai][1][m][0], acc[ai][0][m][1] * acc[ai][1][m][1]); }
        } else if (pn < 32) {
            bf16_t* O = (pn < 24) ? bg : q; const int c0 = ((pn - 16) & 7) * 256 + cw;
#pragma unroll
            for (int ai = 0; ai < 2; ++ai)
#pragma unroll
                for (int m = 0; m < 4; ++m) { const int row = row0 + ai * 128 + m * 16;
#pragma unroll
                    for (int bj = 0; bj < 2; ++bj) *(u32x4*)(O + (size_t)row * D + c0 + bj * 128) = pack8(acc[ai][bj][m][0], acc[ai][bj][m][1]); }
        } else if (pn < 40) {
            const int c0 = (pn - 32) * 256; const int b = c0 >> 9, h0 = (c0 & 511) >> 7;
            bf16_t* O = kv + (size_t)b * ((size_t)T * 512);
#pragma unroll
            for (int ai = 0; ai < 2; ++ai)
#pragma unroll
                for (int m = 0; m < 4; ++m) { const int row = row0 + ai * 128 + m * 16;
#pragma unroll
                    for (int bj = 0; bj < 2; ++bj) {
                        const size_t off = (b >= 2) ? (((size_t)(row >> 5) << 12) + ((row >> 2) & 1) * 2048 + (cw >> 5) * 512 + (4 * ((row & 31) >> 3) + (row & 3)) * 32 + (cw & 31))
                                                    : ((size_t)row * 128 + cw);
                        *(u32x4*)(O + (size_t)(h0 + bj) * ((size_t)T * 128) + off) = pack8(acc[ai][bj][m][0], acc[ai][bj][m][1]);
                        if (b == 2) { const f32x4 a = acc[ai][bj][m][0], c2 = acc[ai][bj][m][1]; *(long*)(ks8 + (size_t)(h0 + bj) * ((size_t)T * 128) + off) = pack8_fp8(a[0], a[1], a[2], a[3], c2[0], c2[1], c2[2], c2[3]); } } }
        } else if (pn < 48) {
            const int c0 = (pn - 40) * 256 + cw;
#pragma unroll
            for (int ai = 0; ai < 2; ++ai)
#pragma unroll
                for (int m = 0; m < 4; ++m) { const int row = row0 + ai * 128 + m * 16;
#pragma unroll
                    for (int bj = 0; bj < 2; ++bj) { f32x4 a = acc[ai][bj][m][0], b = acc[ai][bj][m][1];
                        for (int i = 0; i < 4; ++i) { a[i] = fast_sigmoid(a[i]); b[i] = fast_sigmoid(b[i]); }
                        *(u32x4*)(sma + (size_t)row * D + c0 + bj * 128) = pack8(a, b); } }
        } else {
            if (cw < 48) {
#pragma unroll
                for (int ai = 0; ai < 2; ++ai)
#pragma unroll
                    for (int m = 0; m < 4; ++m) { const int row = row0 + ai * 128 + m * 16; f32x4 a = acc[ai][0][m][0], b = acc[ai][0][m][1];
                        for (int i = 0; i < 4; ++i) { a[i] = fast_sigmoid(a[i]); b[i] = fast_sigmoid(b[i]); }
                        *(f32x4*)(gates + (size_t)row * 48 + cw) = a; *(f32x4*)(gates + (size_t)row * 48 + cw + 4) = b; }
            }
        }
    }
};

struct Args {
    const float* in[22]; float* out; unsigned char* ws; int ph_lo, ph_hi, G, pad;
};

struct Ctx { int tid, lane, wave, gw, NGW, gtid, NT; LAS unsigned char* lds; };

__device__ __forceinline__ void tr_item(const float* W, int ldw, int k0, int nsrc0, bf16_t* WT, int ldt, int drow0, LAS float* scr, int lane) {
#pragma unroll 8
    for (int i = 0; i < 32; ++i) { const int kk = 2 * i + (lane >> 5); scr[kk * 33 + (lane & 31)] = W[(size_t)(k0 + kk) * ldw + nsrc0 + (lane & 31)]; }
    asm volatile("s_waitcnt lgkmcnt(0)" ::: "memory");
    const int c = lane & 7;
#pragma unroll
    for (int j = 0; j < 4; ++j) { const int n = (lane >> 3) + 8 * j; const LAS float* s = scr + (8 * c) * 33 + n;
        u32x4 o; o.x = cvt_pk_bf16(s[0 * 33], s[1 * 33]); o.y = cvt_pk_bf16(s[2 * 33], s[3 * 33]); o.z = cvt_pk_bf16(s[4 * 33], s[5 * 33]); o.w = cvt_pk_bf16(s[6 * 33], s[7 * 33]);
        *(u32x4*)(WT + (size_t)(drow0 + n) * ldt + k0 + 8 * c) = o; }
    asm volatile("s_waitcnt lgkmcnt(0)" ::: "memory");
}
__device__ __forceinline__ void tr_job(const Ctx& C, const float* W, int K, int ldw, int ncol0, int ncols, bf16_t* WT, int ldt, int drow0, int grp, int grp_stride) {
    LAS float* scr = (LAS float*)(C.lds + C.wave * 16384);
    const int nblk = ncols / 32, items = (K / 64) * nblk;
    for (int it = C.gw; it < items; it += C.NGW) {
        const int kb = it / nblk, n = (it % nblk) * 32; const int drow = drow0 + (n / grp) * grp_stride + (n % grp);
        tr_item(W, ldw, kb * 64, ncol0 + n, WT, ldt, drow, scr, C.lane);
    }
}
__device__ __forceinline__ void cvt_job(const Ctx& C, const float* X, bf16_t* O, size_t n8) {
    for (size_t i = C.gtid; i < n8; i += C.NT) { const f32x4 a = *(const f32x4*)(X + i * 8), b = *(const f32x4*)(X + i * 8 + 4); *(u32x4*)(O + i * 8) = pack8(a, b); }
}

template <bool OUT_BF16>
__device__ __forceinline__ void ln_rows(const Ctx& C, const float* P, const float* gam, const float* bet, void* outp) {
    for (int r = C.gw; r < T; r += C.NGW) {
        const f32x4* xr = (const f32x4*)(P + (size_t)r * D) + C.lane;
        f32x4 v[8]; float s = 0.f;
#pragma unroll
        for (int j = 0; j < 8; ++j) { v[j] = xr[64 * j]; s += (v[j][0] + v[j][1]) + (v[j][2] + v[j][3]); }
#pragma unroll
        for (int o = 1; o < 64; o <<= 1) s += __shfl_xor(s, o);
        const float mean = s * (1.f / D); float s2 = 0.f;
#pragma unroll
        for (int j = 0; j < 8; ++j) { v[j] = v[j] - mean; s2 += (v[j][0] * v[j][0] + v[j][1] * v[j][1]) + (v[j][2] * v[j][2] + v[j][3] * v[j][3]); }
#pragma unroll
        for (int o = 1; o < 64; o <<= 1) s2 += __shfl_xor(s2, o);
        const float rstd = 1.f / sqrtf(s2 * (1.f / D) + LN_EPS);
#pragma unroll
        for (int j = 0; j < 8; ++j) {
            const f32x4 gg = *((const f32x4*)gam + C.lane + 64 * j), bb = *((const f32x4*)bet + C.lane + 64 * j);
            const f32x4 y = v[j] * rstd * gg + bb;
            if (OUT_BF16) { u32x2 w; w.x = cvt_pk_bf16(y[0], y[1]); w.y = cvt_pk_bf16(y[2], y[3]); *((u32x2*)((bf16_t*)outp + (size_t)r * D) + C.lane + 64 * j) = w; }
            else *((f32x4*)((float*)outp + (size_t)r * D) + C.lane + 64 * j) = y;
        }
    }
}

constexpr float SC_LOG2E = 0.08838834764831845f * 1.4426950408889634f;
__device__ __forceinline__ int rel_bucket(int n) {
    const int e = 31 - __builtin_clz((unsigned)(n | 1));
    const int odd = ((unsigned)n * (unsigned)n >= (1u << (2 * e + 1))) ? 1 : 0;
    const int lg = min(31, 8 + 2 * e + odd);
    return n < 16 ? n : lg;
}
template <int MODE>
__device__ __forceinline__ void att_step(const bf16_t* __restrict__ Kp, const bf16_t* __restrict__ VTp, int ldv, int key0, int tq, bool colok,
                                         const bf16x8 (&qf)[4], float& m, float& lsum, f32x4 (&O)[8], float inv_l,
                                         const LAS float* tab, int hd16, LAS float* impq, int g, int fr) {
    bf16x8 ka[4], kb[4], vf[8];
    {
        const bf16_t* kq = Kp + ((size_t)(key0 >> 5) << 12) + fr * 32 + 8 * g;
#pragma unroll
        for (int dc = 0; dc < 4; ++dc) { ka[dc] = *(const bf16x8*)(kq + dc * 512); kb[dc] = *(const bf16x8*)(kq + 2048 + dc * 512); }
        if (MODE != 0) { const bf16_t* vq = VTp + ((size_t)(key0 >> 5) << 12) + fr * 32 + 8 * g;
#pragma unroll
            for (int dt = 0; dt < 8; ++dt) vf[dt] = *(const bf16x8*)(vq + dt * 512); }
    }
    f32x4 sa = {0.f, 0.f, 0.f, 0.f}, sb = {0.f, 0.f, 0.f, 0.f};
#pragma unroll
    for (int dc = 0; dc < 4; ++dc) { sa = __builtin_amdgcn_mfma_f32_16x16x32_bf16(ka[dc], qf[dc], sa, 0, 0, 0); sb = __builtin_amdgcn_mfma_f32_16x16x32_bf16(kb[dc], qf[dc], sb, 0, 0, 0); }
    float s[8]; bool ok[8];
#pragma unroll
    for (int e = 0; e < 8; ++e) {
        const int idx = key0 + 8 * g + e;
        const int dist = (MODE < 2) ? (tq - 31 - 16 * idx) : (tq - idx);
        ok[e] = (MODE < 2) ? (dist >= 0) : (MODE == 2 ? (dist >= 0 && dist < 512) : (dist >= 0 && colok));
        const int bk = rel_bucket(max(dist, 0));
        const float sv = (e < 4 ? sa[e & 3] : sb[e & 3]) * SC_LOG2E + tab[bk * 16 + hd16];
        s[e] = ok[e] ? sv : -1e30f;
    }
    float p[8];
    if (MODE != 1) {
        float mx = fmaxf(fmaxf(fmaxf(s[0], s[1]), fmaxf(s[2], s[3])), fmaxf(fmaxf(s[4], s[5]), fmaxf(s[6], s[7])));
        mx = fmaxf(mx, __shfl_xor(mx, 16)); mx = fmaxf(mx, __shfl_xor(mx, 32));
        const float mn = fmaxf(m, mx); const float alpha = __builtin_amdgcn_exp2f(m - mn); m = mn;
        float ps = 0.f;
#pragma unroll
        for (int e = 0; e < 8; ++e) { p[e] = ok[e] ? __builtin_amdgcn_exp2f(s[e] - mn) : 0.f; ps += p[e]; }
        lsum = lsum * alpha + ps;
        if (MODE != 0) {
#pragma unroll
            for (int dt = 0; dt < 8; ++dt) O[dt] = O[dt] * alpha;
        }
    } else {
#pragma unroll
        for (int e = 0; e < 8; ++e) p[e] = ok[e] ? __builtin_amdgcn_exp2f(s[e] - m) * inv_l : 0.f;
        const int G2 = (key0 >> 2) + 2 * g;
        atomicAdd((float*)(impq + G2), (p[0] + p[1]) + (p[2] + p[3]));
        atomicAdd((float*)(impq + G2 + 1), (p[3] + p[4]) + (p[5] + p[6]) + p[7]);
        atomicAdd((float*)(impq + G2 + 2), p[7]);
    }
    if (MODE != 0) {
        u32x4 pw; pw.x = cvt_pk_bf16(p[0], p[1]); pw.y = cvt_pk_bf16(p[2], p[3]); pw.z = cvt_pk_bf16(p[4], p[5]); pw.w = cvt_pk_bf16(p[6], p[7]);
        const bf16x8 pf = __builtin_bit_cast(bf16x8, pw);
#pragma unroll
        for (int dt = 0; dt < 8; ++dt) O[dt] = __builtin_amdgcn_mfma_f32_16x16x32_bf16(vf[dt], pf, O[dt], 0, 0, 0);
    }
}

struct Frag8 { long ka[4], kb[4], vf[8]; };
__device__ __forceinline__ void load_frag8(Frag8& F, const unsigned char* __restrict__ K8, const unsigned char* __restrict__ V8T, int key0, int g, int fr) {
    const unsigned char* kq = K8 + ((size_t)(key0 >> 5) << 12) + fr * 32 + 8 * g;
#pragma unroll
    for (int dc = 0; dc < 4; ++dc) { F.ka[dc] = *(const long*)(kq + dc * 512); F.kb[dc] = *(const long*)(kq + 2048 + dc * 512); }
    const unsigned char* vq = V8T + ((size_t)(key0 >> 5) << 12) + fr * 32 + 8 * g;
#pragma unroll
    for (int dt = 0; dt < 8; ++dt) F.vf[dt] = *(const long*)(vq + dt * 512);
}
__device__ __forceinline__ void compute_fp8(const Frag8& F, int key0, int tq, bool colok, const long (&q8)[4], float& m, float& lsum, f32x4 (&O)[8], const LAS float* tab, int hd16, int g) {
    f32x4 sa = {0.f, 0.f, 0.f, 0.f}, sb = {0.f, 0.f, 0.f, 0.f};
#pragma unroll
    for (int dc = 0; dc < 4; ++dc) { sa = __builtin_amdgcn_mfma_f32_16x16x32_fp8_fp8(F.ka[dc], q8[dc], sa, 0, 0, 0); sb = __builtin_amdgcn_mfma_f32_16x16x32_fp8_fp8(F.kb[dc], q8[dc], sb, 0, 0, 0); }
    float s[8]; bool ok[8];
#pragma unroll
    for (int e = 0; e < 8; ++e) {
        const int dist = tq - (key0 + 8 * g + e);
        ok[e] = dist >= 0 && colok;
        const int bk = rel_bucket(max(dist, 0));
        const float sv = (e < 4 ? sa[e & 3] : sb[e & 3]) * SC_LOG2E + tab[bk * 16 + hd16];
        s[e] = ok[e] ? sv : -1e30f;
    }
    float mx = fmaxf(fmaxf(fmaxf(s[0], s[1]), fmaxf(s[2], s[3])), fmaxf(fmaxf(s[4], s[5]), fmaxf(s[6], s[7])));
    mx = fmaxf(mx, __shfl_xor(mx, 16)); mx = fmaxf(mx, __shfl_xor(mx, 32));
    const float mn = fmaxf(m, mx); const float alpha = __builtin_amdgcn_exp2f(m - mn);
    const bool grew = __builtin_amdgcn_ballot_w64(mn > m) != 0ull; m = mn;
    float p[8]; float ps = 0.f;
#pragma unroll
    for (int e = 0; e < 8; ++e) { p[e] = ok[e] ? __builtin_amdgcn_exp2f(s[e] - mn) : 0.f; ps += p[e]; }
    lsum = lsum * alpha + ps;
    if (grew) {
#pragma unroll
        for (int dt = 0; dt < 8; ++dt) O[dt] = O[dt] * alpha;
    }
    const long pf = pack8_fp8(p[0] * 256.f, p[1] * 256.f, p[2] * 256.f, p[3] * 256.f, p[4] * 256.f, p[5] * 256.f, p[6] * 256.f, p[7] * 256.f);
#pragma unroll
    for (int dt = 0; dt < 8; ++dt) O[dt] = __builtin_amdgcn_mfma_f32_16x16x32_fp8_fp8(F.vf[dt], pf, O[dt], 0, 0, 0);
}

constexpr int IMP_STRIDE = 264;
__device__ __forceinline__ void attention_phase(const Ctx& C, bf16_t* qo, const bf16_t* kc, const bf16_t* vcT, const bf16_t* ks, const bf16_t* vsT,
                                                const bf16_t* kw, const bf16_t* vwT, const float* gates, const float* rel_bias, const unsigned char* ks8, const unsigned char* vs8) {
    LAS float* tab = (LAS float*)C.lds;
    LAS float* imp = (LAS float*)(C.lds + 4096 + C.wave * 8192);
    LAS int* lst = (LAS int*)(C.lds + 4096 + C.wave * 8192 + 4 * IMP_STRIDE * 4);
    for (int i = C.tid; i < 512; i += NWAVES * 64) tab[i] = rel_bias[i] * 1.4426950408889634f;
    __syncthreads();
    const int lane = C.lane, fr = lane & 15, g = lane >> 4, qi = fr >> 2, hd = fr & 3;
    const int hk = (int)(blockIdx.x & 3), wl = (int)(blockIdx.x >> 2) * NWAVES + C.wave, nwl = C.NGW >> 2;
    for (int qg = wl; qg < T / 4; qg += nwl) {
        const int t0 = qg * 4, tq = t0 + qi, head = hk * 4 + hd, jt = t0 >> 6;
        bf16x8 qf[4];
        { const bf16_t* qp = qo + (size_t)tq * D + head * HD + 8 * g;
#pragma unroll
          for (int dc = 0; dc < 4; ++dc) qf[dc] = *(const bf16x8*)(qp + dc * 32); }
        const float g0 = gates[(size_t)tq * 48 + head * 3 + 0], g1 = gates[(size_t)tq * 48 + head * 3 + 1], g2 = gates[(size_t)tq * 48 + head * 3 + 2];
        f32x4 OA[8];
#pragma unroll
        for (int dt = 0; dt < 8; ++dt) OA[dt] = (f32x4){0.f, 0.f, 0.f, 0.f};
        f32x4 O[8];
        for (int i = lane; i < 4 * IMP_STRIDE; i += 64) imp[i] = 0.f;
        __builtin_amdgcn_wave_barrier(); asm volatile("s_waitcnt lgkmcnt(0)" ::: "memory");
        const bf16_t* Kc = kc + (size_t)hk * NCMP * HD; const bf16_t* Vc = vcT + (size_t)hk * HD * NCMP;
        const int ncv = (t0 + 3 >= 31) ? ((t0 + 3 - 31) >> 4) + 1 : 0;
        const int nst = (ncv + 31) >> 5;
        {
            float m = -1e30f, lsum = 0.f;
            for (int st = 0; st < nst; ++st) att_step<0>(Kc, Vc, NCMP, st * 32, tq, true, qf, m, lsum, O, 0.f, tab, hd + 0 * 16 + (hk * 4), imp + qi * IMP_STRIDE, g, fr);
            float l = lsum; l += __shfl_xor(l, 16); l += __shfl_xor(l, 32);
            const float inv = l > 0.f ? 1.f / l : 0.f;
#pragma unroll
            for (int dt = 0; dt < 8; ++dt) O[dt] = (f32x4){0.f, 0.f, 0.f, 0.f};
            for (int st = 0; st < nst; ++st) att_step<1>(Kc, Vc, NCMP, st * 32, tq, true, qf, m, lsum, O, inv, tab, hd + hk * 4, imp + qi * IMP_STRIDE, g, fr);
#pragma unroll
            for (int dt = 0; dt < 8; ++dt) OA[dt] = OA[dt] + O[dt] * g0;
        }
        __builtin_amdgcn_wave_barrier(); asm volatile("s_waitcnt lgkmcnt(0)" ::: "memory");
        int nlist = 0;
        const int ncand = jt - 2;
        if (ncand <= 13) {
            if (lane <= jt) lst[lane] = lane | (0xF << 16);
            nlist = jt + 1;
        } else {
            if (lane == 0) { lst[0] = 0 | (0xF << 16); lst[1] = (jt - 1) | (0xF << 16); lst[2] = jt | (0xF << 16); }
            nlist = 3;
            for (int qq = 0; qq < 4; ++qq) {
                float v[4];
#pragma unroll
                for (int k = 0; k < 4; ++k) { const int sblk = 4 * lane + k; const float x = imp[qq * IMP_STRIDE + sblk]; v[k] = (sblk >= 1 && sblk <= jt - 2) ? x : -1.f; }
                for (int r = 0; r < 13; ++r) {
                    float lm = fmaxf(fmaxf(v[0], v[1]), fmaxf(v[2], v[3]));
                    float wm = lm;
#pragma unroll
                    for (int o = 1; o < 64; o <<= 1) wm = fmaxf(wm, __shfl_xor(wm, o));
                    const unsigned long long bal = __ballot(lm == wm);
                    const int src = __ffsll((long long)bal) - 1;
                    if (lane == src) {
                        int k = (v[0] == wm) ? 0 : (v[1] == wm) ? 1 : (v[2] == wm) ? 2 : 3;
                        if (k == 0) v[0] = -2.f; else if (k == 1) v[1] = -2.f; else if (k == 2) v[2] = -2.f; else v[3] = -2.f;
                        lst[nlist + r] = (4 * lane + k) | ((1 << qq) << 16);
                    }
                }
                nlist += 13;
            }
        }
        __builtin_amdgcn_wave_barrier(); asm volatile("s_waitcnt lgkmcnt(0)" ::: "memory");
        {
            const unsigned char* Ks8 = ks8 + (size_t)hk * T * HD; const unsigned char* Vs8 = vs8 + (size_t)hk * T * HD;
            long q8[4];
#pragma unroll
            for (int dc = 0; dc < 4; ++dc) { const u32x4 w = __builtin_bit_cast(u32x4, qf[dc]); q8[dc] = pack8_fp8(bf_lo(w[0]), bf_hi(w[0]), bf_lo(w[1]), bf_hi(w[1]), bf_lo(w[2]), bf_hi(w[2]), bf_lo(w[3]), bf_hi(w[3])); }
            float m = -1e30f, lsum = 0.f;
#pragma unroll
            for (int dt = 0; dt < 8; ++dt) O[dt] = (f32x4){0.f, 0.f, 0.f, 0.f};
            Frag8 FA, FB;
            int ent = __builtin_amdgcn_readfirstlane(lst[0]);
            load_frag8(FA, Ks8, Vs8, (ent & 0xffff) * 64, g, fr);
            for (int i = 0; i < nlist; ++i) {
                const int blk = ent & 0xffff; const bool colok = ((ent >> (16 + qi)) & 1) != 0;
                load_frag8(FB, Ks8, Vs8, blk * 64 + 32, g, fr);
                compute_fp8(FA, blk * 64, tq, colok, q8, m, lsum, O, tab, hd + hk * 4, g);
                const int nent = __builtin_amdgcn_readfirstlane(lst[(i + 1 < nlist) ? i + 1 : i]);
                load_frag8(FA, Ks8, Vs8, (nent & 0xffff) * 64, g, fr);
                compute_fp8(FB, blk * 64 + 32, tq, colok, q8, m, lsum, O, tab, hd + hk * 4, g);
                ent = nent;
            }
            float l = lsum; l += __shfl_xor(l, 16); l += __shfl_xor(l, 32);
            const float sc = (l > 0.f ? 1.f / l : 0.f) * g1 * (1.f / 256.f);
#pragma unroll
            for (int dt = 0; dt < 8; ++dt) OA[dt] = OA[dt] + O[dt] * sc;
        }
        {
            const bf16_t* Kw = kw + (size_t)hk * T * HD; const bf16_t* Vw = vwT + (size_t)hk * HD * T;
            float m = -1e30f, lsum = 0.f;
#pragma unroll
            for (int dt = 0; dt < 8; ++dt) O[dt] = (f32x4){0.f, 0.f, 0.f, 0.f};
            const int kstart = max(0, t0 - 511) & ~31;
            for (int k0 = kstart; k0 <= t0 + 3; k0 += 32) att_step<2>(Kw, Vw, T, k0, tq, true, qf, m, lsum, O, 0.f, tab, hd + hk * 4, imp, g, fr);
            float l = lsum; l += __shfl_xor(l, 16); l += __shfl_xor(l, 32);
            const float sc = (l > 0.f ? 1.f / l : 0.f) * g2;
#pragma unroll
            for (int dt = 0; dt < 8; ++dt) OA[dt] = OA[dt] + O[dt] * sc;
        }
        { bf16_t* op = qo + (size_t)tq * D + head * HD + 4 * g;
#pragma unroll
          for (int dt = 0; dt < 8; ++dt) { u32x2 w; w.x = cvt_pk_bf16(OA[dt][0], OA[dt][1]); w.y = cvt_pk_bf16(OA[dt][2], OA[dt][3]); *(u32x2*)(op + dt * 16) = w; } }
        __builtin_amdgcn_wave_barrier(); asm volatile("s_waitcnt lgkmcnt(0)" ::: "memory");
    }
}

__global__ void __launch_bounds__(NWAVES * 64, 2) fwd_megakernel(Args args) {
    extern __shared__ __attribute__((aligned(16))) unsigned char lds_raw[];
    __builtin_assume(__builtin_amdgcn_workitem_id_y() == 0); __builtin_assume(__builtin_amdgcn_workitem_id_z() == 0);
    cg::grid_group grid = cg::this_grid();
    Ctx C; C.lds = (LAS unsigned char*)lds_raw; C.tid = threadIdx.x; C.lane = C.tid & 63; C.wave = __builtin_amdgcn_readfirstlane(C.tid >> 6);
    const int G = args.G, bx = blockIdx.x;
    C.gw = bx * NWAVES + C.wave; C.NGW = G * NWAVES; C.gtid = bx * (NWAVES * 64) + C.tid; C.NT = G * NWAVES * 64;
    unsigned char* ws = args.ws;
#define x_in (args.in[0])
#define pin (args.in[1])
#define w_in (args.in[2])
#define conv_w (args.in[3])
#define pe_k (args.in[4])
#define w1_k (args.in[5])
#define w2_k (args.in[6])
#define pe_v (args.in[7])
#define w1_v (args.in[8])
#define w2_v (args.in[9])
#define w_conv_out (args.in[10])
#define w_attn_out (args.in[11])
#define w_mix_out (args.in[12])
#define ln1_g (args.in[13])
#define ln1_b (args.in[14])
#define w_up (args.in[15])
#define w_down (args.in[16])
#define w_ple (args.in[17])
#define w_ple_gate (args.in[18])
#define ln2_g (args.in[19])
#define ln2_b (args.in[20])
#define rel_bias (args.in[21])
#define BP(off) ((bf16_t*)(ws + (off)))
#define FP(off) ((float*)(ws + (off)))
#define XB BP(WS_XB)
#define WTIN BP(WS_WTIN)
#define WTVT BP(WS_WTVT)
#define WTMB BP(WS_WTMB)
#define W1K BP(WS_W1K)
#define W1V BP(WS_W1V)
#define BIASK FP(WS_BIASK)
#define BIASV FP(WS_BIASV)
#define HIDK BP(WS_HIDK)
#define HIDV BP(WS_HIDV)
#define KC BP(WS_KC)
#define VCT BP(WS_VCT)
#define GATES FP(WS_GATES)
#define BG BP(WS_BG)
#define ZZ BP(WS_ZZ)
#define Q BP(WS_Q)
#define KCS BP(WS_KCS)
#define VCS BP(WS_VCS)
#define KS BP(WS_KS)
#define KW BP(WS_KW)
#define VST BP(WS_VST)
#define VWT BP(WS_VWT)
#define SMA BP(WS_SMA)
#define SMB BP(WS_SMB)
#define WTCONV BP(WS_WTCONV)
#define WTATTN BP(WS_WTATTN)
#define WTMIX BP(WS_WTMIX)
#define WTGATE BP(WS_WTGATE)
#define WTPLE BP(WS_WTPLE)
#define PB BP(WS_PB)
#define WTUP BP(WS_WTUP)
#define WTDOWN BP(WS_WTDOWN)
#define PRE1 FP(WS_PRE1)
#define PRE2 FP(WS_PRE2)
#define X1B BP(WS_X1B)
#define H1 BP(WS_H1)
    const int lo = args.ph_lo, hi = args.ph_hi;
    unsigned* gbar = (unsigned*)(ws + 16384); int nbar = 0;
    if (lo == 12345) grid.sync();
#ifndef PHMASK
#define PHMASK 0xFFFF
#endif
#define IN(k) (((PHMASK >> (k)) & 1) && lo <= (k) && (k) < hi)
#define SEAM(k) do { if (IN(k) && IN((k) + 1)) { ++nbar; \
        asm volatile("s_waitcnt vmcnt(0) lgkmcnt(0)" ::: "memory"); __syncthreads(); \
        if (C.tid == 0) { __builtin_amdgcn_fence(__ATOMIC_RELEASE, "agent"); asm volatile("s_waitcnt vmcnt(0)" ::: "memory"); \
            __hip_atomic_fetch_add(gbar, 1u, __ATOMIC_RELAXED, __HIP_MEMORY_SCOPE_AGENT); \
            while (__hip_atomic_load(gbar, __ATOMIC_RELAXED, __HIP_MEMORY_SCOPE_AGENT) < (unsigned)(nbar * G)) __builtin_amdgcn_s_sleep(2); \
            __builtin_amdgcn_fence(__ATOMIC_ACQUIRE, "agent"); asm volatile("s_waitcnt vmcnt(0)" ::: "memory"); } \
        __syncthreads(); \
        __builtin_amdgcn_fence(__ATOMIC_ACQUIRE, "agent"); asm volatile("s_waitcnt vmcnt(0)" ::: "memory"); } } while (0)

    if (IN(0)) {
        cvt_job(C, x_in, XB, (size_t)T * D / 8);
        tr_job(C, w_in, D, NIN, 2048, 2048, WTIN, D, 0, 128, 256);
        tr_job(C, w_in, D, NIN, 4096, 2048, WTIN, D, 128, 128, 256);
        tr_job(C, w_in, D, NIN, 0, 2048, WTIN, D, 4096, 2048, 0);
        tr_job(C, w_in, D, NIN, 6144, 2048, WTIN, D, 6144, 2048, 0);
        tr_job(C, w_in, D, NIN, 8192, 512, WTIN, D, 8192, 512, 0);
        tr_job(C, w_in, D, NIN, 8704, 512, WTIN, D, 8704, 512, 0);
        tr_job(C, w_in, D, NIN, 9216, 512, WTIN, D, 9216, 512, 0);
        tr_job(C, w_in, D, NIN, 10240, 512, WTIN, D, 9728, 512, 0);
        tr_job(C, w_in, D, NIN, 11312, 2048, WTIN, D, 10240, 2048, 0);
        tr_job(C, w_in, D, NIN, 9728, 512, WTVT, D, 0, 512, 0);
        tr_job(C, w_in, D, NIN, 10752, 512, WTVT, D, 512, 512, 0);
        tr_job(C, w_in, D, NIN, 13360, 2048, WTMB, D, 0, 2048, 0);
        tr_job(C, w1_k, 4096, 256, 0, 256, W1K, 4096, 0, 256, 0);
        tr_job(C, w1_v, 4096, 256, 0, 256, W1V, 4096, 0, 256, 0);
        for (int i = C.gtid; i < 256 * D; i += C.NT) { const int r = i / D, k = i % D; const float v = (r < 48) ? w_in[(size_t)k * NIN + 11264 + r] : 0.f; WTIN[(size_t)(12288 + r) * D + k] = (bf16_t)(cvt_pk_bf16(v, 0.f) & 0xffff); }
        if (bx == G - 1) {
            const int n = C.tid & 255; const float* pe = (C.tid < 256) ? pe_k : pe_v; const float* w1 = (C.tid < 256) ? w1_k : w1_v; float s = 0.f;
            for (int j = 0; j < 4096; ++j) s += pe[j] * w1[(size_t)j * 256 + n];
            ((C.tid < 256) ? BIASK : BIASV)[n] = s;
        }
        asm volatile("s_waitcnt vmcnt(0) lgkmcnt(0)" ::: "memory"); __syncthreads();
    }
    SEAM(0);
    if (IN(1)) {
        { pg8::Gemm g{XB, WTIN, T, 12544, D, D, D}; pg8::StaticOrder S; S.init(T, 12544, G, bx);
          EpiInProj E{ZZ, BG, Q, KCS, SMA, GATES, ws + 492 * MiB};
          pg8::gemm_phase(C.lds, g, S, E); }
        { pg8::Gemm g{WTVT, XB, 1024, T, D, D, D}; pg8::StaticOrder S; S.init(1024, T, G, (bx + 64) % G);
          pg8::EpiGen<FStoreVT> E{{VST, ws + 500 * MiB}};
          pg8::gemm_phase(C.lds, g, S, E); }
    }
    SEAM(1);
    if (IN(2)) {
        if (bx < 32) {
            { pg8::Gemm g{KCS, W1K, 4096, 256, 4096, 2048, 4096}; pg8::StaticOrder S; S.init(4096, 256, G, bx < 16 ? bx : -1); S.G = 16;
              pg8::EpiGen<FGeluBias> E{{HIDK, 256, BIASK}}; pg8::gemm_phase(C.lds, g, S, E); }
            { pg8::Gemm g{VCS, W1V, 4096, 256, 4096, 2048, 4096}; pg8::StaticOrder S; S.init(4096, 256, G, (bx >= 16 && bx < 32) ? bx - 16 : -1); S.G = 16;
              pg8::EpiGen<FGeluBias> E{{HIDV, 256, BIASV}}; pg8::gemm_phase(C.lds, g, S, E); }
        } else
        for (size_t i = (size_t)(bx - 32) * (NWAVES * 64) + C.tid; i < (size_t)T * D / 8; i += (size_t)(G - 32) * (NWAVES * 64)) {
            const int t = (int)(i / (D / 8)), c8 = (int)(i % (D / 8)) * 8;
            f32x4 z0a, z0b, z1a = {0.f, 0.f, 0.f, 0.f}, z1b = z1a, z2a = z1a, z2b = z1a, ba, bb;
            unpack8(*(const u32x4*)(ZZ + (size_t)t * D + c8), z0a, z0b);
            if (t >= 1) unpack8(*(const u32x4*)(ZZ + (size_t)(t - 1) * D + c8), z1a, z1b);
            if (t >= 2) unpack8(*(const u32x4*)(ZZ + (size_t)(t - 2) * D + c8), z2a, z2b);
            unpack8(*(const u32x4*)(BG + (size_t)t * D + c8), ba, bb);
            const f32x4 w0a = *(const f32x4*)(conv_w + c8), w0b = *(const f32x4*)(conv_w + c8 + 4);
            const f32x4 w1a = *(const f32x4*)(conv_w + D + c8), w1b = *(const f32x4*)(conv_w + D + c8 + 4);
            const f32x4 w2a = *(const f32x4*)(conv_w + 2 * D + c8), w2b = *(const f32x4*)(conv_w + 2 * D + c8 + 4);
            const f32x4 ua = ba * (w0a * z2a + w1a * z1a + w2a * z0a), ub = bb * (w0b * z2b + w1b * z1b + w2b * z0b);
            *(u32x4*)(BG + (size_t)t * D + c8) = pack8(ua, ub);
        }
    }
    SEAM(2);
    if (IN(3)) {
        { pg8::Gemm g{XB, WTMB, T, D, D, D, D}; pg8::StaticOrder S; S.init(T, D, G, bx);
          pg8::EpiGen<FStoreBf16> E{{SMB, D, 1}}; pg8::gemm_phase(C.lds, g, S, E); }
    }
    SEAM(3);
    if (IN(4)) {
        for (int i = C.gtid; i < 4096 * HD; i += C.NT) {
            const int d = i & 127, row = i >> 7; const bf16_t* hp = HIDK + (size_t)row * 256; float s = 0.f;
            for (int j = 0; j < 256; j += 2) { const unsigned w = *(const unsigned*)(hp + j); s += bf_lo(w) * w2_k[(size_t)j * HD + d] + bf_hi(w) * w2_k[(size_t)(j + 1) * HD + d]; }
            { const int h = row >> 10, c = row & 1023; KC[(size_t)h * 131072 + ((size_t)(c >> 5) << 12) + ((c >> 2) & 1) * 2048 + (d >> 5) * 512 + (4 * ((c & 31) >> 3) + (c & 3)) * 32 + (d & 31)] = (bf16_t)(cvt_pk_bf16(s, 0.f) & 0xffff); }
        }
        for (int i = C.gtid; i < 4096 * HD; i += C.NT) {
            const int ii = i & 1023, d = (i >> 10) & 127, h = i >> 17; const bf16_t* hp = HIDV + (size_t)(h * 1024 + ii) * 256; float s = 0.f;
            for (int j = 0; j < 256; j += 2) { const unsigned w = *(const unsigned*)(hp + j); s += bf_lo(w) * w2_v[(size_t)j * HD + d] + bf_hi(w) * w2_v[(size_t)(j + 1) * HD + d]; }
            VCT[(size_t)h * 131072 + ((size_t)(ii >> 5) << 12) + (d >> 4) * 512 + (d & 15) * 32 + (ii & 31)] = (bf16_t)(cvt_pk_bf16(s, 0.f) & 0xffff);
        }
        tr_job(C, w_conv_out, D, D, 0, D, WTCONV, D, 0, D, 0);
        tr_job(C, w_attn_out, D, D, 0, D, WTATTN, D, 0, D, 0);
        tr_job(C, w_mix_out, D, D, 0, D, WTMIX, D, 0, D, 0);
        tr_job(C, w_ple_gate, D, D, 0, D, WTGATE, D, 0, D, 0);
        tr_job(C, w_ple, PLE, D, 0, D, WTPLE, PLE, 0, D, 0);
        tr_job(C, w_up, D, FF, 0, FF, WTUP, D, 0, FF, 0);
        tr_job(C, w_down, FF, D, 0, D, WTDOWN, FF, 0, D, 0);
        cvt_job(C, pin, PB, (size_t)T * PLE / 8);
        asm volatile("s_waitcnt vmcnt(0) lgkmcnt(0)" ::: "memory"); __syncthreads();
    }
    SEAM(4);
    if (IN(5)) {
        attention_phase(C, Q, KC, VCT, KS, VST, KW, VWT, GATES, rel_bias, ws + 492 * MiB, ws + 500 * MiB);
        asm volatile("s_waitcnt vmcnt(0) lgkmcnt(0)" ::: "memory"); __syncthreads();
    }
    SEAM(5);
    if (IN(6)) {
        { pg8::Gemm g{BG, WTCONV, T, D, D, D, D}; pg8::StaticOrder S; S.init(T, D, G, bx); pg8::EpiGen<FMulInplace> E{{SMA, D}}; pg8::gemm_phase(C.lds, g, S, E); }
        { pg8::Gemm g{Q, WTATTN, T, D, D, D, D}; pg8::StaticOrder S; S.init(T, D, G, bx); pg8::EpiGen<FMulAddInplace> E{{SMB, SMA, D}}; pg8::gemm_phase(C.lds, g, S, E); }
    }
    SEAM(7);
    if (IN(8)) { pg8::Gemm g{SMB, WTMIX, T, D, D, D, D}; pg8::StaticOrder S; S.init(T, D, G, bx); pg8::EpiGen<FResidF32> E{{PRE1, x_in, D}}; pg8::gemm_phase(C.lds, g, S, E); }
    SEAM(8);
    if (IN(9)) ln_rows<true>(C, PRE1, ln1_g, ln1_b, X1B);
    SEAM(9);
    if (IN(10)) {
        { pg8::Gemm g{X1B, WTGATE, T, D, D, D, D}; pg8::StaticOrder S; S.init(T, D, G, bx); pg8::EpiGen<FSigmoidF32> E{{PRE2, D}}; pg8::gemm_phase(C.lds, g, S, E); }
        { pg8::Gemm g{X1B, WTUP, T / 2, FF, D, D, D}; pg8::StaticOrder S; S.init(T / 2, FF, G, bx); pg8::EpiGen<FStoreBf16> E{{H1, FF, 2}}; pg8::gemm_phase(C.lds, g, S, E); }
        { pg8::Gemm g{PB, WTPLE, T, D, PLE, PLE, PLE}; pg8::StaticOrder S; S.init(T, D, G, bx); pg8::EpiGen<FPle> E{{PRE2, X1B, D}}; pg8::gemm_phase(C.lds, g, S, E); }
    }
    SEAM(10);
    if (IN(12)) { pg8::Gemm g{H1, WTDOWN, T / 2, D, FF, FF, FF}; pg8::StaticOrder S; S.init(T / 2, D, G, bx); pg8::EpiGen<FAccF32> E{{PRE2, D}}; pg8::gemm_phase(C.lds, g, S, E); }
    SEAM(12);
    if (IN(13)) { pg8::Gemm g{X1B + (size_t)(T / 2) * D, WTUP, T / 2, FF, D, D, D}; pg8::StaticOrder S; S.init(T / 2, FF, G, bx); pg8::EpiGen<FStoreBf16> E{{H1, FF, 2}}; pg8::gemm_phase(C.lds, g, S, E); }
    SEAM(13);
    if (IN(14)) { pg8::Gemm g{H1, WTDOWN, T / 2, D, FF, FF, FF}; pg8::StaticOrder S; S.init(T / 2, D, G, bx); pg8::EpiGen<FAccF32> E{{PRE2 + (size_t)(T / 2) * D, D}}; pg8::gemm_phase(C.lds, g, S, E); }
    SEAM(14);
    if (IN(15)) ln_rows<false>(C, PRE2, ln2_g, ln2_b, args.out);
#undef IN
#undef SEAM
}

extern "C" void kernel_launch(void* const* d_in, const int* in_sizes, int n_in, void* d_out, int out_size, void* d_ws, size_t ws_size, hipStream_t stream) {
    static int grid = 0;
    if (grid == 0) {
        if (n_in != 22 || ws_size < 508 * MiB) { fprintf(stderr, "kernel_launch: need 22 inputs and >= %zu bytes of workspace (got %d, %zu)\n", (size_t)WS_END, n_in, ws_size); grid = -1; return; }
        int dev = 0, cus = 0, per_cu = 0;
        hipGetDevice(&dev); hipDeviceGetAttribute(&cus, hipDeviceAttributeMultiprocessorCount, dev);
        if (hipFuncSetAttribute((const void*)fwd_megakernel, hipFuncAttributeMaxDynamicSharedMemorySize, LDS_BYTES) != hipSuccess) { fprintf(stderr, "kernel_launch: hipFuncSetAttribute failed\n"); grid = -1; return; }
        if (hipOccupancyMaxActiveBlocksPerMultiprocessor(&per_cu, (const void*)fwd_megakernel, NWAVES * 64, LDS_BYTES) != hipSuccess || per_cu < 1) { fprintf(stderr, "kernel_launch: occupancy query says %d\n", per_cu); per_cu = 1; }
        (void)hipGetLastError();
        grid = cus * 1;
    }
    if (grid < 0) return;
    Args a{};
    for (int i = 0; i < 22; ++i) a.in[i] = (const float*)d_in[i];
    a.out = (float*)d_out; a.ws = (unsigned char*)d_ws; a.G = grid; a.pad = 0;
#if MK_PER_PHASE
    for (int ph = 0; ph < 16; ++ph) { a.ph_lo = ph; a.ph_hi = ph + 1; void* kargs[] = {&a};
        hipError_t e = hipLaunchCooperativeKernel((const void*)fwd_megakernel, dim3(grid), dim3(NWAVES * 64), kargs, LDS_BYTES, stream);
        if (e != hipSuccess) { fprintf(stderr, "kernel_launch: launch failed: %s\n", hipGetErrorString(e)); break; } }
#else
    (void)hipMemsetAsync((char*)d_ws + 16384, 0, 256, stream);
    a.ph_lo = 0; a.ph_hi = 16; void* kargs[] = {&a};
    hipError_t e = hipLaunchCooperativeKernel((const void*)fwd_megakernel, dim3(grid), dim3(NWAVES * 64), kargs, LDS_BYTES, stream);
    if (e != hipSuccess) fprintf(stderr, "kernel_launch: cooperative launch failed: %s (grid %d)\n", hipGetErrorString(e), grid);
#endif
}
```
